# Optimizing an MI355X kernel written in HIP

```python
import jax
import jax.numpy as jnp
from jax import lax
import numpy as np

D_MODEL = 1024
BATCH = 8
SEQ = 4096
DEPTH = 2

GRID_W = 64
CTX_LEN = 256
EPS = 1e-6

HGRN_HEADS = 4
HGRN_DK = 128
HGRN_DV = 128
HGRN_W = HGRN_HEADS * HGRN_DK
HGRN_VW = HGRN_HEADS * HGRN_DV
HGRN_CHUNK = 64
SGU_HEADS = 4
SGU_HEAD_DIM = 128
SGU_W = SGU_HEADS * SGU_HEAD_DIM
SGU_CHUNK = 128
ROWS_PER_CHUNK = SGU_CHUNK // GRID_W
MIX_W = HGRN_VW + SGU_W
IN_W = 3 * HGRN_W + 2 * HGRN_VW + 2 * SGU_W
SPLIT_POINTS = (HGRN_W, 2 * HGRN_W, 3 * HGRN_W, 3 * HGRN_W + HGRN_VW,
                3 * HGRN_W + 2 * HGRN_VW, 3 * HGRN_W + 2 * HGRN_VW + SGU_W)
N_GROUPS = 4
EXPERTS_PER_GROUP = 8
N_EXPERTS = N_GROUPS * EXPERTS_PER_GROUP
TOP_K = 2
D_EXPERT = 512
MOE_BLOCK = 128

kernel_name = 'hybrid_hgrn2_sgu_hmoe_dit'


def rmsnorm(x, gain):
    xf = x.astype(jnp.float32)
    y = xf * lax.rsqrt(jnp.mean(xf * xf, axis=-1, keepdims=True) + EPS)
    return (y * gain.astype(jnp.float32)).astype(x.dtype)


def modulate(h, shift, scale):
    return h * (1 + scale) + shift


def flip(t):
    return jnp.flip(t, axis=1)


def _heads(t, n_heads):
    return t.astype(jnp.float32).reshape(t.shape[0], t.shape[1], n_heads, -1)


def forget_gate(z, lb):
    zf = z.astype(jnp.float32)
    lb = lb.astype(jnp.float32)
    log_f = jnp.logaddexp(jnp.log(lb), jnp.log1p(-lb) + jax.nn.log_sigmoid(zf))
    k = (1.0 - lb) * jax.nn.sigmoid(-zf)
    return log_f, k


def split_mixer_inputs(p, lb):
    q, z_fwd, z_bwd, i, g, u, v = jnp.split(p, SPLIT_POINTS, axis=-1)
    lf_fwd, k_fwd = forget_gate(z_fwd, lb[0])
    lf_bwd, k_bwd = forget_gate(z_bwd, lb[1])
    h = HGRN_HEADS
    return (_heads(q, h), _heads(i, h), _heads(lf_fwd, h), _heads(k_fwd, h),
            _heads(lf_bwd, h), _heads(k_bwd, h), g, u, v)


def hgrn_chunk(q, k, v, log_f, s0):
    b, l = q.shape[0], q.shape[1]
    n = l // HGRN_CHUNK

    def blocks(t):
        return t.reshape(b, n, HGRN_CHUNK, t.shape[2], t.shape[3])

    q, k, v, log_f = blocks(q), blocks(k), blocks(v), blocks(log_f)
    cum = jnp.cumsum(log_f, axis=2)
    ref = cum[:, :, HGRN_CHUNK // 2 - 1][:, :, None]
    tot = cum[:, :, -1]
    scores = jnp.einsum('bnihd,bnjhd->bnhij', q * jnp.exp(cum - ref), k * jnp.exp(ref - cum))
    lower_tri = jnp.tril(jnp.ones((HGRN_CHUNK, HGRN_CHUNK), dtype=bool))
    scores = jnp.where(lower_tri, scores, 0.0)
    o_intra = jnp.einsum('bnhij,bnjhe->bnihe', scores, v)
    u = jnp.einsum('bnjhd,bnjhe->nbhde', k * jnp.exp(tot[:, :, None] - cum), v)
    decay = jnp.exp(tot).transpose(1, 0, 2, 3)

    def step(s, inp):
        d, un = inp
        return d[..., None] * s + un, s

    s_final, s_start = lax.scan(step, s0, (decay, u))
    o_inter = jnp.einsum('bnihd,nbhde->bnihe', q * jnp.exp(cum), s_start)
    return (o_intra + o_inter).reshape(b, l, q.shape[3], v.shape[4]), s_final


def hgrn_final_state(k, v, log_f):
    cum = jnp.cumsum(log_f, axis=1)
    return jnp.einsum('blhd,blhe->bhde', k * jnp.exp(cum[:, -1:] - cum), v)


def hgrn_bidirectional(q, i, lf_f, k_f, lf_b, k_b, s0_f, s0_b):
    o_f, s_f = hgrn_chunk(q, k_f, i, lf_f, s0_f)
    o_b, s_b = hgrn_chunk(flip(q), flip(k_b), flip(i), flip(lf_b), s0_b)
    return o_f + flip(o_b), s_f, s_b


def head_rmsnorm(o, gain):
    o = o * lax.rsqrt(jnp.mean(o * o, axis=-1, keepdims=True) + EPS)
    return o.reshape(o.shape[0], o.shape[1], -1) * gain.astype(jnp.float32)


def spatial_gating(u, v, gain, w_s, b_s, n_chunks):
    b = u.shape[0]
    v = rmsnorm(v, gain).reshape(b, n_chunks, SGU_CHUNK, SGU_HEADS, SGU_HEAD_DIM)
    mixed = jnp.einsum('hij,bnjhd->bnihd', w_s, v) + b_s.T[None, None, :, :, None]
    return u * mixed.reshape(u.shape)


def mixer_output(o, g, u, v, n_chunks, hgrn_gain, sgu_gain, w_s, b_s, w_o):
    hg = (head_rmsnorm(o, hgrn_gain) * jax.nn.silu(g.astype(jnp.float32))).astype(g.dtype)
    sg = spatial_gating(jax.nn.gelu(u), jax.nn.gelu(v), sgu_gain, w_s, b_s, n_chunks)
    return jnp.concatenate([hg, sg], axis=-1) @ w_o


def hier_moe(h, w_group, b_group, w_router, b_router, w_gate, w_up, w_down):
    t, d = h.shape
    logits_g = (h @ w_group).astype(jnp.float32) + b_group.astype(jnp.float32)
    p_group = jax.nn.softmax(logits_g, axis=-1)
    g_sel = jnp.argmax(logits_g, axis=-1)
    p_sel = jnp.take_along_axis(p_group, g_sel[:, None], axis=-1)
    logits_e = ((h @ w_router).astype(jnp.float32) + b_router.astype(jnp.float32))
    logits_e = logits_e.reshape(t, N_GROUPS, EXPERTS_PER_GROUP)
    logits_in = jnp.take_along_axis(logits_e, g_sel[:, None, None], axis=1)[:, 0]
    top_logits, top_idx = lax.top_k(logits_in, TOP_K)
    combine = p_sel * jax.nn.softmax(top_logits, axis=-1)
    expert = (g_sel[:, None] * EXPERTS_PER_GROUP + top_idx).reshape(-1)
    n_slots = t * TOP_K
    order = jnp.argsort(expert)
    e_sorted = expert[order]
    tok_sorted = order // TOP_K
    counts = jax.ops.segment_sum(jnp.ones((n_slots,), jnp.int32), expert, num_segments=N_EXPERTS)
    padded = (counts + MOE_BLOCK - 1) // MOE_BLOCK * MOE_BLOCK
    pad_end = jnp.cumsum(padded)
    pad_start = pad_end - padded
    start = jnp.cumsum(counts) - counts
    dest = pad_start[e_sorted] + jnp.arange(n_slots) - start[e_sorted]
    n_blocks = -(-n_slots // MOE_BLOCK) + N_EXPERTS
    buf = jnp.zeros((n_blocks * MOE_BLOCK, d), h.dtype).at[dest].set(h[tok_sorted])
    block_expert = jnp.minimum(
        jnp.searchsorted(pad_end, jnp.arange(n_blocks) * MOE_BLOCK, side='right'), N_EXPERTS - 1)

    def expert_block(args):
        xb, e = args
        return (jax.nn.silu(xb @ w_gate[e]) * (xb @ w_up[e])) @ w_down[e]

    out = lax.map(expert_block, (buf.reshape(n_blocks, MOE_BLOCK, d), block_expert))
    y_sorted = out.reshape(-1, d)[dest] * combine.reshape(-1)[order][:, None].astype(h.dtype)
    return jax.ops.segment_sum(y_sorted, tok_sorted, num_segments=t)


def setup_inputs(seed: int = 0) -> dict:
    key = jax.random.key(seed)
    ks = jax.random.split(key, 24)
    d = D_MODEL

    def nrm(k, shape, scale):
        return jax.random.normal(k, shape, jnp.float32) * scale

    return {
        'x': nrm(ks[0], (BATCH, SEQ, d), 1.0),
        'c': nrm(ks[1], (BATCH, d), 1.0),
        'ctx': nrm(ks[2], (BATCH, CTX_LEN, d), 1.0),
        'c_ctx': nrm(ks[3], (d,), 1.0),
        'norm1': 1.0 + nrm(ks[4], (DEPTH, d), 0.02),
        'norm2': 1.0 + nrm(ks[5], (DEPTH, d), 0.02),
        'w_mod': nrm(ks[6], (DEPTH, d, 6 * d), 0.5 * d ** -0.5),
        'b_mod': nrm(ks[7], (DEPTH, 6 * d), 0.02),
        'w_in': nrm(ks[8], (DEPTH, d, IN_W), d ** -0.5),
        'lb_logits': nrm(ks[9], (DEPTH, 2, HGRN_W), 0.5),
        'hgrn_norm': 1.0 + nrm(ks[10], (DEPTH, HGRN_VW), 0.02),
        'sgu_norm': 1.0 + nrm(ks[11], (DEPTH, SGU_W), 0.02),
        'sgu_w': nrm(ks[12], (DEPTH, SGU_HEADS, SGU_CHUNK, SGU_CHUNK), SGU_CHUNK ** -0.5),
        'sgu_b': 1.0 + nrm(ks[13], (DEPTH, SGU_HEADS, SGU_CHUNK), 0.02),
        'w_out': nrm(ks[14], (DEPTH, MIX_W, d), MIX_W ** -0.5),
        'w_group': nrm(ks[15], (DEPTH, d, N_GROUPS), d ** -0.5),
        'b_group': nrm(ks[16], (DEPTH, N_GROUPS), 0.01),
        'w_router': nrm(ks[17], (DEPTH, d, N_EXPERTS), d ** -0.5),
        'b_router': nrm(ks[18], (DEPTH, N_EXPERTS), 0.01),
        'w_gate': nrm(ks[19], (DEPTH, N_EXPERTS, d, D_EXPERT), d ** -0.5),
        'w_up': nrm(ks[20], (DEPTH, N_EXPERTS, d, D_EXPERT), d ** -0.5),
        'w_down': nrm(ks[21], (DEPTH, N_EXPERTS, D_EXPERT, d), D_EXPERT ** -0.5),
        'final_norm': 1.0 + nrm(ks[22], (d,), 0.02),
    }


def reference(x, c, ctx, c_ctx, norm1, norm2, w_mod, b_mod, w_in, lb_logits, hgrn_norm,
              sgu_norm, sgu_w, sgu_b, w_out, w_group, b_group, w_router, b_router,
              w_gate, w_up, w_down, final_norm):
    b, l, d = x.shape
    rows = l // GRID_W
    n_lat_chunks = rows // ROWS_PER_CHUNK
    n_ctx_chunks = ctx.shape[1] // SGU_CHUNK
    lb_cum = jnp.cumsum(jax.nn.softmax(lb_logits.astype(jnp.float32), axis=0), axis=0)
    lower_bound = jnp.maximum(lb_cum - lb_cum[0:1], 0.0)
    s_zero = jnp.zeros((b, HGRN_HEADS, HGRN_DK, HGRN_DV), jnp.float32)
    y = ctx
    for layer in range(DEPTH):
        last = layer == DEPTH - 1
        mod_lat = jax.nn.silu(c) @ w_mod[layer] + b_mod[layer]
        mod_ctx = jax.nn.silu(c_ctx) @ w_mod[layer] + b_mod[layer]
        sh1, sc1, g1, sh2, sc2, g2 = jnp.split(mod_lat[:, None, :], 6, axis=-1)
        csh1, csc1, cg1, csh2, csc2, cg2 = jnp.split(mod_ctx[None, None, :], 6, axis=-1)

        p_lat = modulate(rmsnorm(x, norm1[layer]), sh1, sc1) @ w_in[layer]
        p_ctx = modulate(rmsnorm(y, norm1[layer]), csh1, csc1) @ w_in[layer]
        q, i, lf_f, k_f, lf_b, k_b, g, u, v = split_mixer_inputs(p_lat, lower_bound[layer])
        cq, ci, clf_f, ck_f, clf_b, ck_b, cg, cu, cv = split_mixer_inputs(p_ctx, lower_bound[layer])
        if last:
            s_f = hgrn_final_state(ck_f, ci, clf_f)
            s_b = hgrn_final_state(flip(ck_b), flip(ci), flip(clf_b))
        else:
            co, s_f, s_b = hgrn_bidirectional(cq, ci, clf_f, ck_f, clf_b, ck_b, s_zero, s_zero)
            out_ctx = mixer_output(co, cg, cu, cv, n_ctx_chunks, hgrn_norm[layer], sgu_norm[layer],
                                   sgu_w[layer], sgu_b[layer], w_out[layer])
            y = y + cg1 * out_ctx
        lo, _, _ = hgrn_bidirectional(q, i, lf_f, k_f, lf_b, k_b, s_f, s_b)
        out_lat = mixer_output(lo, g, u, v, n_lat_chunks, hgrn_norm[layer], sgu_norm[layer],
                               sgu_w[layer], sgu_b[layer], w_out[layer])
        x = x + g1 * out_lat

        moe_w = (w_group[layer], b_group[layer], w_router[layer], b_router[layer],
                 w_gate[layer], w_up[layer], w_down[layer])
        h2_lat = modulate(rmsnorm(x, norm2[layer]), sh2, sc2).reshape(-1, d)
        if last:
            f_lat = hier_moe(h2_lat, *moe_w).reshape(b, l, d)
        else:
            h2_ctx = modulate(rmsnorm(y, norm2[layer]), csh2, csc2).reshape(-1, d)
            f_all = hier_moe(jnp.concatenate([h2_lat, h2_ctx], axis=0), *moe_w)
            f_lat = f_all[: b * l].reshape(b, l, d)
            y = y + cg2 * f_all[b * l:].reshape(y.shape)
        x = x + g2 * f_lat
    return rmsnorm(x, final_norm)
```

```cpp
#include <hip/hip_runtime.h>
#include <hip/hip_cooperative_groups.h>
#include <cstdio>
#include <cstdint>
namespace cg = cooperative_groups;

constexpr int D = 1024, NB = 8, SEQ = 4096, CL = 256, RB = SEQ + CL  , M = NB * RB  ;
constexpr int INW = 3584, NEXP = 32, DE = 512, NSLOT = M * 2, NSLOT_PAD = NSLOT + NEXP * 256, MT_MAX = NSLOT_PAD / 256;
constexpr float EPS = 1e-6f;

namespace pg8 {
#define PG8_LAS __attribute__((address_space(3)))
typedef unsigned short bf16_t;
typedef short bf16x8 __attribute__((ext_vector_type(8)));
typedef float f32x4 __attribute__((ext_vector_type(4)));
typedef unsigned u32x4 __attribute__((ext_vector_type(4)));
constexpr int BM = 256, BK = 64, HALF = 128, HTB = HALF * BK * 2  , STAGE_BYTES = 8 * HTB, NXCD = 8, WGM = 8;

__host__ __device__ __forceinline__ int lds_byte(int r, int c) { const int st = (r >> 4) * 2 + (c >> 5), rr = r & 15, cc = c & 31, ob = rr * 64 + cc * 2; return st * 1024 + (ob ^ (((ob >> 9) & 1) << 5)); }
__host__ __device__ __forceinline__ void stage_rc(int b, int& R, int& C) { const int st = b / 1024, sb = b % 1024, swz = sb ^ (((sb >> 9) & 1) << 5); R = (st >> 1) * 16 + swz / 64; C = (st & 1) * 32 + (swz % 64) / 2; }
__host__ __device__ __forceinline__ int perm32(int rho) { const int n = rho >> 4, i = rho & 15; return 8 * (i >> 2) + 4 * n + (i & 3); }

struct Unit { int pm, pn, pb; };
struct Gemm { const bf16_t* A; const bf16_t* Bt; int M, N, K; };

struct StaticOrder {
    int nM, nN, nwg, G, c;
    __host__ __device__ void init(int M, int N, int G_, int c_) { nM = M / BM; nN = N / BM; nwg = nM * nN; G = G_; c = c_; }
    __host__ __device__ bool next(int i, Unit& u) const {
        const long L = (long)i * G + c; if (L >= nwg) return false;
        int wgid = (int)L; { const int q = nwg / NXCD, r = nwg % NXCD, xcd = wgid % NXCD, off = wgid / NXCD; wgid = (xcd < r ? xcd * (q + 1) : r * (q + 1) + (xcd - r) * q) + off; }
        const int nig = WGM * nN, gid = wgid / nig, fm = gid * WGM, gsz = (nM - fm) < WGM ? (nM - fm) : WGM;
        u.pm = fm + ((wgid % nig) % gsz); u.pn = (wgid % nig) / gsz; u.pb = u.pn; return true;
    }
    __device__ __forceinline__ void a_ready(const Unit&) const {}
    __device__ __forceinline__ void done(const Unit&) const {}
};

__device__ __forceinline__ unsigned cvt_pk_bf16(float lo, float hi) { unsigned r; asm volatile("v_cvt_pk_bf16_f32 %0, %1, %2" : "=v"(r) : "v"(lo), "v"(hi)); return r; }
typedef float f32x2 __attribute__((ext_vector_type(2)));
struct DenseOrder {
    int nM, nN, nwg, G, c, lat_only;
    __device__ void init(int nM_, int nN_, int G_, int c_, int lat_only_) { nM = nM_; nN = nN_; nwg = nM * nN; G = G_; c = c_; lat_only = lat_only_; }
    __device__ bool next(int i, Unit& u) const {
        const long L = (long)i * G + c; if (L >= nwg) return false;
        int wgid = (int)L; { const int q = nwg / NXCD, r = nwg % NXCD, xcd = wgid % NXCD, off = wgid / NXCD; wgid = (xcd < r ? xcd * (q + 1) : r * (q + 1) + (xcd - r) * q) + off; }
        const int nig = WGM * nN, gid = wgid / nig, fm = gid * WGM, gsz = (nM - fm) < WGM ? (nM - fm) : WGM;
        int pm = fm + ((wgid % nig) % gsz); u.pn = (wgid % nig) / gsz; u.pb = u.pn;
        if (lat_only) pm = (pm >> 4) * 17 + (pm & 15);
        u.pm = pm; return true;
    }
    __device__ __forceinline__ void a_ready(const Unit&) const {}
    __device__ __forceinline__ void done(const Unit&) const {}
};
struct MoeOrder {
    const int* tile_e; int nM, nN, nwg, G, c, nbt;
    __device__ void init(const int* te, int nM_, int nN_, int G_, int c_, int nbt_) { tile_e = te; nM = nM_; nN = nN_; nwg = nM * nN; G = G_; c = c_; nbt = nbt_; }
    __device__ bool next(int i, Unit& u) const {
        const long L = (long)i * G + c; if (L >= nwg) return false;
        int wgid = (int)L; { const int q = nwg / NXCD, r = nwg % NXCD, xcd = wgid % NXCD, off = wgid / NXCD; wgid = (xcd < r ? xcd * (q + 1) : r * (q + 1) + (xcd - r) * q) + off; }
        const int nig = WGM * nN, gid = wgid / nig, fm = gid * WGM, gsz = (nM - fm) < WGM ? (nM - fm) : WGM;
        u.pm = fm + ((wgid % nig) % gsz); u.pn = (wgid % nig) / gsz;
        u.pb = __builtin_amdgcn_readfirstlane(tile_e[u.pm]) * nbt + u.pn; return true;
    }
    __device__ __forceinline__ void a_ready(const Unit&) const {}
    __device__ __forceinline__ void done(const Unit&) const {}
};

__device__ __forceinline__ float fast_silu(float x) { return x * __builtin_amdgcn_rcpf(1.f + __expf(-x)); }
struct EpiStoreBf16 {
    static constexpr bool PERM = true, AFTER_DRAIN = false;
    bf16_t* O; int ldc;
    __device__ __forceinline__ void operator()(const f32x4 (&acc)[2][2][4][2], const Unit& u, int wr, int wc, int fr, int fq) const {
        const int row0 = u.pm * BM + wr * 64 + fr, col0 = u.pn * BM + wc * 32 + 8 * fq;
#pragma unroll
        for (int ai = 0; ai < 2; ++ai)
#pragma unroll
            for (int m = 0; m < 4; ++m) { bf16_t* rowp = O + (size_t)(row0 + ai * HALF + m * 16) * ldc + col0;
#pragma unroll
                for (int bj = 0; bj < 2; ++bj) { const f32x4 v0 = acc[ai][bj][m][0], v1 = acc[ai][bj][m][1];
                    u32x4 w; w.x = cvt_pk_bf16(v0[0], v0[1]); w.y = cvt_pk_bf16(v0[2], v0[3]); w.z = cvt_pk_bf16(v1[0], v1[1]); w.w = cvt_pk_bf16(v1[2], v1[3]);
                    *(u32x4*)(rowp + bj * HALF) = w; } }
    }
};
struct EpiSwiglu {
    static constexpr bool PERM = true, AFTER_DRAIN = false;
    bf16_t* ACT;
    __device__ __forceinline__ void operator()(const f32x4 (&acc)[2][2][4][2], const Unit& u, int wr, int wc, int fr, int fq) const {
        const int row0 = u.pm * BM + wr * 64 + fr, col0 = u.pn * HALF + wc * 32 + 8 * fq;
#pragma unroll
        for (int ai = 0; ai < 2; ++ai)
#pragma unroll
            for (int m = 0; m < 4; ++m) { bf16_t* rowp = ACT + (size_t)(row0 + ai * HALF + m * 16) * DE + col0;
                const f32x4 g0 = acc[ai][0][m][0], g1 = acc[ai][0][m][1], u0 = acc[ai][1][m][0], u1 = acc[ai][1][m][1];
                u32x4 w; w.x = cvt_pk_bf16(fast_silu(g0[0]) * u0[0], fast_silu(g0[1]) * u0[1]); w.y = cvt_pk_bf16(fast_silu(g0[2]) * u0[2], fast_silu(g0[3]) * u0[3]);
                w.z = cvt_pk_bf16(fast_silu(g1[0]) * u1[0], fast_silu(g1[1]) * u1[1]); w.w = cvt_pk_bf16(fast_silu(g1[2]) * u1[2], fast_silu(g1[3]) * u1[3]);
                *(u32x4*)rowp = w; }
    }
};
struct EpiResid {
    static constexpr bool PERM = false, AFTER_DRAIN = false;
    const float* src_lat; const float* src_ctx; float* dst_lat; float* dst_ctx; const float* modl; float* ss;
    __device__ __forceinline__ void operator()(const f32x4 (&acc)[2][2][4][2], const Unit& u, int wr, int wc, int fr, int fq) const {
        const int b = u.pm / 17, j = u.pm % 17; const bool isctx = j == 16;
        const size_t trow = isctx ? (size_t)b * CL : (size_t)b * SEQ + (size_t)j * 256;
        const float* sb = (isctx ? src_ctx : src_lat) + trow * D; float* db = (isctx ? dst_ctx : dst_lat) + trow * D;
        const float* g1 = modl + (size_t)(isctx ? 8 : b) * 6144 + 2 * 1024;
        const int col0 = u.pn * BM + wc * 32 + 4 * fq;
        f32x4 gv[2][2];
#pragma unroll
        for (int bj = 0; bj < 2; ++bj)
#pragma unroll
            for (int n = 0; n < 2; ++n) gv[bj][n] = *(const f32x4*)(g1 + col0 + bj * HALF + n * 16);
#pragma unroll
        for (int ai = 0; ai < 2; ++ai)
#pragma unroll
            for (int m = 0; m < 4; ++m) { const int rt = ai * HALF + wr * 64 + m * 16 + fr; const size_t off = (size_t)rt * D + col0; float s = 0.f;
#pragma unroll
                for (int bj = 0; bj < 2; ++bj)
#pragma unroll
                    for (int n = 0; n < 2; ++n) { const f32x4 xs = *(const f32x4*)(sb + off + bj * HALF + n * 16); const f32x4 o = xs + gv[bj][n] * acc[ai][bj][m][n];
                        *(f32x4*)(db + off + bj * HALF + n * 16) = o; s += (o[0] * o[0] + o[1] * o[1]) + (o[2] * o[2] + o[3] * o[3]); }
                s += __shfl_xor(s, 16); s += __shfl_xor(s, 32);
                if (fq == 0) atomicAdd(ss + u.pm * BM + rt, s); }
    }
};
template <class Epi, class Sched, bool ALIGN_EPI = false, bool SP2 = false>
__device__ __forceinline__ void gemm_phase(PG8_LAS unsigned char* lds, const Gemm g, const Sched& S, const Epi& E, const int tid_in) {
    const int tid = tid_in, wid = __builtin_amdgcn_readfirstlane(tid >> 6), lane = tid & 63, wr = wid >> 2, wc = wid & 3, fr = lane & 15, fq = lane >> 4;
    const int K = g.K, nt = K / BK;
    unsigned voffA[2], voffB[2];
#pragma unroll
    for (int i = 0; i < 2; ++i) { int R, C; stage_rc(tid * 16 + i * 8192, R, C); const int Rb = Epi::PERM ? ((R & ~31) + perm32(R & 31)) : R;
        voffA[i] = (unsigned)(R * K + C) * 2u; voffB[i] = (unsigned)(Rb * K + C) * 2u; }
    const size_t kstep = (size_t)(BK * 2);
    const size_t hstep = (size_t)HALF * K * 2;
    const size_t tstep = 2 * hstep;
    const unsigned ldsw = (unsigned)wid * 1024u;
    const int aoff = lds_byte(wr * 64 + fr, fq * 8), boff = lds_byte(wc * 32 + fr, fq * 8);
#define PG8_SA(b, h) (((b) * 2 + (h)) * HTB)
#define PG8_SB(b, h) ((4 + (b) * 2 + (h)) * HTB)
#define PG8_STAGE(bufoff, gbase, voff) do { _Pragma("unroll") for (int _i = 0; _i < 2; ++_i) \
        __builtin_amdgcn_global_load_lds((const unsigned*)((const char*)(gbase) + (voff)[_i]), (PG8_LAS unsigned*)(lds + (bufoff) + ldsw + _i * 8192), 16, 0, 0); } while (0)
#define PG8_LDA(dst, b, h) do { _Pragma("unroll") for (int m = 0; m < 4; ++m) _Pragma("unroll") for (int k = 0; k < 2; ++k) dst[m][k] = *(const PG8_LAS bf16x8*)(lds + PG8_SA(b, h) + aoff + m * 2048 + k * 1024); } while (0)
#define PG8_LDB(dst, b, h) do { _Pragma("unroll") for (int n = 0; n < 2; ++n) _Pragma("unroll") for (int k = 0; k < 2; ++k) dst[n][k] = *(const PG8_LAS bf16x8*)(lds + PG8_SB(b, h) + boff + n * 2048 + k * 1024); } while (0)
#define PG8_MMA(ai, bj, At, Bt) do { __builtin_amdgcn_s_setprio(1); _Pragma("unroll") for (int m = 0; m < 4; ++m) _Pragma("unroll") for (int n = 0; n < 2; ++n) _Pragma("unroll") for (int k = 0; k < 2; ++k) \
        acc[ai][bj][m][n] = __builtin_amdgcn_mfma_f32_16x16x32_bf16(Bt[n][k], At[m][k], acc[ai][bj][m][n], 0, 0, 0); __builtin_amdgcn_s_setprio(0); } while (0)
#define PG8_WAIT_V(n) asm volatile("s_waitcnt vmcnt(" #n ")" ::: "memory")
#define PG8_WAIT_L(n) asm volatile("s_waitcnt lgkmcnt(" #n ")" ::: "memory")
#define PG8_BAR __builtin_amdgcn_s_barrier()
#define PG8_SCHED __builtin_amdgcn_sched_barrier(0)
    Unit cur, nxt; int ui = 0;
    if (!S.next(0, cur)) return;
    f32x4 acc[2][2][4][2];
#pragma unroll
    for (int a = 0; a < 2; ++a)
#pragma unroll
        for (int b = 0; b < 2; ++b)
#pragma unroll
            for (int m = 0; m < 4; ++m)
#pragma unroll
                for (int n = 0; n < 2; ++n) acc[a][b][m][n] = (f32x4){0.f, 0.f, 0.f, 0.f};
    bf16x8 At[4][2], B0[2][2], B1[2][2];
    const char* cA = (const char*)g.A + (size_t)cur.pm * tstep; const char* cB = (const char*)g.Bt + (size_t)cur.pb * tstep;
    S.a_ready(cur);
    if constexpr (SP2) {
        PG8_STAGE(PG8_SB(0, 0), cB, voffB); PG8_STAGE(PG8_SB(0, 1), cB + hstep, voffB); PG8_STAGE(PG8_SA(0, 0), cA, voffA); PG8_STAGE(PG8_SA(0, 1), cA + hstep, voffA);
        if (wr == 1) PG8_BAR;
        PG8_WAIT_V(2); PG8_BAR;
        PG8_STAGE(PG8_SB(1, 0), cB + kstep, voffB); PG8_STAGE(PG8_SA(1, 0), cA + kstep, voffA); PG8_STAGE(PG8_SB(1, 1), cB + hstep + kstep, voffB);
        PG8_WAIT_V(6); PG8_BAR;
    } else {
        PG8_STAGE(PG8_SB(0, 0), cB, voffB); PG8_STAGE(PG8_SA(0, 0), cA, voffA); PG8_STAGE(PG8_SB(0, 1), cB + hstep, voffB); PG8_STAGE(PG8_SA(0, 1), cA + hstep, voffA);
        if (wr == 1) PG8_BAR;
        PG8_WAIT_V(4); PG8_BAR;
        PG8_STAGE(PG8_SB(1, 0), cB + kstep, voffB); PG8_STAGE(PG8_SA(1, 0), cA + kstep, voffA); PG8_STAGE(PG8_SB(1, 1), cB + hstep + kstep, voffB);
        PG8_WAIT_V(6); PG8_BAR;
    }
    for (;;) {
        const bool has_next = S.next(ui + 1, nxt);
        const char* nA = has_next ? (const char*)g.A + (size_t)nxt.pm * tstep : cA; const char* nB = has_next ? (const char*)g.Bt + (size_t)nxt.pb * tstep : cB;
        for (int t = 0; t < nt; t += 2) {
            const bool last = (t == nt - 2);
            const char* a1 = cA + (size_t)(t + 1) * kstep;
            const char* a2 = last ? nA : cA + (size_t)(t + 2) * kstep; const char* b2 = last ? nB : cB + (size_t)(t + 2) * kstep;
            const char* a3 = a2 + kstep; const char* b3 = b2 + kstep;
            if (last && has_next) S.a_ready(nxt);
            if constexpr (SP2) {
            PG8_LDB(B0, 0, 0); PG8_LDB(B1, 0, 1); PG8_SCHED; PG8_LDA(At, 0, 0); PG8_STAGE(PG8_SA(1, 1), a1 + hstep, voffA);
            PG8_WAIT_V(8); PG8_WAIT_L(0); PG8_BAR; PG8_MMA(0, 0, At, B0); PG8_MMA(0, 1, At, B1); PG8_BAR; PG8_SCHED;
            PG8_LDA(At, 0, 1); PG8_STAGE(PG8_SB(0, 0), b2, voffB); PG8_STAGE(PG8_SB(0, 1), b2 + hstep, voffB); PG8_STAGE(PG8_SA(0, 0), a2, voffA);
            PG8_WAIT_V(8); PG8_WAIT_L(0); PG8_BAR; PG8_MMA(1, 0, At, B0); PG8_MMA(1, 1, At, B1); PG8_BAR; PG8_SCHED;
            PG8_LDB(B0, 1, 0); PG8_LDB(B1, 1, 1); PG8_SCHED; PG8_LDA(At, 1, 0); PG8_STAGE(PG8_SA(0, 1), a2 + hstep, voffA);
            PG8_WAIT_V(8); PG8_WAIT_L(0); PG8_BAR; PG8_MMA(0, 0, At, B0); PG8_MMA(0, 1, At, B1); PG8_BAR; PG8_SCHED;
            PG8_LDA(At, 1, 1); PG8_STAGE(PG8_SB(1, 0), b3, voffB); PG8_STAGE(PG8_SB(1, 1), b3 + hstep, voffB); PG8_STAGE(PG8_SA(1, 0), a3, voffA);
            PG8_WAIT_V(8); PG8_WAIT_L(0); PG8_BAR; PG8_MMA(1, 0, At, B0); PG8_MMA(1, 1, At, B1); PG8_BAR; PG8_SCHED;
            } else {
            PG8_LDB(B0, 0, 0); PG8_SCHED; PG8_LDA(At, 0, 0); PG8_STAGE(PG8_SA(1, 1), a1 + hstep, voffA);
            PG8_WAIT_L(8); PG8_BAR; PG8_WAIT_L(0); PG8_MMA(0, 0, At, B0); PG8_BAR; PG8_SCHED;
            PG8_LDB(B1, 0, 1); PG8_STAGE(PG8_SB(0, 0), b2, voffB);
            PG8_BAR; PG8_WAIT_L(0); PG8_MMA(0, 1, At, B1); PG8_BAR;
            PG8_LDA(At, 0, 1); PG8_STAGE(PG8_SA(0, 0), a2, voffA);
            PG8_BAR; PG8_WAIT_L(0); PG8_MMA(1, 0, At, B0); PG8_BAR; PG8_SCHED;
            PG8_STAGE(PG8_SB(0, 1), b2 + hstep, voffB);
            PG8_WAIT_V(6); PG8_BAR; PG8_MMA(1, 1, At, B1); PG8_BAR;
            PG8_LDB(B0, 1, 0); PG8_SCHED; PG8_LDA(At, 1, 0); PG8_STAGE(PG8_SA(0, 1), a2 + hstep, voffA);
            PG8_WAIT_L(8); PG8_BAR; PG8_WAIT_L(0); PG8_MMA(0, 0, At, B0); PG8_BAR; PG8_SCHED;
            PG8_LDB(B1, 1, 1); PG8_STAGE(PG8_SB(1, 0), b3, voffB);
            PG8_BAR; PG8_WAIT_L(0); PG8_MMA(0, 1, At, B1); PG8_BAR;
            PG8_LDA(At, 1, 1); PG8_STAGE(PG8_SA(1, 0), a3, voffA);
            PG8_BAR; PG8_WAIT_L(0); PG8_MMA(1, 0, At, B0); PG8_BAR; PG8_SCHED;
            PG8_STAGE(PG8_SB(1, 1), b3 + hstep, voffB);
            PG8_WAIT_V(6); PG8_BAR; PG8_MMA(1, 1, At, B1); PG8_BAR;
            }
        }
        if constexpr (ALIGN_EPI) { if (wr == 0) PG8_BAR; }
        if constexpr (!Epi::AFTER_DRAIN) { E(acc, cur, wr, wc, fr, fq); S.done(cur); }
        if (!has_next) break;
#pragma unroll
        for (int a = 0; a < 2; ++a)
#pragma unroll
            for (int b = 0; b < 2; ++b)
#pragma unroll
                for (int m = 0; m < 4; ++m)
#pragma unroll
                    for (int n = 0; n < 2; ++n) acc[a][b][m][n] = (f32x4){0.f, 0.f, 0.f, 0.f};
        cur = nxt; cA = nA; cB = nB; ++ui;
        if constexpr (ALIGN_EPI) { if (wr == 1) PG8_BAR; }
    }
    PG8_WAIT_V(0);
    if constexpr (!ALIGN_EPI) { if (wr == 0) PG8_BAR; }
    PG8_BAR;
    if constexpr (Epi::AFTER_DRAIN) { E.fused(acc, cur, wr, wc, fr, fq, lds, wid, lane); S.done(cur); }
#undef PG8_SA
#undef PG8_SB
#undef PG8_STAGE
#undef PG8_LDA
#undef PG8_LDB
#undef PG8_MMA
#undef PG8_WAIT_V
#undef PG8_WAIT_L
#undef PG8_BAR
#undef PG8_SCHED
}
}

#define LAS __attribute__((address_space(3)))
typedef unsigned short bf16;
typedef float f32x4 __attribute__((ext_vector_type(4)));
typedef unsigned u32x4 __attribute__((ext_vector_type(4)));
typedef unsigned u32x2 __attribute__((ext_vector_type(2)));
constexpr int NWAVES = 8, NTHREADS = 512, LDS_BYTES = 160 * 1024;

__device__ __forceinline__ unsigned f2bf(float f) { unsigned u = __float_as_uint(f); return (u + 0x7fffu + ((u >> 16) & 1u)) >> 16; }
__device__ __forceinline__ unsigned pk2(float lo, float hi) { return f2bf(lo) | (f2bf(hi) << 16); }
__device__ __forceinline__ float bf2f(unsigned h) { return __uint_as_float(h << 16); }
__device__ __forceinline__ float wave_sum(float v) {
#pragma unroll
    for (int o = 1; o < 64; o <<= 1) v += __shfl_xor(v, o);
    return v;
}
__device__ __forceinline__ float siluf(float x) { return x / (1.f + expf(-x)); }
__device__ __forceinline__ float gelu_tanh(float x) { return 0.5f * x * (1.f + tanhf(0.7978845608028654f * (x + 0.044715f * x * x * x))); }
__device__ __forceinline__ int mod_row(int row) { return ((row % RB) < SEQ) ? row / RB : 8; }
__device__ __forceinline__ bool is_ctx_row(int row) { return (row % RB) >= SEQ; }

constexpr size_t al256(size_t x) { return (x + 255) & ~(size_t)255; }
constexpr size_t WS_ZERO = 0, ZERO_BYTES = 2u << 20;
constexpr size_t Z_GCNT = 0;
constexpr size_t Z_SS2 = 4096;
constexpr size_t WS_MOD = ZERO_BYTES;
constexpr size_t WS_WRT = WS_MOD + al256((size_t)2 * 9 * 6144 * 4);
constexpr size_t WS_TOKE = WS_WRT + al256((size_t)2 * 36 * 1024 * 4);
constexpr size_t WS_TOKP = WS_TOKE + al256((size_t)NSLOT * 4);
constexpr size_t WS_TOKC = WS_TOKP + al256((size_t)NSLOT * 4);
constexpr size_t WS_TOKS = WS_TOKC + al256((size_t)NSLOT * 4);
constexpr size_t WS_TILE = WS_TOKS + al256((size_t)NSLOT * 4);
constexpr size_t WS_XC = WS_TILE + al256((size_t)(MT_MAX + 64) * 4);
constexpr size_t WS_WIN = WS_XC + al256((size_t)NB * CL * D * 4);
constexpr size_t WS_WOUT = WS_WIN + al256((size_t)2 * INW * D * 2);
constexpr size_t WS_HB = WS_WOUT + al256((size_t)2 * D * D * 2);
constexpr size_t WS_R = WS_HB + al256((size_t)M * D * 2);
constexpr size_t R_PB = 0;
constexpr size_t R_HS = R_PB + al256((size_t)M * INW * 2);
constexpr size_t R_OF = R_HS + al256((size_t)M * D * 2);
constexpr size_t R_OB = R_OF + al256((size_t)M * 512 * 2);
constexpr size_t R_VN = R_OB + al256((size_t)M * 512 * 2);
constexpr size_t R_MIX_END = R_VN + al256((size_t)M * 512 * 2);
constexpr size_t R_WGU = 0;
constexpr size_t R_WD = R_WGU + al256((size_t)NEXP * 1024 * D * 2);
constexpr size_t R_BUF = R_WD + al256((size_t)NEXP * D * DE * 2);
constexpr size_t R_ACT = R_BUF + al256((size_t)NSLOT_PAD * D * 2);
constexpr size_t R_Y = R_ACT + al256((size_t)NSLOT_PAD * DE * 2);
constexpr size_t R_MOE_END = R_Y + al256((size_t)NSLOT_PAD * D * 2);
constexpr size_t WS_END = WS_R + (R_MIX_END > R_MOE_END ? R_MIX_END : R_MOE_END);
static_assert(R_WD + (size_t)NEXP * D * DE * 2 <= R_HS, "MoE weights must not overlay HS (out_proj reads it while... conversion runs after, but keep clear anyway)");

struct Params { const float* in[23]; float* out; unsigned char* ws; };
enum { I_X = 0, I_C, I_CTX, I_CCTX, I_NORM1, I_NORM2, I_WMOD, I_BMOD, I_WIN, I_LB, I_HGN, I_SGN, I_SGW, I_SGB, I_WOUT, I_WG, I_BG, I_WR, I_BR, I_WGATE, I_WUP, I_WDOWN, I_FN };

__device__ __forceinline__ void transpose_item(const float* W, int K, int N, bf16* WT, int k0, int n0, int rowbase, LAS float* scr, int lane) {
#pragma unroll 8
    for (int i = 0; i < 32; ++i) { const int kk = 2 * i + (lane >> 5); scr[kk * 33 + (lane & 31)] = W[(size_t)(k0 + kk) * N + n0 + (lane & 31)]; }
    asm volatile("s_waitcnt lgkmcnt(0)" ::: "memory");
    const int c = lane & 7;
#pragma unroll
    for (int j = 0; j < 4; ++j) { const int n = (lane >> 3) + 8 * j; const LAS float* s = scr + (8 * c) * 33 + n;
        u32x4 o; o.x = pk2(s[0 * 33], s[1 * 33]); o.y = pk2(s[2 * 33], s[3 * 33]); o.z = pk2(s[4 * 33], s[5 * 33]); o.w = pk2(s[6 * 33], s[7 * 33]);
        *(u32x4*)(WT + (size_t)(rowbase + n) * K + k0 + 8 * c) = o; }
    asm volatile("s_waitcnt lgkmcnt(0)" ::: "memory");
}
__device__ __forceinline__ void norm_mod_row(const float* xr, const float* gain, const float* sh, const float* sc, bf16* orow, int lane) {
    f32x4 v[4]; float ss = 0.f;
#pragma unroll
    for (int j = 0; j < 4; ++j) { v[j] = *(const f32x4*)(xr + 4 * lane + 256 * j); ss += (v[j][0] * v[j][0] + v[j][1] * v[j][1]) + (v[j][2] * v[j][2] + v[j][3] * v[j][3]); }
    const float rs = rsqrtf(wave_sum(ss) * (1.f / D) + EPS);
#pragma unroll
    for (int j = 0; j < 4; ++j) { const int k = 4 * lane + 256 * j; const f32x4 g = *(const f32x4*)(gain + k), s1 = *(const f32x4*)(sc + k), s0 = *(const f32x4*)(sh + k);
        const f32x4 o = v[j] * rs * g * (s1 + 1.f) + s0; u32x2 w; w.x = pk2(o[0], o[1]); w.y = pk2(o[2], o[3]); *(u32x2*)(orow + k) = w; }
}
__device__ __forceinline__ const float* xrow_in(const Params& p, int row) { const int b = row / RB, t = row % RB; return t < SEQ ? p.in[I_X] + ((size_t)b * SEQ + t) * D : p.in[I_CTX] + ((size_t)b * CL + (t - SEQ)) * D; }
__device__ __forceinline__ float* xrow_cur(const Params& p, int row) { const int b = row / RB, t = row % RB; return t < SEQ ? p.out + ((size_t)b * SEQ + t) * D : (float*)(p.ws + WS_XC) + ((size_t)b * CL + (t - SEQ)) * D; }

__device__ __forceinline__ void ph_prologue(const Params& p, LAS unsigned char* lds, int tid, int lane, int wave, int G) {
    float* MOD = (float*)(p.ws + WS_MOD);
    if (blockIdx.x < 192) {
        const int l = blockIdx.x / 96, col0 = (blockIdx.x % 96) * 64;
        LAS float* sc = (LAS float*)lds; LAS float* red = (LAS float*)(lds + 36864);
        for (int i = tid; i < 9 * 1024; i += NTHREADS) { const int r = i >> 10, k = i & 1023; sc[i] = siluf(r < 8 ? p.in[I_C][r * 1024 + k] : p.in[I_CCTX][k]); }
        __syncthreads();
        const int c4 = tid & 15, kg = tid >> 4;
        f32x4 acc[9];
#pragma unroll
        for (int r = 0; r < 9; ++r) acc[r] = (f32x4){0.f, 0.f, 0.f, 0.f};
        const float* w = p.in[I_WMOD] + (size_t)l * 1024 * 6144 + col0 + 4 * c4;
        for (int k = kg; k < 1024; k += 32) { const f32x4 wv = *(const f32x4*)(w + (size_t)k * 6144);
#pragma unroll
            for (int r = 0; r < 9; ++r) acc[r] += wv * sc[r * 1024 + k]; }
#pragma unroll
        for (int r = 0; r < 9; ++r) *(LAS f32x4*)&red[(kg * 9 + r) * 64 + 4 * c4] = acc[r];
        __syncthreads();
        for (int i = tid; i < 576; i += NTHREADS) { const int r = i >> 6, cc = i & 63; float s = 0.f;
            for (int g = 0; g < 32; ++g) s += red[(g * 9 + r) * 64 + cc];
            MOD[(size_t)(l * 9 + r) * 6144 + col0 + cc] = s + p.in[I_BMOD][l * 6144 + col0 + cc]; }
        __syncthreads();
    }
    {
        float* WRT = (float*)(p.ws + WS_WRT);
        for (int i = blockIdx.x * NTHREADS + tid; i < 2 * 36 * 1024; i += G * NTHREADS) { const int l = i / (36 * 1024), o = (i / 1024) % 36, k = i & 1023;
            WRT[i] = o < 4 ? p.in[I_WG][((size_t)l * 1024 + k) * 4 + o] : p.in[I_WR][((size_t)l * 1024 + k) * 32 + (o - 4)]; }
    }
    LAS float* scr = (LAS float*)(lds + wave * 16384);
    const int gw = blockIdx.x * NWAVES + wave, NGW = G * NWAVES;
    constexpr int I_IN = (D / 64) * (INW / 32), I_OUT = (D / 64) * (D / 32);
    for (int it = gw; it < 2 * (I_IN + I_OUT); it += NGW) {
        const int l = it / (I_IN + I_OUT); int r = it % (I_IN + I_OUT);
        if (r < I_IN) { const int nblk = INW / 32, kb = r / nblk, nb = r % nblk; transpose_item(p.in[I_WIN] + (size_t)l * D * INW, D, INW, (bf16*)(p.ws + WS_WIN) + (size_t)l * INW * D, 64 * kb, 32 * nb, 32 * nb, scr, lane); }
        else { r -= I_IN; const int nblk = D / 32, kb = r / nblk, nb = r % nblk; transpose_item(p.in[I_WOUT] + (size_t)l * D * D, D, D, (bf16*)(p.ws + WS_WOUT) + (size_t)l * D * D, 64 * kb, 32 * nb, 32 * nb, scr, lane); }
    }
}
__device__ __forceinline__ void ph_h1_first(const Params& p, int lane, int wave, int G) {
    const float* MOD = (const float*)(p.ws + WS_MOD); bf16* HB = (bf16*)(p.ws + WS_HB);
    for (int row = blockIdx.x * NWAVES + wave; row < M; row += G * NWAVES) { const float* mr = MOD + (size_t)mod_row(row) * 6144;
        norm_mod_row(xrow_in(p, row), p.in[I_NORM1], mr, mr + 1024, HB + (size_t)row * D, lane); }
}
__device__ __forceinline__ void ph_moe_wconv(const Params& p, int l, LAS unsigned char* lds, int lane, int wave, int G) {
    LAS float* scr = (LAS float*)(lds + wave * 16384);
    bf16* WGU = (bf16*)(p.ws + WS_R + R_WGU); bf16* WD = (bf16*)(p.ws + WS_R + R_WD);
    constexpr int I_G = (D / 64) * (DE / 32)  , I_D = (DE / 64) * (D / 32)  , PER_E = 2 * I_G + I_D;
    for (int it = blockIdx.x * NWAVES + wave; it < NEXP * PER_E; it += G * NWAVES) {
        const int e = it / PER_E; int r = it % PER_E;
        if (r < 2 * I_G) { const int isup = r >= I_G; r -= isup * I_G; const int nblk = DE / 32, kb = r / nblk, nb = r % nblk, n0 = 32 * nb;
            const float* W = p.in[isup ? I_WUP : I_WGATE] + ((size_t)l * NEXP + e) * D * DE;
            transpose_item(W, D, DE, WGU + (size_t)e * 1024 * D, 64 * kb, n0, 256 * (n0 >> 7) + 128 * isup + (n0 & 127), scr, lane); }
        else { r -= 2 * I_G; const int nblk = D / 32, kb = r / nblk, nb = r % nblk;
            transpose_item(p.in[I_WDOWN] + ((size_t)l * NEXP + e) * DE * D, DE, D, WD + (size_t)e * D * DE, 64 * kb, 32 * nb, 32 * nb, scr, lane); }
    }
}
__device__ __forceinline__ void ph_router(const Params& p, int l, int last, LAS unsigned char* lds, int tid, int lane, int wave, int G) {
    LAS float* W = (LAS float*)lds; LAS int* hist = (LAS int*)(lds + 147456); LAS int* base = hist + 32; LAS int* sinfo = base + 32 + wave * 40;
    const float* WRT = (const float*)(p.ws + WS_WRT) + (size_t)l * 36 * 1024;
    for (int i = tid; i < 36 * 256; i += NTHREADS) ((LAS f32x4*)W)[i] = ((const f32x4*)WRT)[i];
    if (tid < 32) hist[tid] = 0;
    __syncthreads();
    const float* MOD = (const float*)(p.ws + WS_MOD) + (size_t)l * 9 * 6144; const float* SS2 = (const float*)(p.ws + WS_ZERO + Z_SS2) + (size_t)l * M;
    bf16* HB = (bf16*)(p.ws + WS_HB); int* TOKE = (int*)(p.ws + WS_TOKE); float* TOKC = (float*)(p.ws + WS_TOKC); int* TOKP = (int*)(p.ws + WS_TOKP);
    int* gcnt = (int*)(p.ws + WS_ZERO + Z_GCNT) + l * 64;
    const float* gain = p.in[I_NORM2] + l * D; const float* bg = p.in[I_BG] + l * 4; const float* br = p.in[I_BR] + l * 32;
    int nloc = 0;
    for (int row = blockIdx.x * NWAVES + wave; row < M; row += G * NWAVES) {
        if (last && is_ctx_row(row)) continue;
        const float* xr = xrow_cur(p, row); const float* mr = MOD + (size_t)mod_row(row) * 6144;
        const float rs = rsqrtf(SS2[row] * (1.f / D) + EPS);
        f32x4 h[4];
#pragma unroll
        for (int j = 0; j < 4; ++j) { const int k = 4 * lane + 256 * j; const f32x4 v = *(const f32x4*)(xr + k), g = *(const f32x4*)(gain + k), s1 = *(const f32x4*)(mr + 4 * 1024 + k), s0 = *(const f32x4*)(mr + 3 * 1024 + k);
            h[j] = v * rs * g * (s1 + 1.f) + s0; u32x2 w; w.x = pk2(h[j][0], h[j][1]); w.y = pk2(h[j][2], h[j][3]); *(u32x2*)(HB + (size_t)row * D + k) = w; }
        float lg[36];
#pragma unroll
        for (int o = 0; o < 36; ++o) { float a = 0.f;
#pragma unroll
            for (int j = 0; j < 4; ++j) { const f32x4 wv = *(const LAS f32x4*)&W[o * 1024 + 4 * lane + 256 * j]; a += (h[j][0] * wv[0] + h[j][1] * wv[1]) + (h[j][2] * wv[2] + h[j][3] * wv[3]); }
            lg[o] = wave_sum(a) + (o < 4 ? bg[o] : br[o - 4]); }
        int gs = 0; float gmax = lg[0];
#pragma unroll
        for (int o = 1; o < 4; ++o) if (lg[o] > gmax) { gmax = lg[o]; gs = o; }
        float den = 0.f;
#pragma unroll
        for (int o = 0; o < 4; ++o) den += expf(lg[o] - gmax);
        const float psel = 1.f / den;
        float li[8];
#pragma unroll
        for (int j = 0; j < 8; ++j) li[j] = gs == 0 ? lg[4 + j] : gs == 1 ? lg[12 + j] : gs == 2 ? lg[20 + j] : lg[28 + j];
        int i0 = 0; float m0 = li[0];
#pragma unroll
        for (int j = 1; j < 8; ++j) if (li[j] > m0) { m0 = li[j]; i0 = j; }
        int i1 = 0; float m1 = -3.0e38f;
#pragma unroll
        for (int j = 0; j < 8; ++j) if (j != i0 && li[j] > m1) { m1 = li[j]; i1 = j; }
        const float e1 = expf(m1 - m0);
        if (lane < 2) { const int e = gs * 8 + (lane ? i1 : i0); const float c = lane ? psel * e1 / (1.f + e1) : psel / (1.f + e1);
            const int lp = __hip_atomic_fetch_add(&hist[e], 1, __ATOMIC_RELAXED, __HIP_MEMORY_SCOPE_WORKGROUP); TOKE[row * 2 + lane] = e; TOKC[row * 2 + lane] = c; sinfo[nloc * 2 + lane] = (e << 16) | lp; }
        ++nloc;
    }
    __syncthreads();
    if (tid < 32) base[tid] = atomicAdd(&gcnt[tid], hist[tid]);
    __syncthreads();
    nloc = 0;
    for (int row = blockIdx.x * NWAVES + wave; row < M; row += G * NWAVES) {
        if (last && is_ctx_row(row)) continue;
        if (lane < 2) { const int info = sinfo[nloc * 2 + lane]; TOKP[row * 2 + lane] = base[info >> 16] + (info & 0xffff); }
        ++nloc;
    }
}
__device__ __forceinline__ void ph_place(const Params& p, int l, int last, LAS unsigned char* lds, int tid, int lane, int wave, int G) {
    LAS int* ps = (LAS int*)lds;
    const int* gcnt = (const int*)(p.ws + WS_ZERO + Z_GCNT) + l * 64; int* TILE = (int*)(p.ws + WS_TILE);
    if (tid == 0) { int s = 0; for (int e = 0; e < NEXP; ++e) { ps[e] = s; s += (gcnt[e] + 255) / 256 * 256; } ps[32] = s; }
    __syncthreads();
    if (blockIdx.x == 0 && tid < 32) { for (int t = ps[tid] / 256; t < ps[tid + 1] / 256; ++t) TILE[t] = tid; if (tid == 0) TILE[MT_MAX] = ps[32] / 256; }
    const bf16* HB = (const bf16*)(p.ws + WS_HB); bf16* BUF = (bf16*)(p.ws + WS_R + R_BUF);
    const int* TOKE = (const int*)(p.ws + WS_TOKE); const int* TOKP = (const int*)(p.ws + WS_TOKP); int* TOKS = (int*)(p.ws + WS_TOKS);
    for (int row = blockIdx.x * NWAVES + wave; row < M; row += G * NWAVES) {
        if (last && is_ctx_row(row)) continue;
        const int s0 = ps[TOKE[row * 2]] + TOKP[row * 2], s1 = ps[TOKE[row * 2 + 1]] + TOKP[row * 2 + 1];
        const u32x4 a = ((const u32x4*)(HB + (size_t)row * D))[lane], b = ((const u32x4*)(HB + (size_t)row * D))[lane + 64];
        ((u32x4*)(BUF + (size_t)s0 * D))[lane] = a; ((u32x4*)(BUF + (size_t)s0 * D))[lane + 64] = b;
        ((u32x4*)(BUF + (size_t)s1 * D))[lane] = a; ((u32x4*)(BUF + (size_t)s1 * D))[lane + 64] = b;
        if (lane == 0) { TOKS[row * 2] = s0; TOKS[row * 2 + 1] = s1; }
    }
}
__device__ __forceinline__ void ph_combine(const Params& p, int l, int last, int lane, int wave, int G) {
    const float* MOD = (const float*)(p.ws + WS_MOD); const bf16* Y = (const bf16*)(p.ws + WS_R + R_Y); bf16* HB = (bf16*)(p.ws + WS_HB);
    const int* TOKS = (const int*)(p.ws + WS_TOKS); const float* TOKC = (const float*)(p.ws + WS_TOKC);
    for (int row = blockIdx.x * NWAVES + wave; row < M; row += G * NWAVES) {
        if (last && is_ctx_row(row)) continue;
        float* xr = xrow_cur(p, row); const int mrow = mod_row(row); const float* g2 = MOD + ((size_t)l * 9 + mrow) * 6144 + 5 * 1024;
        const int s0 = TOKS[row * 2], s1 = TOKS[row * 2 + 1]; const float c0 = TOKC[row * 2], c1 = TOKC[row * 2 + 1];
        f32x4 v[4]; float ss = 0.f;
#pragma unroll
        for (int j = 0; j < 4; ++j) { const int k = 4 * lane + 256 * j; const f32x4 x = *(const f32x4*)(xr + k), g = *(const f32x4*)(g2 + k);
            const u32x2 y0 = *(const u32x2*)(Y + (size_t)s0 * D + k), y1 = *(const u32x2*)(Y + (size_t)s1 * D + k);
            f32x4 f; f[0] = c0 * bf2f(y0.x & 0xffffu) + c1 * bf2f(y1.x & 0xffffu); f[1] = c0 * bf2f(y0.x >> 16) + c1 * bf2f(y1.x >> 16);
            f[2] = c0 * bf2f(y0.y & 0xffffu) + c1 * bf2f(y1.y & 0xffffu); f[3] = c0 * bf2f(y0.y >> 16) + c1 * bf2f(y1.y >> 16);
            v[j] = x + g * f; ss += (v[j][0] * v[j][0] + v[j][1] * v[j][1]) + (v[j][2] * v[j][2] + v[j][3] * v[j][3]); }
        const float rs = rsqrtf(wave_sum(ss) * (1.f / D) + EPS);
        if (!last) { const float* mr = MOD + ((size_t)(l + 1) * 9 + mrow) * 6144; const float* gain = p.in[I_NORM1] + (l + 1) * D;
#pragma unroll
            for (int j = 0; j < 4; ++j) { const int k = 4 * lane + 256 * j; *(f32x4*)(xr + k) = v[j];
                const f32x4 g = *(const f32x4*)(gain + k), s1v = *(const f32x4*)(mr + 1024 + k), s0v = *(const f32x4*)(mr + k);
                const f32x4 o = v[j] * rs * g * (s1v + 1.f) + s0v; u32x2 w; w.x = pk2(o[0], o[1]); w.y = pk2(o[2], o[3]); *(u32x2*)(HB + (size_t)row * D + k) = w; } }
        else {
#pragma unroll
            for (int j = 0; j < 4; ++j) { const int k = 4 * lane + 256 * j; const f32x4 g = *(const f32x4*)(p.in[I_FN] + k); *(f32x4*)(xr + k) = v[j] * rs * g; } }
    }
}
__device__ __forceinline__ float ldbf(const bf16* p) { return __uint_as_float((unsigned)(*p) << 16); }
__device__ __forceinline__ void ph_naive_scan(const Params& p, int l, LAS unsigned char* lds, int tid, int G) {
    const bf16* PB = (const bf16*)(p.ws + WS_R + R_PB);
    const int grp = tid >> 7, e = tid & 127, item = blockIdx.x * 4 + grp;
    if (blockIdx.x < 16) {
        const int h = item & 3, dir = (item >> 2) & 1, b = item >> 3;
        LAS float* sf = (LAS float*)lds + grp * 768; LAS float* sk = sf + 256; LAS float* sq = sf + 512;
        float lb = 0.f;
        { const int c = dir * 512 + h * 128 + e; if (l == 1) { const float a = p.in[I_LB][c], bb = p.in[I_LB][1024 + c]; lb = 1.f / (1.f + expf(a - bb)); } }
        bf16* O = (bf16*)(p.ws + WS_R + (dir ? R_OB : R_OF));
        float S[128];
#pragma unroll
        for (int d = 0; d < 128; ++d) S[d] = 0.f;
        int it = 0;
        for (int seg = 0; seg < 2; ++seg) {
            const int n = seg == 0 ? CL : SEQ, base = b * RB + (seg == 0 ? SEQ : 0);
            for (int s = 0; s < n; ++s, ++it) {
                const int row = base + (dir ? n - 1 - s : s), pb = (it & 1) * 128;
                const bf16* pr = PB + (size_t)row * INW;
                { const float q = ldbf(pr + h * 128 + e), z = ldbf(pr + 512 + dir * 512 + h * 128 + e);
                  const float sig = 1.f / (1.f + expf(-z)), sgn = 1.f / (1.f + expf(z));
                  sf[pb + e] = lb + (1.f - lb) * sig; sk[pb + e] = (1.f - lb) * sgn; sq[pb + e] = q; }
                const float v = ldbf(pr + 1536 + h * 128 + e);
                __syncthreads();
                float o = 0.f;
#pragma unroll
                for (int d = 0; d < 128; ++d) { S[d] = sf[pb + d] * S[d] + sk[pb + d] * v; o += sq[pb + d] * S[d]; }
                O[(size_t)row * 512 + h * 128 + e] = (bf16)f2bf(o);
            }
        }
    } else {
        const float* gain = p.in[I_SGN] + l * 512; bf16* VN = (bf16*)(p.ws + WS_R + R_VN); const int lane = tid & 63;
        for (int row = (blockIdx.x - 16) * NWAVES + (tid >> 6); row < M; row += (G - 16) * NWAVES) {
            float v[8], ss = 0.f;
#pragma unroll
            for (int j = 0; j < 8; ++j) { v[j] = gelu_tanh(ldbf(PB + (size_t)row * INW + 3072 + lane + 64 * j)); ss += v[j] * v[j]; }
            ss = wave_sum(ss);
            const float r = rsqrtf(ss * (1.f / 512.f) + EPS);
#pragma unroll
            for (int j = 0; j < 8; ++j) { const int c = lane + 64 * j; VN[(size_t)row * 512 + c] = (bf16)f2bf(v[j] * r * gain[c]); }
        }
    }
}
__device__ __forceinline__ void ph_naive_mix(const Params& p, int l, int tid, int G) {
    const bf16* PB = (const bf16*)(p.ws + WS_R + R_PB); const bf16* OF = (const bf16*)(p.ws + WS_R + R_OF); const bf16* OB = (const bf16*)(p.ws + WS_R + R_OB);
    const bf16* VN = (const bf16*)(p.ws + WS_R + R_VN); bf16* HS = (bf16*)(p.ws + WS_R + R_HS);
    const float* gain = p.in[I_HGN] + l * 512; const float* Ws = p.in[I_SGW] + (size_t)l * 4 * 128 * 128; const float* bs = p.in[I_SGB] + l * 512;
    const int lane = tid & 63;
    for (int w = blockIdx.x * NWAVES + (tid >> 6); w < M * 4; w += G * NWAVES) { const int row = w >> 2, h = w & 3;
        float o[2], ss = 0.f;
#pragma unroll
        for (int j = 0; j < 2; ++j) { const int c = h * 128 + lane + 64 * j; o[j] = ldbf(OF + (size_t)row * 512 + c) + ldbf(OB + (size_t)row * 512 + c); ss += o[j] * o[j]; }
        ss = wave_sum(ss);
        const float r = rsqrtf(ss * (1.f / 128.f) + EPS);
#pragma unroll
        for (int j = 0; j < 2; ++j) { const int c = h * 128 + lane + 64 * j; HS[(size_t)row * D + c] = (bf16)f2bf(o[j] * r * gain[c] * siluf(ldbf(PB + (size_t)row * INW + 2048 + c))); }
    }
    for (int it = blockIdx.x * 2 + (tid >> 8); it < (M / 128) * 4; it += G * 2) { const int chunk = it >> 2, h = it & 3, t = tid & 255, ch = t & 127, ih = t >> 7;
        for (int i = ih * 64; i < ih * 64 + 64; ++i) {
            float acc = bs[h * 128 + i];
            const float* w = Ws + ((size_t)h * 128 + i) * 128;
            for (int j = 0; j < 128; ++j) acc += w[j] * ldbf(VN + (size_t)(chunk * 128 + j) * 512 + h * 128 + ch);
            const int row = chunk * 128 + i;
            HS[(size_t)row * D + 512 + h * 128 + ch] = (bf16)f2bf(gelu_tanh(ldbf(PB + (size_t)row * INW + 2560 + h * 128 + ch)) * acc);
        }
    }
}
constexpr int PH_PRO = 0, PH_H1 = 1, PH_L0 = 2, PH_PER_LAYER = 10, PH_END = PH_L0 + 2 * PH_PER_LAYER;
__device__ __forceinline__ void* launder_ptr(void* q) { unsigned long long v = (unsigned long long)q; asm volatile("" : "+s"(v)); return (void*)v; }
__global__ void __launch_bounds__(NTHREADS, 2) mk(Params p, int ph_lo, int ph_hi) {
    extern __shared__ __attribute__((aligned(16))) unsigned char lds_raw[];
    LAS unsigned char* lds = (LAS unsigned char*)lds_raw;
    const int G = gridDim.x;
    cg::grid_group grid = cg::this_grid();
    for (int ph = ph_lo; ph < ph_hi; ++ph) {
        int tid = threadIdx.x; asm volatile("" : "+v"(tid));
        p.ws = (unsigned char*)launder_ptr(p.ws);
        const int lane = tid & 63, wave = __builtin_amdgcn_readfirstlane(tid >> 6);
        if (ph == PH_PRO) ph_prologue(p, lds, tid, lane, wave, G);
        else if (ph == PH_H1) ph_h1_first(p, lane, wave, G);
        else {
            const int l = (ph - PH_L0) / PH_PER_LAYER, s = (ph - PH_L0) % PH_PER_LAYER, last = l == 1;
            const float* modl = (const float*)(p.ws + WS_MOD) + (size_t)l * 9 * 6144;
            if (s == 0) {
                pg8::Gemm g{(const bf16*)(p.ws + WS_HB), (const bf16*)(p.ws + WS_WIN) + (size_t)l * INW * D, M, INW, D};
                pg8::DenseOrder S; S.init(M / 256, INW / 256, G, (int)blockIdx.x, 0);
                pg8::EpiStoreBf16 E{(bf16*)(p.ws + WS_R + R_PB), INW};
                pg8::gemm_phase<pg8::EpiStoreBf16, pg8::DenseOrder, true, true>(lds, g, S, E, tid);
            } else if (s == 1) ph_naive_scan(p, l, lds, tid, G);
            else if (s == 2) ph_naive_mix(p, l, tid, G);
            else if (s == 3) {
                pg8::Gemm g{(const bf16*)(p.ws + WS_R + R_HS), (const bf16*)(p.ws + WS_WOUT) + (size_t)l * D * D, M, D, D};
                pg8::DenseOrder S; S.init(last ? NB * 16 : M / 256, D / 256, G, (int)blockIdx.x, last);
                pg8::EpiResid E{l == 0 ? p.in[I_X] : p.out, l == 0 ? p.in[I_CTX] : (const float*)(p.ws + WS_XC), p.out, (float*)(p.ws + WS_XC), modl, (float*)(p.ws + WS_ZERO + Z_SS2) + (size_t)l * M};
                pg8::gemm_phase<pg8::EpiResid, pg8::DenseOrder, true, true>(lds, g, S, E, tid);
            } else if (s == 4) ph_moe_wconv(p, l, lds, lane, wave, G);
            else if (s == 5) ph_router(p, l, last, lds, tid, lane, wave, G);
            else if (s == 6) ph_place(p, l, last, lds, tid, lane, wave, G);
            else if (s == 7) {
                const int* TILE = (const int*)(p.ws + WS_TILE); const int nt = __builtin_amdgcn_readfirstlane(TILE[MT_MAX]);
                pg8::Gemm g{(const bf16*)(p.ws + WS_R + R_BUF), (const bf16*)(p.ws + WS_R + R_WGU), NSLOT_PAD, 1024, D};
                pg8::MoeOrder S; S.init(TILE, nt, 4, G, (int)blockIdx.x, 4);
                pg8::EpiSwiglu E{(bf16*)(p.ws + WS_R + R_ACT)};
                pg8::gemm_phase<pg8::EpiSwiglu, pg8::MoeOrder, true, true>(lds, g, S, E, tid);
            } else if (s == 8) {
                const int* TILE = (const int*)(p.ws + WS_TILE); const int nt = __builtin_amdgcn_readfirstlane(TILE[MT_MAX]);
                pg8::Gemm g{(const bf16*)(p.ws + WS_R + R_ACT), (const bf16*)(p.ws + WS_R + R_WD), NSLOT_PAD, D, DE};
                pg8::MoeOrder S; S.init(TILE, nt, 4, G, (int)blockIdx.x, 4);
                pg8::EpiStoreBf16 E{(bf16*)(p.ws + WS_R + R_Y), D};
                pg8::gemm_phase<pg8::EpiStoreBf16, pg8::MoeOrder, true, true>(lds, g, S, E, tid);
            } else ph_combine(p, l, last, lane, wave, G);
        }
        if (ph + 1 < ph_hi) grid.sync();
    }
}

extern "C" void kernel_launch(void* const* d_in, const int* in_sizes, int n_in, void* d_out, int out_size, void* d_ws, size_t ws_size, hipStream_t stream) {
    static int grid = 0;
    if (grid == 0) {
        if (n_in != 23 || ws_size < WS_END) { fprintf(stderr, "kernel_launch: n_in %d ws %zu need %zu\n", n_in, ws_size, (size_t)WS_END); grid = -1; return; }
        int dev = 0, cus = 0, per_cu = 0;
        hipGetDevice(&dev); hipDeviceGetAttribute(&cus, hipDeviceAttributeMultiprocessorCount, dev);
        hipFuncSetAttribute((const void*)mk, hipFuncAttributeMaxDynamicSharedMemorySize, LDS_BYTES);
        hipOccupancyMaxActiveBlocksPerMultiprocessor(&per_cu, (const void*)mk, NTHREADS, LDS_BYTES);
        (void)hipGetLastError();
        grid = cus * (per_cu >= 1 ? 1 : 0);
        if (grid <= 0) { fprintf(stderr, "kernel_launch: occupancy %d cus %d\n", per_cu, cus); grid = -1; return; }
    }
    if (grid < 0) return;
    hipMemsetAsync((char*)d_ws + WS_ZERO, 0, ZERO_BYTES, stream);
    Params p{};
    for (int i = 0; i < 23; ++i) p.in[i] = (const float*)d_in[i];
    p.out = (float*)d_out; p.ws = (unsigned char*)d_ws;
    int lo = 0, hi = PH_END;
    void* args[] = {&p, &lo, &hi};
    hipError_t e = hipLaunchCooperativeKernel((const void*)mk, dim3(grid), dim3(NTHREADS), args, LDS_BYTES, stream);
    if (e != hipSuccess) fprintf(stderr, "cooperative launch failed: %s (grid %d)\n", hipGetErrorString(e), grid);
}
```

```cpp
#include <hip/hip_runtime.h>
#include <hip/hip_cooperative_groups.h>
#include <cstdio>
#include <cstdint>
namespace cg = cooperative_groups;

constexpr int D = 1024, NB = 8, SEQ = 4096, CL = 256, RB = SEQ + CL  , M = NB * RB  ;
constexpr int INW = 3584, NEXP = 32, DE = 512, NSLOT = M * 2, NSLOT_PAD = NSLOT + NEXP * 256, MT_MAX = NSLOT_PAD / 256;
constexpr float EPS = 1e-6f;

namespace pg8 {
#define PG8_LAS __attribute__((address_space(3)))
typedef unsigned short bf16_t;
typedef short bf16x8 __attribute__((ext_vector_type(8)));
typedef float f32x4 __attribute__((ext_vector_type(4)));
typedef unsigned u32x4 __attribute__((ext_vector_type(4)));
constexpr int BM = 256, BK = 64, HALF = 128, HTB = HALF * BK * 2  , STAGE_BYTES = 8 * HTB, NXCD = 8, WGM = 8;

__host__ __device__ __forceinline__ int lds_byte(int r, int c) { const int st = (r >> 4) * 2 + (c >> 5), rr = r & 15, cc = c & 31, ob = rr * 64 + cc * 2; return st * 1024 + (ob ^ (((ob >> 9) & 1) << 5)); }
__host__ __device__ __forceinline__ void stage_rc(int b, int& R, int& C) { const int st = b / 1024, sb = b % 1024, swz = sb ^ (((sb >> 9) & 1) << 5); R = (st >> 1) * 16 + swz / 64; C = (st & 1) * 32 + (swz % 64) / 2; }
__host__ __device__ __forceinline__ int perm32(int rho) { const int n = rho >> 4, i = rho & 15; return 8 * (i >> 2) + 4 * n + (i & 3); }

struct Unit { int pm, pn, pb; };
struct Gemm { const bf16_t* A; const bf16_t* Bt; int M, N, K; };

struct StaticOrder {
    int nM, nN, nwg, G, c;
    __host__ __device__ void init(int M, int N, int G_, int c_) { nM = M / BM; nN = N / BM; nwg = nM * nN; G = G_; c = c_; }
    __host__ __device__ bool next(int i, Unit& u) const {
        const long L = (long)i * G + c; if (L >= nwg) return false;
        int wgid = (int)L; { const int q = nwg / NXCD, r = nwg % NXCD, xcd = wgid % NXCD, off = wgid / NXCD; wgid = (xcd < r ? xcd * (q + 1) : r * (q + 1) + (xcd - r) * q) + off; }
        const int nig = WGM * nN, gid = wgid / nig, fm = gid * WGM, gsz = (nM - fm) < WGM ? (nM - fm) : WGM;
        u.pm = fm + ((wgid % nig) % gsz); u.pn = (wgid % nig) / gsz; u.pb = u.pn; return true;
    }
    __device__ __forceinline__ void a_ready(const Unit&) const {}
    __device__ __forceinline__ void done(const Unit&) const {}
};

__device__ __forceinline__ unsigned cvt_pk_bf16(float lo, float hi) { unsigned r; asm volatile("v_cvt_pk_bf16_f32 %0, %1, %2" : "=v"(r) : "v"(lo), "v"(hi)); return r; }
typedef float f32x2 __attribute__((ext_vector_type(2)));
struct DenseOrder {
    int nM, nN, nwg, G, c, lat_only;
    __device__ void init(int nM_, int nN_, int G_, int c_, int lat_only_) { nM = nM_; nN = nN_; nwg = nM * nN; G = G_; c = c_; lat_only = lat_only_; }
    __device__ bool next(int i, Unit& u) const {
        const long L = (long)i * G + c; if (L >= nwg) return false;
        int wgid = (int)L; { const int q = nwg / NXCD, r = nwg % NXCD, xcd = wgid % NXCD, off = wgid / NXCD; wgid = (xcd < r ? xcd * (q + 1) : r * (q + 1) + (xcd - r) * q) + off; }
        const int nig = WGM * nN, gid = wgid / nig, fm = gid * WGM, gsz = (nM - fm) < WGM ? (nM - fm) : WGM;
        int pm = fm + ((wgid % nig) % gsz); u.pn = (wgid % nig) / gsz; u.pb = u.pn;
        if (lat_only) pm = (pm >> 4) * 17 + (pm & 15);
        u.pm = pm; return true;
    }
    __device__ __forceinline__ void a_ready(const Unit&) const {}
    __device__ __forceinline__ void done(const Unit&) const {}
};
struct MoeOrder {
    const int* tile_e; int nM, nN, nwg, G, c, nbt;
    __device__ void init(const int* te, int nM_, int nN_, int G_, int c_, int nbt_) { tile_e = te; nM = nM_; nN = nN_; nwg = nM * nN; G = G_; c = c_; nbt = nbt_; }
    __device__ bool next(int i, Unit& u) const {
        const long L = (long)i * G + c; if (L >= nwg) return false;
        int wgid = (int)L; { const int q = nwg / NXCD, r = nwg % NXCD, xcd = wgid % NXCD, off = wgid / NXCD; wgid = (xcd < r ? xcd * (q + 1) : r * (q + 1) + (xcd - r) * q) + off; }
        const int nig = WGM * nN, gid = wgid / nig, fm = gid * WGM, gsz = (nM - fm) < WGM ? (nM - fm) : WGM;
        u.pm = fm + ((wgid % nig) % gsz); u.pn = (wgid % nig) / gsz;
        u.pb = __builtin_amdgcn_readfirstlane(tile_e[u.pm]) * nbt + u.pn; return true;
    }
    __device__ __forceinline__ void a_ready(const Unit&) const {}
    __device__ __forceinline__ void done(const Unit&) const {}
};

__device__ __forceinline__ float fast_silu(float x) { return x * __builtin_amdgcn_rcpf(1.f + __expf(-x)); }
struct EpiStoreBf16 {
    static constexpr bool PERM = true, AFTER_DRAIN = false;
    bf16_t* O; int ldc;
    __device__ __forceinline__ void operator()(const f32x4 (&acc)[2][2][4][2], const Unit& u, int wr, int wc, int fr, int fq) const {
        const int row0 = u.pm * BM + wr * 64 + fr, col0 = u.pn * BM + wc * 32 + 8 * fq;
#pragma unroll
        for (int ai = 0; ai < 2; ++ai)
#pragma unroll
            for (int m = 0; m < 4; ++m) { bf16_t* rowp = O + (size_t)(row0 + ai * HALF + m * 16) * ldc + col0;
#pragma unroll
                for (int bj = 0; bj < 2; ++bj) { const f32x4 v0 = acc[ai][bj][m][0], v1 = acc[ai][bj][m][1];
                    u32x4 w; w.x = cvt_pk_bf16(v0[0], v0[1]); w.y = cvt_pk_bf16(v0[2], v0[3]); w.z = cvt_pk_bf16(v1[0], v1[1]); w.w = cvt_pk_bf16(v1[2], v1[3]);
                    *(u32x4*)(rowp + bj * HALF) = w; } }
    }
};
struct EpiSwiglu {
    static constexpr bool PERM = true, AFTER_DRAIN = false;
    bf16_t* ACT;
    __device__ __forceinline__ void operator()(const f32x4 (&acc)[2][2][4][2], const Unit& u, int wr, int wc, int fr, int fq) const {
        const int row0 = u.pm * BM + wr * 64 + fr, col0 = u.pn * HALF + wc * 32 + 8 * fq;
#pragma unroll
        for (int ai = 0; ai < 2; ++ai)
#pragma unroll
            for (int m = 0; m < 4; ++m) { bf16_t* rowp = ACT + (size_t)(row0 + ai * HALF + m * 16) * DE + col0;
                const f32x4 g0 = acc[ai][0][m][0], g1 = acc[ai][0][m][1], u0 = acc[ai][1][m][0], u1 = acc[ai][1][m][1];
                u32x4 w; w.x = cvt_pk_bf16(fast_silu(g0[0]) * u0[0], fast_silu(g0[1]) * u0[1]); w.y = cvt_pk_bf16(fast_silu(g0[2]) * u0[2], fast_silu(g0[3]) * u0[3]);
                w.z = cvt_pk_bf16(fast_silu(g1[0]) * u1[0], fast_silu(g1[1]) * u1[1]); w.w = cvt_pk_bf16(fast_silu(g1[2]) * u1[2], fast_silu(g1[3]) * u1[3]);
                *(u32x4*)rowp = w; }
    }
};
__device__ __forceinline__ float fast_sigmoid(float x) { return __builtin_amdgcn_rcpf(1.f + __expf(-x)); }
__device__ __forceinline__ float fast_gelu(float x) { return x * fast_sigmoid(1.5957691216057308f * (x + 0.044715f * x * x * x)); }
__device__ __forceinline__ bf16_t bf16_1(float x) { return (bf16_t)(cvt_pk_bf16(x, 0.f) & 0xffffu); }
struct EpiInProj {
    static constexpr bool PERM = true, AFTER_DRAIN = false;
    bf16_t *QA, *KB, *KDT, *VT, *SG, *GU, *GVT; float *EREF, *DEC, *SSV; const float* LBV; const float* vgain; size_t dstride; int nch;
    __device__ __forceinline__ void operator()(const f32x4 (&acc)[2][2][4][2], const Unit& u, int wr, int wc, int fr, int fq) const {
        if (u.pn < 8) hgrn(acc, u, wr, wc, fr, fq); else if (u.pn < 12) actv(acc, u, wr, wc, fr, fq); else vtile(acc, u, wr, wc, fr, fq);
    }
    __device__ __forceinline__ void hgrn(const f32x4 (&acc)[2][2][4][2], const Unit& u, int wr, int wc, int fr, int fq) const {
        const int dcol = (u.pn >> 1) * 128 + (u.pn & 1) * 64 + 16 * wc + 4 * fq, src15 = (fq << 4) | 15;
        const f32x4 lbf = *(const f32x4*)(LBV + dcol), lbb = *(const f32x4*)(LBV + 512 + dcol);
#pragma unroll
        for (int ai = 0; ai < 2; ++ai) {
            const int rowc = u.pm * BM + ai * HALF + wr * 64, gc = rowc >> 6;
            unsigned pqa[2][4][2], pkb[2][4][2]; float hqa[2][4], hkb[2][4];
#pragma unroll
            for (int e = 0; e < 4; ++e) {
#pragma unroll
                for (int dir = 0; dir < 2; ++dir) {
                    const float lb = dir ? lbb[e] : lbf[e];
                    float lf[4], kk[4], x[4], T[4];
#pragma unroll
                    for (int m = 0; m < 4; ++m) { const float z = dir ? acc[ai][1][m][0][e] : acc[ai][0][m][1][e]; const float sig = fast_sigmoid(z);
                        lf[m] = __logf(lb + (1.f - lb) * sig); kk[m] = (1.f - lb) * (1.f - sig); x[m] = lf[m]; }
#pragma unroll
                    for (int m = 0; m < 4; ++m) {
#pragma unroll
                        for (int o = 1; o < 16; o <<= 1) { const float t = __shfl_up(x[m], o, 16); if (fr >= o) x[m] += t; }
                        T[m] = __shfl(x[m], src15); }
                    const float t01 = T[0] + T[1], tot = t01 + T[2] + T[3];
                    float cum[4] = {x[0], x[1] + T[0], x[2] + t01, x[3] + t01 + T[2]}; float ref = t01;
                    if (dir) {
#pragma unroll
                        for (int m = 0; m < 4; ++m) cum[m] = tot - cum[m] + lf[m];
                        ref = tot - t01; }
#pragma unroll
                    for (int m = 0; m < 4; ++m) { const float q = acc[ai][0][m][0][e];
                        const float qa = q * __expf(cum[m] - ref), kb = kk[m] * __expf(ref - cum[m]), kd = kk[m] * __expf(tot - cum[m]);
                        KDT[dir * dstride + ((size_t)gc * 512 + dcol + e) * 64 + 16 * m + fr] = bf16_1(kd);
                        if (e & 1) { pqa[dir][m][e >> 1] = cvt_pk_bf16(hqa[dir][m], qa); pkb[dir][m][e >> 1] = cvt_pk_bf16(hkb[dir][m], kb); } else { hqa[dir][m] = qa; hkb[dir][m] = kb; } }
                    if (fr == 0) { EREF[((size_t)dir * nch + gc) * 512 + dcol + e] = __expf(ref); DEC[((size_t)dir * nch + gc) * 512 + dcol + e] = __expf(tot); }
                }
#pragma unroll
                for (int m = 0; m < 4; ++m) VT[((size_t)gc * 512 + dcol + e) * 64 + 16 * m + fr] = bf16_1(acc[ai][1][m][1][e]);
            }
#pragma unroll
            for (int dir = 0; dir < 2; ++dir)
#pragma unroll
                for (int m = 0; m < 4; ++m) { const size_t o = dir * dstride + (size_t)(rowc + 16 * m + fr) * 512 + dcol;
                    typedef unsigned u32x2v __attribute__((ext_vector_type(2)));
                    *(u32x2v*)(QA + o) = (u32x2v){pqa[dir][m][0], pqa[dir][m][1]}; *(u32x2v*)(KB + o) = (u32x2v){pkb[dir][m][0], pkb[dir][m][1]}; }
        }
    }
    __device__ __forceinline__ void actv(const f32x4 (&acc)[2][2][4][2], const Unit& u, int wr, int wc, int fr, int fq) const {
        const bool isu = u.pn >= 10; bf16_t* O = isu ? GU : SG;
        const int row0 = u.pm * BM + wr * 64 + fr, col0 = (u.pn & 1) * 256 + wc * 32 + 8 * fq;
#pragma unroll
        for (int ai = 0; ai < 2; ++ai)
#pragma unroll
            for (int m = 0; m < 4; ++m) { bf16_t* rowp = O + (size_t)(row0 + ai * HALF + m * 16) * 512 + col0;
#pragma unroll
                for (int bj = 0; bj < 2; ++bj) { float v[8];
#pragma unroll
                    for (int i = 0; i < 8; ++i) { const float x = acc[ai][bj][m][i >> 2][i & 3]; v[i] = isu ? fast_gelu(x) : x * fast_sigmoid(x); }
                    u32x4 w; w.x = cvt_pk_bf16(v[0], v[1]); w.y = cvt_pk_bf16(v[2], v[3]); w.z = cvt_pk_bf16(v[4], v[5]); w.w = cvt_pk_bf16(v[6], v[7]);
                    *(u32x4*)(rowp + bj * HALF) = w; } }
    }
    __device__ __forceinline__ void vtile(const f32x4 (&acc)[2][2][4][2], const Unit& u, int wr, int wc, int fr, int fq) const {
        const int ch0 = (u.pn & 1) * 256 + wc * 32 + 8 * fq;
        f32x4 gn[2][2];
#pragma unroll
        for (int bj = 0; bj < 2; ++bj)
#pragma unroll
            for (int n = 0; n < 2; ++n) gn[bj][n] = *(const f32x4*)(vgain + ch0 + bj * HALF + 4 * n);
#pragma unroll
        for (int ai = 0; ai < 2; ++ai) { const int gc2 = u.pm * 2 + ai;
#pragma unroll
            for (int m = 0; m < 4; ++m) { const int tok = wr * 64 + 16 * m + fr; float s = 0.f;
#pragma unroll
                for (int bj = 0; bj < 2; ++bj)
#pragma unroll
                    for (int n = 0; n < 2; ++n)
#pragma unroll
                        for (int e = 0; e < 4; ++e) { const float g = fast_gelu(acc[ai][bj][m][n][e]); s += g * g;
                            GVT[((size_t)gc2 * 512 + ch0 + bj * HALF + 4 * n + e) * 128 + tok] = bf16_1(g * gn[bj][n][e]); }
                s += __shfl_xor(s, 16); s += __shfl_xor(s, 32);
                if (fq == 0) atomicAdd(SSV + gc2 * 128 + tok, s); } }
    }
};
struct EpiResid {
    static constexpr bool PERM = false, AFTER_DRAIN = false;
    const float* src_lat; const float* src_ctx; float* dst_lat; float* dst_ctx; const float* modl; float* ss;
    __device__ __forceinline__ void operator()(const f32x4 (&acc)[2][2][4][2], const Unit& u, int wr, int wc, int fr, int fq) const {
        const int b = u.pm / 17, j = u.pm % 17; const bool isctx = j == 16;
        const size_t trow = isctx ? (size_t)b * CL : (size_t)b * SEQ + (size_t)j * 256;
        const float* sb = (isctx ? src_ctx : src_lat) + trow * D; float* db = (isctx ? dst_ctx : dst_lat) + trow * D;
        const float* g1 = modl + (size_t)(isctx ? 8 : b) * 6144 + 2 * 1024;
        const int col0 = u.pn * BM + wc * 32 + 4 * fq;
        f32x4 gv[2][2];
#pragma unroll
        for (int bj = 0; bj < 2; ++bj)
#pragma unroll
            for (int n = 0; n < 2; ++n) gv[bj][n] = *(const f32x4*)(g1 + col0 + bj * HALF + n * 16);
#pragma unroll
        for (int ai = 0; ai < 2; ++ai)
#pragma unroll
            for (int m = 0; m < 4; ++m) { const int rt = ai * HALF + wr * 64 + m * 16 + fr; const size_t off = (size_t)rt * D + col0; float s = 0.f;
#pragma unroll
                for (int bj = 0; bj < 2; ++bj)
#pragma unroll
                    for (int n = 0; n < 2; ++n) { const f32x4 xs = *(const f32x4*)(sb + off + bj * HALF + n * 16); const f32x4 o = xs + gv[bj][n] * acc[ai][bj][m][n];
                        *(f32x4*)(db + off + bj * HALF + n * 16) = o; s += (o[0] * o[0] + o[1] * o[1]) + (o[2] * o[2] + o[3] * o[3]); }
                s += __shfl_xor(s, 16); s += __shfl_xor(s, 32);
                if (fq == 0) atomicAdd(ss + u.pm * BM + rt, s); }
    }
};
template <class Epi, class Sched, bool ALIGN_EPI = false, bool SP2 = false>
__device__ __forceinline__ void gemm_phase(PG8_LAS unsigned char* lds, const Gemm g, const Sched& S, const Epi& E, const int tid_in) {
    const int tid = tid_in, wid = __builtin_amdgcn_readfirstlane(tid >> 6), lane = tid & 63, wr = wid >> 2, wc = wid & 3, fr = lane & 15, fq = lane >> 4;
    const int K = g.K, nt = K / BK;
    unsigned voffA[2], voffB[2];
#pragma unroll
    for (int i = 0; i < 2; ++i) { int R, C; stage_rc(tid * 16 + i * 8192, R, C); const int Rb = Epi::PERM ? ((R & ~31) + perm32(R & 31)) : R;
        voffA[i] = (unsigned)(R * K + C) * 2u; voffB[i] = (unsigned)(Rb * K + C) * 2u; }
    const size_t kstep = (size_t)(BK * 2);
    const size_t hstep = (size_t)HALF * K * 2;
    const size_t tstep = 2 * hstep;
    const unsigned ldsw = (unsigned)wid * 1024u;
    const int aoff = lds_byte(wr * 64 + fr, fq * 8), boff = lds_byte(wc * 32 + fr, fq * 8);
#define PG8_SA(b, h) (((b) * 2 + (h)) * HTB)
#define PG8_SB(b, h) ((4 + (b) * 2 + (h)) * HTB)
#define PG8_STAGE(bufoff, gbase, voff) do { _Pragma("unroll") for (int _i = 0; _i < 2; ++_i) \
        __builtin_amdgcn_global_load_lds((const unsigned*)((const char*)(gbase) + (voff)[_i]), (PG8_LAS unsigned*)(lds + (bufoff) + ldsw + _i * 8192), 16, 0, 0); } while (0)
#define PG8_LDA(dst, b, h) do { _Pragma("unroll") for (int m = 0; m < 4; ++m) _Pragma("unroll") for (int k = 0; k < 2; ++k) dst[m][k] = *(const PG8_LAS bf16x8*)(lds + PG8_SA(b, h) + aoff + m * 2048 + k * 1024); } while (0)
#define PG8_LDB(dst, b, h) do { _Pragma("unroll") for (int n = 0; n < 2; ++n) _Pragma("unroll") for (int k = 0; k < 2; ++k) dst[n][k] = *(const PG8_LAS bf16x8*)(lds + PG8_SB(b, h) + boff + n * 2048 + k * 1024); } while (0)
#define PG8_MMA(ai, bj, At, Bt) do { __builtin_amdgcn_s_setprio(1); _Pragma("unroll") for (int m = 0; m < 4; ++m) _Pragma("unroll") for (int n = 0; n < 2; ++n) _Pragma("unroll") for (int k = 0; k < 2; ++k) \
        acc[ai][bj][m][n] = __builtin_amdgcn_mfma_f32_16x16x32_bf16(Bt[n][k], At[m][k], acc[ai][bj][m][n], 0, 0, 0); __builtin_amdgcn_s_setprio(0); } while (0)
#define PG8_WAIT_V(n) asm volatile("s_waitcnt vmcnt(" #n ")" ::: "memory")
#define PG8_WAIT_L(n) asm volatile("s_waitcnt lgkmcnt(" #n ")" ::: "memory")
#define PG8_BAR __builtin_amdgcn_s_barrier()
#define PG8_SCHED __builtin_amdgcn_sched_barrier(0)
    Unit cur, nxt; int ui = 0;
    if (!S.next(0, cur)) return;
    f32x4 acc[2][2][4][2];
#pragma unroll
    for (int a = 0; a < 2; ++a)
#pragma unroll
        for (int b = 0; b < 2; ++b)
#pragma unroll
            for (int m = 0; m < 4; ++m)
#pragma unroll
                for (int n = 0; n < 2; ++n) acc[a][b][m][n] = (f32x4){0.f, 0.f, 0.f, 0.f};
    bf16x8 At[4][2], B0[2][2], B1[2][2];
    const char* cA = (const char*)g.A + (size_t)cur.pm * tstep; const char* cB = (const char*)g.Bt + (size_t)cur.pb * tstep;
    S.a_ready(cur);
    if constexpr (SP2) {
        PG8_STAGE(PG8_SB(0, 0), cB, voffB); PG8_STAGE(PG8_SB(0, 1), cB + hstep, voffB); PG8_STAGE(PG8_SA(0, 0), cA, voffA); PG8_STAGE(PG8_SA(0, 1), cA + hstep, voffA);
        if (wr == 1) PG8_BAR;
        PG8_WAIT_V(2); PG8_BAR;
        PG8_STAGE(PG8_SB(1, 0), cB + kstep, voffB); PG8_STAGE(PG8_SA(1, 0), cA + kstep, voffA); PG8_STAGE(PG8_SB(1, 1), cB + hstep + kstep, voffB);
        PG8_WAIT_V(6); PG8_BAR;
    } else {
        PG8_STAGE(PG8_SB(0, 0), cB, voffB); PG8_STAGE(PG8_SA(0, 0), cA, voffA); PG8_STAGE(PG8_SB(0, 1), cB + hstep, voffB); PG8_STAGE(PG8_SA(0, 1), cA + hstep, voffA);
        if (wr == 1) PG8_BAR;
        PG8_WAIT_V(4); PG8_BAR;
        PG8_STAGE(PG8_SB(1, 0), cB + kstep, voffB); PG8_STAGE(PG8_SA(1, 0), cA + kstep, voffA); PG8_STAGE(PG8_SB(1, 1), cB + hstep + kstep, voffB);
        PG8_WAIT_V(6); PG8_BAR;
    }
    for (;;) {
        const bool has_next = S.next(ui + 1, nxt);
        const char* nA = has_next ? (const char*)g.A + (size_t)nxt.pm * tstep : cA; const char* nB = has_next ? (const char*)g.Bt + (size_t)nxt.pb * tstep : cB;
        for (int t = 0; t < nt; t += 2) {
            const bool last = (t == nt - 2);
            const char* a1 = cA + (size_t)(t + 1) * kstep;
            const char* a2 = last ? nA : cA + (size_t)(t + 2) * kstep; const char* b2 = last ? nB : cB + (size_t)(t + 2) * kstep;
            const char* a3 = a2 + kstep; const char* b3 = b2 + kstep;
            if (last && has_next) S.a_ready(nxt);
            if constexpr (SP2) {
            PG8_LDB(B0, 0, 0); PG8_LDB(B1, 0, 1); PG8_SCHED; PG8_LDA(At, 0, 0); PG8_STAGE(PG8_SA(1, 1), a1 + hstep, voffA);
            PG8_WAIT_V(8); PG8_WAIT_L(0); PG8_BAR; PG8_MMA(0, 0, At, B0); PG8_MMA(0, 1, At, B1); PG8_BAR; PG8_SCHED;
            PG8_LDA(At, 0, 1); PG8_STAGE(PG8_SB(0, 0), b2, voffB); PG8_STAGE(PG8_SB(0, 1), b2 + hstep, voffB); PG8_STAGE(PG8_SA(0, 0), a2, voffA);
            PG8_WAIT_V(8); PG8_WAIT_L(0); PG8_BAR; PG8_MMA(1, 0, At, B0); PG8_MMA(1, 1, At, B1); PG8_BAR; PG8_SCHED;
            PG8_LDB(B0, 1, 0); PG8_LDB(B1, 1, 1); PG8_SCHED; PG8_LDA(At, 1, 0); PG8_STAGE(PG8_SA(0, 1), a2 + hstep, voffA);
            PG8_WAIT_V(8); PG8_WAIT_L(0); PG8_BAR; PG8_MMA(0, 0, At, B0); PG8_MMA(0, 1, At, B1); PG8_BAR; PG8_SCHED;
            PG8_LDA(At, 1, 1); PG8_STAGE(PG8_SB(1, 0), b3, voffB); PG8_STAGE(PG8_SB(1, 1), b3 + hstep, voffB); PG8_STAGE(PG8_SA(1, 0), a3, voffA);
            PG8_WAIT_V(8); PG8_WAIT_L(0); PG8_BAR; PG8_MMA(1, 0, At, B0); PG8_MMA(1, 1, At, B1); PG8_BAR; PG8_SCHED;
            } else {
            PG8_LDB(B0, 0, 0); PG8_SCHED; PG8_LDA(At, 0, 0); PG8_STAGE(PG8_SA(1, 1), a1 + hstep, voffA);
            PG8_WAIT_L(8); PG8_BAR; PG8_WAIT_L(0); PG8_MMA(0, 0, At, B0); PG8_BAR; PG8_SCHED;
            PG8_LDB(B1, 0, 1); PG8_STAGE(PG8_SB(0, 0), b2, voffB);
            PG8_BAR; PG8_WAIT_L(0); PG8_MMA(0, 1, At, B1); PG8_BAR;
            PG8_LDA(At, 0, 1); PG8_STAGE(PG8_SA(0, 0), a2, voffA);
            PG8_BAR; PG8_WAIT_L(0); PG8_MMA(1, 0, At, B0); PG8_BAR; PG8_SCHED;
            PG8_STAGE(PG8_SB(0, 1), b2 + hstep, voffB);
            PG8_WAIT_V(6); PG8_BAR; PG8_MMA(1, 1, At, B1); PG8_BAR;
            PG8_LDB(B0, 1, 0); PG8_SCHED; PG8_LDA(At, 1, 0); PG8_STAGE(PG8_SA(0, 1), a2 + hstep, voffA);
            PG8_WAIT_L(8); PG8_BAR; PG8_WAIT_L(0); PG8_MMA(0, 0, At, B0); PG8_BAR; PG8_SCHED;
            PG8_LDB(B1, 1, 1); PG8_STAGE(PG8_SB(1, 0), b3, voffB);
            PG8_BAR; PG8_WAIT_L(0); PG8_MMA(0, 1, At, B1); PG8_BAR;
            PG8_LDA(At, 1, 1); PG8_STAGE(PG8_SA(1, 0), a3, voffA);
            PG8_BAR; PG8_WAIT_L(0); PG8_MMA(1, 0, At, B0); PG8_BAR; PG8_SCHED;
            PG8_STAGE(PG8_SB(1, 1), b3 + hstep, voffB);
            PG8_WAIT_V(6); PG8_BAR; PG8_MMA(1, 1, At, B1); PG8_BAR;
            }
        }
        if constexpr (ALIGN_EPI) { if (wr == 0) PG8_BAR; }
        if constexpr (!Epi::AFTER_DRAIN) { E(acc, cur, wr, wc, fr, fq); S.done(cur); }
        if (!has_next) break;
#pragma unroll
        for (int a = 0; a < 2; ++a)
#pragma unroll
            for (int b = 0; b < 2; ++b)
#pragma unroll
                for (int m = 0; m < 4; ++m)
#pragma unroll
                    for (int n = 0; n < 2; ++n) acc[a][b][m][n] = (f32x4){0.f, 0.f, 0.f, 0.f};
        cur = nxt; cA = nA; cB = nB; ++ui;
        if constexpr (ALIGN_EPI) { if (wr == 1) PG8_BAR; }
    }
    PG8_WAIT_V(0);
    if constexpr (!ALIGN_EPI) { if (wr == 0) PG8_BAR; }
    PG8_BAR;
    if constexpr (Epi::AFTER_DRAIN) { E.fused(acc, cur, wr, wc, fr, fq, lds, wid, lane); S.done(cur); }
#undef PG8_SA
#undef PG8_SB
#undef PG8_STAGE
#undef PG8_LDA
#undef PG8_LDB
#undef PG8_MMA
#undef PG8_WAIT_V
#undef PG8_WAIT_L
#undef PG8_BAR
#undef PG8_SCHED
}
}

#define LAS __attribute__((address_space(3)))
typedef unsigned short bf16;
typedef float f32x4 __attribute__((ext_vector_type(4)));
typedef unsigned u32x4 __attribute__((ext_vector_type(4)));
typedef unsigned u32x2 __attribute__((ext_vector_type(2)));
constexpr int NWAVES = 8, NTHREADS = 512, LDS_BYTES = 160 * 1024;

__device__ __forceinline__ unsigned f2bf(float f) { unsigned u = __float_as_uint(f); return (u + 0x7fffu + ((u >> 16) & 1u)) >> 16; }
__device__ __forceinline__ unsigned pk2(float lo, float hi) { return f2bf(lo) | (f2bf(hi) << 16); }
__device__ __forceinline__ float bf2f(unsigned h) { return __uint_as_float(h << 16); }
__device__ __forceinline__ float wave_sum(float v) {
#pragma unroll
    for (int o = 1; o < 64; o <<= 1) v += __shfl_xor(v, o);
    return v;
}
__device__ __forceinline__ float siluf(float x) { return x / (1.f + expf(-x)); }
__device__ __forceinline__ float gelu_tanh(float x) { return 0.5f * x * (1.f + tanhf(0.7978845608028654f * (x + 0.044715f * x * x * x))); }
__device__ __forceinline__ int mod_row(int row) { return ((row % RB) < SEQ) ? row / RB : 8; }
__device__ __forceinline__ bool is_ctx_row(int row) { return (row % RB) >= SEQ; }

constexpr size_t al256(size_t x) { return (x + 255) & ~(size_t)255; }
constexpr size_t WS_ZERO = 0, ZERO_BYTES = 2u << 20;
constexpr size_t Z_GCNT = 0;
constexpr size_t Z_SS2 = 4096;
constexpr size_t WS_MOD = ZERO_BYTES;
constexpr size_t WS_WRT = WS_MOD + al256((size_t)2 * 9 * 6144 * 4);
constexpr size_t WS_TOKE = WS_WRT + al256((size_t)2 * 36 * 1024 * 4);
constexpr size_t WS_TOKP = WS_TOKE + al256((size_t)NSLOT * 4);
constexpr size_t WS_TOKC = WS_TOKP + al256((size_t)NSLOT * 4);
constexpr size_t WS_TOKS = WS_TOKC + al256((size_t)NSLOT * 4);
constexpr size_t WS_TILE = WS_TOKS + al256((size_t)NSLOT * 4);
constexpr size_t WS_XC = WS_TILE + al256((size_t)(MT_MAX + 64) * 4);
constexpr size_t WS_WIN = WS_XC + al256((size_t)NB * CL * D * 4);
constexpr size_t WS_WOUT = WS_WIN + al256((size_t)2 * INW * D * 2);
constexpr size_t WS_WSB = WS_WOUT + al256((size_t)2 * D * D * 2);
constexpr size_t WS_LBV = WS_WSB + al256((size_t)2 * 4 * 128 * 128 * 2);
constexpr size_t WS_HB = WS_LBV + al256((size_t)2 * 2 * 512 * 4);
constexpr size_t WS_R = WS_HB + al256((size_t)M * D * 2);
constexpr int NCH = M / 64  , NCH2 = M / 128;
constexpr size_t R_QA = 0;
constexpr size_t R_KB = R_QA + al256((size_t)2 * M * 512 * 2);
constexpr size_t R_KDT = R_KB + al256((size_t)2 * M * 512 * 2);
constexpr size_t R_VT = R_KDT + al256((size_t)2 * M * 512 * 2);
constexpr size_t R_SG = R_VT + al256((size_t)M * 512 * 2);
constexpr size_t R_GU = R_SG + al256((size_t)M * 512 * 2);
constexpr size_t R_GVT = R_GU + al256((size_t)M * 512 * 2);
constexpr size_t R_EREF = R_GVT + al256((size_t)M * 512 * 2);
constexpr size_t R_DEC = R_EREF + al256((size_t)2 * NCH * 512 * 4);
constexpr size_t R_ST = R_DEC + al256((size_t)2 * NCH * 512 * 4);
constexpr size_t R_MIX_END = R_ST + al256((size_t)NCH * 2 * 4 * 128 * 128 * 2);
constexpr size_t R_HS_DUMMY = 0;
constexpr size_t R_WGU = 0;
constexpr size_t R_WD = R_WGU + al256((size_t)NEXP * 1024 * D * 2);
constexpr size_t R_BUF = R_WD + al256((size_t)NEXP * D * DE * 2);
constexpr size_t R_ACT = R_BUF + al256((size_t)NSLOT_PAD * D * 2);
constexpr size_t R_Y = R_ACT + al256((size_t)NSLOT_PAD * DE * 2);
constexpr size_t R_MOE_END = R_Y + al256((size_t)NSLOT_PAD * D * 2);
constexpr size_t WS_END = WS_R + (R_MIX_END > R_MOE_END ? R_MIX_END : R_MOE_END);
static_assert(WS_END <= (size_t)634 * 1000 * 1000, "workspace budget (sum of inputs = 634.3 MB)");
constexpr size_t Z_SSV = Z_SS2 + (size_t)2 * M * 4;
static_assert(Z_SSV + (size_t)2 * M * 4 <= ZERO_BYTES, "zeroed region");

struct Params { const float* in[23]; float* out; unsigned char* ws; };
enum { I_X = 0, I_C, I_CTX, I_CCTX, I_NORM1, I_NORM2, I_WMOD, I_BMOD, I_WIN, I_LB, I_HGN, I_SGN, I_SGW, I_SGB, I_WOUT, I_WG, I_BG, I_WR, I_BR, I_WGATE, I_WUP, I_WDOWN, I_FN };

__device__ __forceinline__ void transpose_item(const float* W, int K, int N, bf16* WT, int k0, int n0, int rowbase, LAS float* scr, int lane) {
#pragma unroll 8
    for (int i = 0; i < 32; ++i) { const int kk = 2 * i + (lane >> 5); scr[kk * 33 + (lane & 31)] = W[(size_t)(k0 + kk) * N + n0 + (lane & 31)]; }
    asm volatile("s_waitcnt lgkmcnt(0)" ::: "memory");
    const int c = lane & 7;
#pragma unroll
    for (int j = 0; j < 4; ++j) { const int n = (lane >> 3) + 8 * j; const LAS float* s = scr + (8 * c) * 33 + n;
        u32x4 o; o.x = pk2(s[0 * 33], s[1 * 33]); o.y = pk2(s[2 * 33], s[3 * 33]); o.z = pk2(s[4 * 33], s[5 * 33]); o.w = pk2(s[6 * 33], s[7 * 33]);
        *(u32x4*)(WT + (size_t)(rowbase + n) * K + k0 + 8 * c) = o; }
    asm volatile("s_waitcnt lgkmcnt(0)" ::: "memory");
}
__device__ __forceinline__ void transpose_item_g(const float* W, int K, int N, bf16* WT, int k0, int srccol_lane, int rowbase, LAS float* scr, int lane) {
#pragma unroll 8
    for (int i = 0; i < 32; ++i) { const int kk = 2 * i + (lane >> 5); scr[kk * 33 + (lane & 31)] = W[(size_t)(k0 + kk) * N + srccol_lane]; }
    asm volatile("s_waitcnt lgkmcnt(0)" ::: "memory");
    const int c = lane & 7;
#pragma unroll
    for (int j = 0; j < 4; ++j) { const int n = (lane >> 3) + 8 * j; const LAS float* s = scr + (8 * c) * 33 + n;
        u32x4 o; o.x = pk2(s[0 * 33], s[1 * 33]); o.y = pk2(s[2 * 33], s[3 * 33]); o.z = pk2(s[4 * 33], s[5 * 33]); o.w = pk2(s[6 * 33], s[7 * 33]);
        *(u32x4*)(WT + (size_t)(rowbase + n) * K + k0 + 8 * c) = o; }
    asm volatile("s_waitcnt lgkmcnt(0)" ::: "memory");
}
__device__ __forceinline__ int win_srccol(int r) {
    const int pn = r >> 8, c = r & 255;
    if (pn >= 8) return 2048 + (pn - 8) * 256 + c;
    const int bj = c >> 7, wc = (c >> 5) & 3, fq = (c >> 3) & 3, n = (c >> 2) & 1, e = c & 3;
    return (2 * bj + n) * 512 + (pn >> 1) * 128 + (pn & 1) * 64 + 16 * wc + 4 * fq + e;
}
__device__ __forceinline__ void norm_mod_row(const float* xr, const float* gain, const float* sh, const float* sc, bf16* orow, int lane) {
    f32x4 v[4]; float ss = 0.f;
#pragma unroll
    for (int j = 0; j < 4; ++j) { v[j] = *(const f32x4*)(xr + 4 * lane + 256 * j); ss += (v[j][0] * v[j][0] + v[j][1] * v[j][1]) + (v[j][2] * v[j][2] + v[j][3] * v[j][3]); }
    const float rs = rsqrtf(wave_sum(ss) * (1.f / D) + EPS);
#pragma unroll
    for (int j = 0; j < 4; ++j) { const int k = 4 * lane + 256 * j; const f32x4 g = *(const f32x4*)(gain + k), s1 = *(const f32x4*)(sc + k), s0 = *(const f32x4*)(sh + k);
        const f32x4 o = v[j] * rs * g * (s1 + 1.f) + s0; u32x2 w; w.x = pk2(o[0], o[1]); w.y = pk2(o[2], o[3]); *(u32x2*)(orow + k) = w; }
}
__device__ __forceinline__ const float* xrow_in(const Params& p, int row) { const int b = row / RB, t = row % RB; return t < SEQ ? p.in[I_X] + ((size_t)b * SEQ + t) * D : p.in[I_CTX] + ((size_t)b * CL + (t - SEQ)) * D; }
__device__ __forceinline__ float* xrow_cur(const Params& p, int row) { const int b = row / RB, t = row % RB; return t < SEQ ? p.out + ((size_t)b * SEQ + t) * D : (float*)(p.ws + WS_XC) + ((size_t)b * CL + (t - SEQ)) * D; }

__device__ __forceinline__ void ph_prologue(const Params& p, LAS unsigned char* lds, int tid, int lane, int wave, int G) {
    float* MOD = (float*)(p.ws + WS_MOD);
    if (blockIdx.x < 192) {
        const int l = blockIdx.x / 96, col0 = (blockIdx.x % 96) * 64;
        LAS float* sc = (LAS float*)lds; LAS float* red = (LAS float*)(lds + 36864);
        for (int i = tid; i < 9 * 1024; i += NTHREADS) { const int r = i >> 10, k = i & 1023; sc[i] = siluf(r < 8 ? p.in[I_C][r * 1024 + k] : p.in[I_CCTX][k]); }
        __syncthreads();
        const int c4 = tid & 15, kg = tid >> 4;
        f32x4 acc[9];
#pragma unroll
        for (int r = 0; r < 9; ++r) acc[r] = (f32x4){0.f, 0.f, 0.f, 0.f};
        const float* w = p.in[I_WMOD] + (size_t)l * 1024 * 6144 + col0 + 4 * c4;
        for (int k = kg; k < 1024; k += 32) { const f32x4 wv = *(const f32x4*)(w + (size_t)k * 6144);
#pragma unroll
            for (int r = 0; r < 9; ++r) acc[r] += wv * sc[r * 1024 + k]; }
#pragma unroll
        for (int r = 0; r < 9; ++r) *(LAS f32x4*)&red[(kg * 9 + r) * 64 + 4 * c4] = acc[r];
        __syncthreads();
        for (int i = tid; i < 576; i += NTHREADS) { const int r = i >> 6, cc = i & 63; float s = 0.f;
            for (int g = 0; g < 32; ++g) s += red[(g * 9 + r) * 64 + cc];
            MOD[(size_t)(l * 9 + r) * 6144 + col0 + cc] = s + p.in[I_BMOD][l * 6144 + col0 + cc]; }
        __syncthreads();
    }
    {
        float* WRT = (float*)(p.ws + WS_WRT);
        for (int i = blockIdx.x * NTHREADS + tid; i < 2 * 36 * 1024; i += G * NTHREADS) { const int l = i / (36 * 1024), o = (i / 1024) % 36, k = i & 1023;
            WRT[i] = o < 4 ? p.in[I_WG][((size_t)l * 1024 + k) * 4 + o] : p.in[I_WR][((size_t)l * 1024 + k) * 32 + (o - 4)]; }
    }
    {
        float* LBV = (float*)(p.ws + WS_LBV); bf16* WSB = (bf16*)(p.ws + WS_WSB);
        for (int i = blockIdx.x * NTHREADS + tid; i < 1024; i += G * NTHREADS) { LBV[i] = 0.f; LBV[1024 + i] = 1.f / (1.f + expf(p.in[I_LB][i] - p.in[I_LB][1024 + i])); }
        for (int i = blockIdx.x * NTHREADS + tid; i < 2 * 4 * 128 * 128; i += G * NTHREADS) WSB[i] = (bf16)f2bf(p.in[I_SGW][i]);
    }
    LAS float* scr = (LAS float*)(lds + wave * 16384);
    const int gw = blockIdx.x * NWAVES + wave, NGW = G * NWAVES;
    constexpr int I_IN = (D / 64) * (INW / 32), I_OUT = (D / 64) * (D / 32);
    for (int it = gw; it < 2 * (I_IN + I_OUT); it += NGW) {
        const int l = it / (I_IN + I_OUT); int r = it % (I_IN + I_OUT);
        if (r < I_IN) { const int nblk = INW / 32, kb = r / nblk, nb = r % nblk; transpose_item_g(p.in[I_WIN] + (size_t)l * D * INW, D, INW, (bf16*)(p.ws + WS_WIN) + (size_t)l * INW * D, 64 * kb, win_srccol(32 * nb + (lane & 31)), 32 * nb, scr, lane); }
        else { r -= I_IN; const int nblk = D / 32, kb = r / nblk, nb = r % nblk; transpose_item(p.in[I_WOUT] + (size_t)l * D * D, D, D, (bf16*)(p.ws + WS_WOUT) + (size_t)l * D * D, 64 * kb, 32 * nb, 32 * nb, scr, lane); }
    }
}
__device__ __forceinline__ void ph_h1_first(const Params& p, int lane, int wave, int G) {
    const float* MOD = (const float*)(p.ws + WS_MOD); bf16* HB = (bf16*)(p.ws + WS_HB);
    for (int row = blockIdx.x * NWAVES + wave; row < M; row += G * NWAVES) { const float* mr = MOD + (size_t)mod_row(row) * 6144;
        norm_mod_row(xrow_in(p, row), p.in[I_NORM1], mr, mr + 1024, HB + (size_t)row * D, lane); }
}
__device__ __forceinline__ void ph_moe_wconv(const Params& p, int l, LAS unsigned char* lds, int lane, int wave, int G) {
    LAS float* scr = (LAS float*)(lds + wave * 16384);
    bf16* WGU = (bf16*)(p.ws + WS_R + R_WGU); bf16* WD = (bf16*)(p.ws + WS_R + R_WD);
    constexpr int I_G = (D / 64) * (DE / 32)  , I_D = (DE / 64) * (D / 32)  , PER_E = 2 * I_G + I_D;
    for (int it = blockIdx.x * NWAVES + wave; it < NEXP * PER_E; it += G * NWAVES) {
        const int e = it / PER_E; int r = it % PER_E;
        if (r < 2 * I_G) { const int isup = r >= I_G; r -= isup * I_G; const int nblk = DE / 32, kb = r / nblk, nb = r % nblk, n0 = 32 * nb;
            const float* W = p.in[isup ? I_WUP : I_WGATE] + ((size_t)l * NEXP + e) * D * DE;
            transpose_item(W, D, DE, WGU + (size_t)e * 1024 * D, 64 * kb, n0, 256 * (n0 >> 7) + 128 * isup + (n0 & 127), scr, lane); }
        else { r -= 2 * I_G; const int nblk = D / 32, kb = r / nblk, nb = r % nblk;
            transpose_item(p.in[I_WDOWN] + ((size_t)l * NEXP + e) * DE * D, DE, D, WD + (size_t)e * D * DE, 64 * kb, 32 * nb, 32 * nb, scr, lane); }
    }
}
__device__ __forceinline__ void ph_router(const Params& p, int l, int last, LAS unsigned char* lds, int tid, int lane, int wave, int G) {
    LAS float* W = (LAS float*)lds; LAS int* hist = (LAS int*)(lds + 147456); LAS int* base = hist + 32; LAS int* sinfo = base + 32 + wave * 40;
    const float* WRT = (const float*)(p.ws + WS_WRT) + (size_t)l * 36 * 1024;
    for (int i = tid; i < 36 * 256; i += NTHREADS) ((LAS f32x4*)W)[i] = ((const f32x4*)WRT)[i];
    if (tid < 32) hist[tid] = 0;
    __syncthreads();
    const float* MOD = (const float*)(p.ws + WS_MOD) + (size_t)l * 9 * 6144; const float* SS2 = (const float*)(p.ws + WS_ZERO + Z_SS2) + (size_t)l * M;
    bf16* HB = (bf16*)(p.ws + WS_HB); int* TOKE = (int*)(p.ws + WS_TOKE); float* TOKC = (float*)(p.ws + WS_TOKC); int* TOKP = (int*)(p.ws + WS_TOKP);
    int* gcnt = (int*)(p.ws + WS_ZERO + Z_GCNT) + l * 64;
    const float* gain = p.in[I_NORM2] + l * D; const float* bg = p.in[I_BG] + l * 4; const float* br = p.in[I_BR] + l * 32;
    int nloc = 0;
    for (int row = blockIdx.x * NWAVES + wave; row < M; row += G * NWAVES) {
        if (last && is_ctx_row(row)) continue;
        const float* xr = xrow_cur(p, row); const float* mr = MOD + (size_t)mod_row(row) * 6144;
        const float rs = rsqrtf(SS2[row] * (1.f / D) + EPS);
        f32x4 h[4];
#pragma unroll
        for (int j = 0; j < 4; ++j) { const int k = 4 * lane + 256 * j; const f32x4 v = *(const f32x4*)(xr + k), g = *(const f32x4*)(gain + k), s1 = *(const f32x4*)(mr + 4 * 1024 + k), s0 = *(const f32x4*)(mr + 3 * 1024 + k);
            h[j] = v * rs * g * (s1 + 1.f) + s0; u32x2 w; w.x = pk2(h[j][0], h[j][1]); w.y = pk2(h[j][2], h[j][3]); *(u32x2*)(HB + (size_t)row * D + k) = w; }
        float lg[36];
#pragma unroll
        for (int o = 0; o < 36; ++o) { float a = 0.f;
#pragma unroll
            for (int j = 0; j < 4; ++j) { const f32x4 wv = *(const LAS f32x4*)&W[o * 1024 + 4 * lane + 256 * j]; a += (h[j][0] * wv[0] + h[j][1] * wv[1]) + (h[j][2] * wv[2] + h[j][3] * wv[3]); }
            lg[o] = wave_sum(a) + (o < 4 ? bg[o] : br[o - 4]); }
        int gs = 0; float gmax = lg[0];
#pragma unroll
        for (int o = 1; o < 4; ++o) if (lg[o] > gmax) { gmax = lg[o]; gs = o; }
        float den = 0.f;
#pragma unroll
        for (int o = 0; o < 4; ++o) den += expf(lg[o] - gmax);
        const float psel = 1.f / den;
        float li[8];
#pragma unroll
        for (int j = 0; j < 8; ++j) li[j] = gs == 0 ? lg[4 + j] : gs == 1 ? lg[12 + j] : gs == 2 ? lg[20 + j] : lg[28 + j];
        int i0 = 0; float m0 = li[0];
#pragma unroll
        for (int j = 1; j < 8; ++j) if (li[j] > m0) { m0 = li[j]; i0 = j; }
        int i1 = 0; float m1 = -3.0e38f;
#pragma unroll
        for (int j = 0; j < 8; ++j) if (j != i0 && li[j] > m1) { m1 = li[j]; i1 = j; }
        const float e1 = expf(m1 - m0);
        if (lane < 2) { const int e = gs * 8 + (lane ? i1 : i0); const float c = lane ? psel * e1 / (1.f + e1) : psel / (1.f + e1);
            const int lp = __hip_atomic_fetch_add(&hist[e], 1, __ATOMIC_RELAXED, __HIP_MEMORY_SCOPE_WORKGROUP); TOKE[row * 2 + lane] = e; TOKC[row * 2 + lane] = c; sinfo[nloc * 2 + lane] = (e << 16) | lp; }
        ++nloc;
    }
    __syncthreads();
    if (tid < 32) base[tid] = atomicAdd(&gcnt[tid], hist[tid]);
    __syncthreads();
    nloc = 0;
    for (int row = blockIdx.x * NWAVES + wave; row < M; row += G * NWAVES) {
        if (last && is_ctx_row(row)) continue;
        if (lane < 2) { const int info = sinfo[nloc * 2 + lane]; TOKP[row * 2 + lane] = base[info >> 16] + (info & 0xffff); }
        ++nloc;
    }
}
__device__ __forceinline__ void ph_place(const Params& p, int l, int last, LAS unsigned char* lds, int tid, int lane, int wave, int G) {
    LAS int* ps = (LAS int*)lds;
    const int* gcnt = (const int*)(p.ws + WS_ZERO + Z_GCNT) + l * 64; int* TILE = (int*)(p.ws + WS_TILE);
    if (tid == 0) { int s = 0; for (int e = 0; e < NEXP; ++e) { ps[e] = s; s += (gcnt[e] + 255) / 256 * 256; } ps[32] = s; }
    __syncthreads();
    if (blockIdx.x == 0 && tid < 32) { for (int t = ps[tid] / 256; t < ps[tid + 1] / 256; ++t) TILE[t] = tid; if (tid == 0) TILE[MT_MAX] = ps[32] / 256; }
    const bf16* HB = (const bf16*)(p.ws + WS_HB); bf16* BUF = (bf16*)(p.ws + WS_R + R_BUF);
    const int* TOKE = (const int*)(p.ws + WS_TOKE); const int* TOKP = (const int*)(p.ws + WS_TOKP); int* TOKS = (int*)(p.ws + WS_TOKS);
    for (int row = blockIdx.x * NWAVES + wave; row < M; row += G * NWAVES) {
        if (last && is_ctx_row(row)) continue;
        const int s0 = ps[TOKE[row * 2]] + TOKP[row * 2], s1 = ps[TOKE[row * 2 + 1]] + TOKP[row * 2 + 1];
        const u32x4 a = ((const u32x4*)(HB + (size_t)row * D))[lane], b = ((const u32x4*)(HB + (size_t)row * D))[lane + 64];
        ((u32x4*)(BUF + (size_t)s0 * D))[lane] = a; ((u32x4*)(BUF + (size_t)s0 * D))[lane + 64] = b;
        ((u32x4*)(BUF + (size_t)s1 * D))[lane] = a; ((u32x4*)(BUF + (size_t)s1 * D))[lane + 64] = b;
        if (lane == 0) { TOKS[row * 2] = s0; TOKS[row * 2 + 1] = s1; }
    }
}
__device__ __forceinline__ void ph_combine(const Params& p, int l, int last, int lane, int wave, int G) {
    const float* MOD = (const float*)(p.ws + WS_MOD); const bf16* Y = (const bf16*)(p.ws + WS_R + R_Y); bf16* HB = (bf16*)(p.ws + WS_HB);
    const int* TOKS = (const int*)(p.ws + WS_TOKS); const float* TOKC = (const float*)(p.ws + WS_TOKC);
    for (int row = blockIdx.x * NWAVES + wave; row < M; row += G * NWAVES) {
        if (last && is_ctx_row(row)) continue;
        float* xr = xrow_cur(p, row); const int mrow = mod_row(row); const float* g2 = MOD + ((size_t)l * 9 + mrow) * 6144 + 5 * 1024;
        const int s0 = TOKS[row * 2], s1 = TOKS[row * 2 + 1]; const float c0 = TOKC[row * 2], c1 = TOKC[row * 2 + 1];
        f32x4 v[4]; float ss = 0.f;
#pragma unroll
        for (int j = 0; j < 4; ++j) { const int k = 4 * lane + 256 * j; const f32x4 x = *(const f32x4*)(xr + k), g = *(const f32x4*)(g2 + k);
            const u32x2 y0 = *(const u32x2*)(Y + (size_t)s0 * D + k), y1 = *(const u32x2*)(Y + (size_t)s1 * D + k);
            f32x4 f; f[0] = c0 * bf2f(y0.x & 0xffffu) + c1 * bf2f(y1.x & 0xffffu); f[1] = c0 * bf2f(y0.x >> 16) + c1 * bf2f(y1.x >> 16);
            f[2] = c0 * bf2f(y0.y & 0xffffu) + c1 * bf2f(y1.y & 0xffffu); f[3] = c0 * bf2f(y0.y >> 16) + c1 * bf2f(y1.y >> 16);
            v[j] = x + g * f; ss += (v[j][0] * v[j][0] + v[j][1] * v[j][1]) + (v[j][2] * v[j][2] + v[j][3] * v[j][3]); }
        const float rs = rsqrtf(wave_sum(ss) * (1.f / D) + EPS);
        if (!last) { const float* mr = MOD + ((size_t)(l + 1) * 9 + mrow) * 6144; const float* gain = p.in[I_NORM1] + (l + 1) * D;
#pragma unroll
            for (int j = 0; j < 4; ++j) { const int k = 4 * lane + 256 * j; *(f32x4*)(xr + k) = v[j];
                const f32x4 g = *(const f32x4*)(gain + k), s1v = *(const f32x4*)(mr + 1024 + k), s0v = *(const f32x4*)(mr + k);
                const f32x4 o = v[j] * rs * g * (s1v + 1.f) + s0v; u32x2 w; w.x = pk2(o[0], o[1]); w.y = pk2(o[2], o[3]); *(u32x2*)(HB + (size_t)row * D + k) = w; } }
        else {
#pragma unroll
            for (int j = 0; j < 4; ++j) { const int k = 4 * lane + 256 * j; const f32x4 g = *(const f32x4*)(p.in[I_FN] + k); *(f32x4*)(xr + k) = v[j] * rs * g; } }
    }
}
__device__ __forceinline__ float ldbf(const bf16* p) { return __uint_as_float((unsigned)(*p) << 16); }
__device__ __forceinline__ int scan_chunk(int step, int dir) { return dir == 0 ? (step < 4 ? 64 + step : step - 4) : (step < 4 ? 67 - step : 67 - step); }
__device__ __forceinline__ void ph_nscan(const Params& p, LAS unsigned char* lds, int tid) {
    const int item = blockIdx.x, h = item & 3, dir = (item >> 2) & 1, b = item >> 3, e = tid & 127, dg = tid >> 7;
    const bf16* KDT = (const bf16*)(p.ws + WS_R + R_KDT) + (size_t)dir * M * 512; const bf16* VT = (const bf16*)(p.ws + WS_R + R_VT);
    const float* DEC = (const float*)(p.ws + WS_R + R_DEC) + (size_t)dir * NCH * 512; bf16* ST = (bf16*)(p.ws + WS_R + R_ST);
    LAS float* kd = (LAS float*)lds; LAS float* vt = kd + 128 * 64;
    float S[32];
#pragma unroll
    for (int i = 0; i < 32; ++i) S[i] = 0.f;
    for (int step = 0; step < 68; ++step) {
        const int gc = b * 68 + scan_chunk(step, dir);
        { bf16* o = ST + ((((size_t)gc * 2 + dir) * 4 + h) * 128 + e) * 128 + dg * 32;
#pragma unroll
          for (int i = 0; i < 32; i += 2) *(unsigned*)(o + i) = pk2(S[i], S[i + 1]); }
        const bf16* kg = KDT + ((size_t)gc * 512 + h * 128) * 64; const bf16* vg = VT + ((size_t)gc * 512 + h * 128) * 64;
        for (int i = tid; i < 128 * 64; i += NTHREADS) { kd[i] = ldbf(kg + i); vt[(i >> 6) * 65 + (i & 63)] = ldbf(vg + i); }
        __syncthreads();
#pragma unroll
        for (int i = 0; i < 32; ++i) { const int d = dg * 32 + i; float a = DEC[(size_t)gc * 512 + h * 128 + d] * S[i];
            for (int j = 0; j < 64; ++j) a += kd[d * 64 + j] * vt[e * 65 + j];
            S[i] = a; }
        __syncthreads();
    }
}
__device__ __forceinline__ void ph_nsgu(const Params& p, int l, LAS unsigned char* lds, int tid, int first, int nblk) {
    const bf16* GVT = (const bf16*)(p.ws + WS_R + R_GVT); const bf16* GU = (const bf16*)(p.ws + WS_R + R_GU); bf16* HS = (bf16*)(p.ws + WS_HB);
    const float* SSV = (const float*)(p.ws + WS_ZERO + Z_SSV) + (size_t)l * M; const float* Ws = p.in[I_SGW] + (size_t)l * 4 * 128 * 128; const float* bs = p.in[I_SGB] + l * 512;
    LAS float* vn = (LAS float*)lds;
    for (int it = (int)blockIdx.x - first; it < NCH2 * 4; it += nblk) { const int gc2 = it >> 2, h = it & 3;
        for (int i = tid; i < 128 * 128; i += NTHREADS) { const int ch = i >> 7, j = i & 127;
            vn[j * 129 + ch] = ldbf(GVT + ((size_t)gc2 * 512 + h * 128 + ch) * 128 + j) * rsqrtf(SSV[gc2 * 128 + j] * (1.f / 512.f) + EPS); }
        __syncthreads();
        const int ch = tid & 127, iq = tid >> 7;
        for (int i = iq * 32; i < iq * 32 + 32; ++i) { float a = bs[h * 128 + i]; const float* w = Ws + ((size_t)h * 128 + i) * 128;
            for (int j = 0; j < 128; ++j) a += w[j] * vn[j * 129 + ch];
            const size_t row = (size_t)gc2 * 128 + i; HS[row * D + 512 + h * 128 + ch] = (bf16)f2bf(ldbf(GU + row * 512 + h * 128 + ch) * a); }
        __syncthreads();
    }
}
__device__ __forceinline__ void ph_nout(const Params& p, int l, int last, LAS unsigned char* lds, int tid, int G) {
    const bf16* QA = (const bf16*)(p.ws + WS_R + R_QA); const bf16* KB = (const bf16*)(p.ws + WS_R + R_KB); const bf16* VT = (const bf16*)(p.ws + WS_R + R_VT);
    const float* EREF = (const float*)(p.ws + WS_R + R_EREF); const bf16* ST = (const bf16*)(p.ws + WS_R + R_ST); const bf16* SG = (const bf16*)(p.ws + WS_R + R_SG);
    bf16* HS = (bf16*)(p.ws + WS_HB); const float* gain = p.in[I_HGN] + l * 512;
    LAS float* sP = (LAS float*)lds;
    LAS unsigned short* sq = (LAS unsigned short*)(lds + 16640);
    LAS unsigned short* sk = sq + 2 * 64 * 130;
    LAS float* sO = (LAS float*)(lds + 16640 + 4 * 64 * 130 * 2);
    for (int it = blockIdx.x; it < NCH * 4; it += G) { const int gc = it >> 2, h = it & 3;
        if (last && (gc % 68) >= 64) continue;
        for (int i = tid; i < 2 * 64 * 128; i += NTHREADS) { const int dir = i >> 13, r = (i >> 7) & 63, d = i & 127; const size_t g = (size_t)dir * M * 512 + ((size_t)gc * 64 + r) * 512 + h * 128 + d;
            sq[(dir * 64 + r) * 130 + d] = QA[g]; sk[(dir * 64 + r) * 130 + d] = KB[g]; }
        __syncthreads();
        { const int i = tid >> 3, jg = tid & 7;
          for (int jj = 0; jj < 8; ++jj) { const int j = jg * 8 + jj; float a = 0.f;
              if (j <= i) for (int d = 0; d < 128; ++d) a += bf2f(sq[i * 130 + d]) * bf2f(sk[j * 130 + d]);
              if (j >= i) for (int d = 0; d < 128; ++d) a += bf2f(sq[(64 + i) * 130 + d]) * bf2f(sk[(64 + j) * 130 + d]);
              sP[i * 65 + j] = a; } }
        __syncthreads();
        for (int i = tid; i < 2 * 64 * 128; i += NTHREADS) { const int dir = i >> 13, r = (i >> 7) & 63, d = i & 127;
            sq[(dir * 64 + r) * 130 + d] = (unsigned short)f2bf(bf2f(sq[(dir * 64 + r) * 130 + d]) * EREF[((size_t)dir * NCH + gc) * 512 + h * 128 + d]); }
        __syncthreads();
        { const int e = tid & 127, ig = tid >> 7; float acc[16];
#pragma unroll
          for (int ii = 0; ii < 16; ++ii) acc[ii] = 0.f;
          const bf16* sf = ST + ((((size_t)gc * 2 + 0) * 4 + h) * 128 + e) * 128; const bf16* sb = ST + ((((size_t)gc * 2 + 1) * 4 + h) * 128 + e) * 128;
          for (int d = 0; d < 128; ++d) { const float a = ldbf(sf + d), bb = ldbf(sb + d);
#pragma unroll
              for (int ii = 0; ii < 16; ++ii) acc[ii] += bf2f(sq[(ig * 16 + ii) * 130 + d]) * a + bf2f(sq[(64 + ig * 16 + ii) * 130 + d]) * bb; }
          const bf16* vr = VT + ((size_t)gc * 512 + h * 128 + e) * 64;
          for (int j = 0; j < 64; ++j) { const float v = ldbf(vr + j);
#pragma unroll
              for (int ii = 0; ii < 16; ++ii) acc[ii] += sP[(ig * 16 + ii) * 65 + j] * v; }
#pragma unroll
          for (int ii = 0; ii < 16; ++ii) sO[(ig * 16 + ii) * 129 + e] = acc[ii]; }
        __syncthreads();
        { const int w = tid >> 6, lane = tid & 63;
          for (int i = w * 8; i < w * 8 + 8; ++i) { const float o0 = sO[i * 129 + lane], o1 = sO[i * 129 + 64 + lane]; const float rs = rsqrtf(wave_sum(o0 * o0 + o1 * o1) * (1.f / 128.f) + EPS);
              const size_t row = (size_t)gc * 64 + i; const int c0 = h * 128 + lane, c1 = c0 + 64;
              HS[row * D + c0] = (bf16)f2bf(o0 * rs * gain[c0] * ldbf(SG + row * 512 + c0)); HS[row * D + c1] = (bf16)f2bf(o1 * rs * gain[c1] * ldbf(SG + row * 512 + c1)); } }
        __syncthreads();
    }
}
typedef short bf16x8 __attribute__((ext_vector_type(8)));
typedef short s16x4 __attribute__((ext_vector_type(4)));
typedef float f32x16 __attribute__((ext_vector_type(16)));
#define MFMA32(a, b, c) __builtin_amdgcn_mfma_f32_32x32x16_bf16((a), (b), (c), 0, 0, 0)
__device__ __forceinline__ bf16x8 ld8(const bf16* q) { return *(const bf16x8*)q; }
__device__ __forceinline__ bf16x8 ld44(const bf16* q0, const bf16* q1) { const s16x4 lo = *(const s16x4*)q0, hi = *(const s16x4*)q1; return __builtin_shufflevector(lo, hi, 0, 1, 2, 3, 4, 5, 6, 7); }
__device__ __forceinline__ f32x16 zero16() { f32x16 z;
#pragma unroll
    for (int i = 0; i < 16; ++i) z[i] = 0.f; return z; }
__device__ __forceinline__ bf16x8 pack_acc(const f32x16& x, int s) { u32x4 w; w.x = pk2(x[8 * s], x[8 * s + 1]); w.y = pk2(x[8 * s + 2], x[8 * s + 3]); w.z = pk2(x[8 * s + 4], x[8 * s + 5]); w.w = pk2(x[8 * s + 6], x[8 * s + 7]); return __builtin_bit_cast(bf16x8, w); }
__device__ __forceinline__ bf16x8 scale8(bf16x8 f, f32x4 a, f32x4 b) { const u32x4 w = __builtin_bit_cast(u32x4, f); u32x4 o;
    o.x = pk2(bf2f(w.x & 0xffffu) * a[0], bf2f(w.x >> 16) * a[1]); o.y = pk2(bf2f(w.y & 0xffffu) * a[2], bf2f(w.y >> 16) * a[3]);
    o.z = pk2(bf2f(w.z & 0xffffu) * b[0], bf2f(w.z >> 16) * b[1]); o.w = pk2(bf2f(w.w & 0xffffu) * b[2], bf2f(w.w >> 16) * b[3]); return __builtin_bit_cast(bf16x8, o); }

__device__ __forceinline__ void ph_scan(const Params& p, int last, int lane, int wave) {
    const int item = blockIdx.x, h = item & 3, dir = (item >> 2) & 1, b = item >> 3, dt = wave >> 1, et0 = 2 * (wave & 1), r = lane & 31, hh = lane >> 5;
    const bf16* KDT = (const bf16*)(p.ws + WS_R + R_KDT) + (size_t)dir * M * 512 + (size_t)(h * 128 + 32 * dt + r) * 64 + 8 * hh;
    const bf16* VT = (const bf16*)(p.ws + WS_R + R_VT) + (size_t)(h * 128 + 32 * et0 + r) * 64 + 8 * hh;
    const float* DEC = (const float*)(p.ws + WS_R + R_DEC) + (size_t)dir * NCH * 512 + h * 128 + 32 * dt + 4 * hh;
    bf16* ST = (bf16*)(p.ws + WS_R + R_ST) + ((size_t)dir * 4 + h) * 16384 + (size_t)(32 * et0 + r) * 128 + 32 * dt + 4 * hh;
    f32x16 S0 = zero16(), S1 = zero16();
    bf16x8 a[4], b0[4], b1[4]; f32x4 dc[4];
    { const size_t g = (size_t)(b * 68 + scan_chunk(0, dir)) * 512;
#pragma unroll
      for (int s = 0; s < 4; ++s) { a[s] = ld8(KDT + g * 64 + 16 * s); b0[s] = ld8(VT + g * 64 + 16 * s); b1[s] = ld8(VT + g * 64 + 32 * 64 + 16 * s); dc[s] = *(const f32x4*)(DEC + g + 8 * s); } }
    for (int step = 0; step < 68; ++step) {
        const int c = scan_chunk(step, dir); const size_t gc = (size_t)(b * 68 + c);
        bf16x8 na[4], nb0[4], nb1[4]; f32x4 ndc[4];
        { const size_t g = (size_t)(b * 68 + scan_chunk(step < 67 ? step + 1 : 67, dir)) * 512;
#pragma unroll
          for (int s = 0; s < 4; ++s) { na[s] = ld8(KDT + g * 64 + 16 * s); nb0[s] = ld8(VT + g * 64 + 16 * s); nb1[s] = ld8(VT + g * 64 + 32 * 64 + 16 * s); ndc[s] = *(const f32x4*)(DEC + g + 8 * s); } }
        if (!(last && c >= 64)) { bf16* o = ST + gc * (2 * 4 * 16384);
#pragma unroll
            for (int g = 0; g < 4; ++g) { u32x2 w0, w1; w0.x = pk2(S0[4 * g], S0[4 * g + 1]); w0.y = pk2(S0[4 * g + 2], S0[4 * g + 3]); w1.x = pk2(S1[4 * g], S1[4 * g + 1]); w1.y = pk2(S1[4 * g + 2], S1[4 * g + 3]);
                *(u32x2*)(o + 8 * g) = w0; *(u32x2*)(o + 32 * 128 + 8 * g) = w1; } }
#pragma unroll
        for (int g = 0; g < 4; ++g)
#pragma unroll
            for (int q = 0; q < 4; ++q) { S0[4 * g + q] *= dc[g][q]; S1[4 * g + q] *= dc[g][q]; }
#pragma unroll
        for (int s = 0; s < 4; ++s) { S0 = MFMA32(a[s], b0[s], S0); S1 = MFMA32(a[s], b1[s], S1); }
#pragma unroll
        for (int s = 0; s < 4; ++s) { a[s] = na[s]; b0[s] = nb0[s]; b1[s] = nb1[s]; dc[s] = ndc[s]; }
    }
}
__device__ __forceinline__ void ph_sgu(const Params& p, int l, int lane, int wave, int first, int nblk) {
    const bf16* GVT = (const bf16*)(p.ws + WS_R + R_GVT); const bf16* GU = (const bf16*)(p.ws + WS_R + R_GU); bf16* HS = (bf16*)(p.ws + WS_HB);
    const float* SSV = (const float*)(p.ws + WS_ZERO + Z_SSV) + (size_t)l * M; const bf16* WSB = (const bf16*)(p.ws + WS_WSB) + (size_t)l * 4 * 128 * 128; const float* bs = p.in[I_SGB] + l * 512;
    const int r = lane & 31, hh = lane >> 5;
    for (int it = ((int)blockIdx.x - first) * NWAVES + wave; it < NCH2 * 16; it += nblk * NWAVES) { const int gc2 = it >> 4, h = (it >> 2) & 3, cht = it & 3;
        const bf16* ap = GVT + ((size_t)gc2 * 512 + h * 128 + 32 * cht + r) * 128 + 8 * hh; const float* sp = SSV + gc2 * 128 + 8 * hh; const bf16* wp = WSB + ((size_t)h * 128 + r) * 128 + 8 * hh;
        f32x16 acc[4] = {zero16(), zero16(), zero16(), zero16()};
#pragma unroll
        for (int s = 0; s < 8; ++s) { f32x4 s0 = *(const f32x4*)(sp + 16 * s), s1 = *(const f32x4*)(sp + 16 * s + 4);
#pragma unroll
            for (int q = 0; q < 4; ++q) { s0[q] = rsqrtf(s0[q] * (1.f / 512.f) + EPS); s1[q] = rsqrtf(s1[q] * (1.f / 512.f) + EPS); }
            const bf16x8 a = scale8(ld8(ap + 16 * s), s0, s1);
#pragma unroll
            for (int t = 0; t < 4; ++t) acc[t] = MFMA32(a, ld8(wp + (size_t)t * 32 * 128 + 16 * s), acc[t]); }
#pragma unroll
        for (int t = 0; t < 4; ++t) { const int i = 32 * t + r; const size_t row = (size_t)gc2 * 128 + i; const float bias = bs[h * 128 + i];
#pragma unroll
            for (int g = 0; g < 4; ++g) { const int ch = h * 128 + 32 * cht + 8 * g + 4 * hh; const u32x2 u = *(const u32x2*)(GU + row * 512 + ch);
                u32x2 w; w.x = pk2(bf2f(u.x & 0xffffu) * (acc[t][4 * g] + bias), bf2f(u.x >> 16) * (acc[t][4 * g + 1] + bias)); w.y = pk2(bf2f(u.y & 0xffffu) * (acc[t][4 * g + 2] + bias), bf2f(u.y >> 16) * (acc[t][4 * g + 3] + bias));
                *(u32x2*)(HS + row * D + 512 + ch) = w; } }
    }
}
__device__ __forceinline__ f32x16 score_tile(const bf16* kbp, const bf16x8 (&qa)[8]) { f32x16 acc = zero16();
#pragma unroll
    for (int s = 0; s < 8; ++s) acc = MFMA32(ld8(kbp + 16 * s), qa[s], acc);
    return acc; }
__device__ __forceinline__ void ph_out(const Params& p, int l, int last, int lane, int wave, int G) {
    const bf16* QA = (const bf16*)(p.ws + WS_R + R_QA); const bf16* KB = (const bf16*)(p.ws + WS_R + R_KB); const bf16* VT = (const bf16*)(p.ws + WS_R + R_VT);
    const float* EREF = (const float*)(p.ws + WS_R + R_EREF); const bf16* ST = (const bf16*)(p.ws + WS_R + R_ST); const bf16* SG = (const bf16*)(p.ws + WS_R + R_SG);
    bf16* HS = (bf16*)(p.ws + WS_HB); const float* gain = p.in[I_HGN] + l * 512;
    const int r = lane & 31, hh = lane >> 5;
    for (int it = blockIdx.x * NWAVES + wave; it < NCH * 8; it += G * NWAVES) { const int gc = it >> 3, h = (it >> 1) & 3, ih = it & 1;
        if (last && (gc % 68) >= 64) continue;
        f32x16 o[4] = {zero16(), zero16(), zero16(), zero16()}; f32x16 Pd, Po;
#pragma unroll
        for (int dir = 0; dir < 2; ++dir) {
            const bf16* qp = QA + (size_t)dir * M * 512 + ((size_t)gc * 64 + 32 * ih + r) * 512 + h * 128 + 8 * hh;
            const bf16* kp = KB + (size_t)dir * M * 512 + ((size_t)gc * 64 + r) * 512 + h * 128 + 8 * hh;
            bf16x8 qa[8];
#pragma unroll
            for (int s = 0; s < 8; ++s) qa[s] = ld8(qp + 16 * s);
            { f32x16 t = score_tile(kp + (size_t)ih * 32 * 512, qa);
#pragma unroll
              for (int q = 0; q < 16; ++q) { const int j = (q & 3) + 8 * (q >> 2) + 4 * hh; const bool keep = dir == 0 ? (j <= r) : (j >= r); const float v = keep ? t[q] : 0.f; if (dir == 0) Pd[q] = v; else Pd[q] += v; } }
            if ((dir == 0) == (ih == 1)) Po = score_tile(kp + (size_t)(1 - ih) * 32 * 512, qa);
            const float* ep = EREF + ((size_t)dir * NCH + gc) * 512 + h * 128 + 8 * hh;
#pragma unroll
            for (int s = 0; s < 8; ++s) qa[s] = scale8(qa[s], *(const f32x4*)(ep + 16 * s), *(const f32x4*)(ep + 16 * s + 4));
            const bf16* sp = ST + (((size_t)gc * 2 + dir) * 4 + h) * 16384 + (size_t)r * 128 + 8 * hh;
#pragma unroll
            for (int et = 0; et < 4; ++et)
#pragma unroll
                for (int s = 0; s < 8; ++s) o[et] = MFMA32(ld8(sp + (size_t)et * 32 * 128 + 16 * s), qa[s], o[et]);
        }
        {
            const bf16* vp = VT + ((size_t)gc * 512 + h * 128 + r) * 64 + 4 * hh;
#pragma unroll
            for (int s = 0; s < 2; ++s) { const bf16x8 pd = pack_acc(Pd, s), po = pack_acc(Po, s); const int jd = 32 * ih + 16 * s, jo = 32 * (1 - ih) + 16 * s;
#pragma unroll
                for (int et = 0; et < 4; ++et) { const bf16* v = vp + (size_t)et * 32 * 64;
                    o[et] = MFMA32(ld44(v + jd, v + jd + 8), pd, o[et]); o[et] = MFMA32(ld44(v + jo, v + jo + 8), po, o[et]); } }
        }
        float ss = 0.f;
#pragma unroll
        for (int et = 0; et < 4; ++et)
#pragma unroll
            for (int q = 0; q < 16; ++q) ss += o[et][q] * o[et][q];
        ss += __shfl_xor(ss, 32);
        const float rs = rsqrtf(ss * (1.f / 128.f) + EPS); const size_t row = (size_t)gc * 64 + 32 * ih + r;
#pragma unroll
        for (int et = 0; et < 4; ++et)
#pragma unroll
            for (int g = 0; g < 4; ++g) { const int c = h * 128 + 32 * et + 8 * g + 4 * hh; const f32x4 gn = *(const f32x4*)(gain + c); const u32x2 sg = *(const u32x2*)(SG + row * 512 + c);
                u32x2 w; w.x = pk2(o[et][4 * g] * rs * gn[0] * bf2f(sg.x & 0xffffu), o[et][4 * g + 1] * rs * gn[1] * bf2f(sg.x >> 16));
                w.y = pk2(o[et][4 * g + 2] * rs * gn[2] * bf2f(sg.y & 0xffffu), o[et][4 * g + 3] * rs * gn[3] * bf2f(sg.y >> 16));
                *(u32x2*)(HS + row * D + c) = w; }
    }
}
constexpr int PH_PRO = 0, PH_H1 = 1, PH_L0 = 2, PH_PER_LAYER = 10, PH_END = PH_L0 + 2 * PH_PER_LAYER;
__device__ __forceinline__ void* launder_ptr(void* q) { unsigned long long v = (unsigned long long)q; asm volatile("" : "+s"(v)); return (void*)v; }
__global__ void __launch_bounds__(NTHREADS, 2) mk(Params p, int ph_lo, int ph_hi) {
    extern __shared__ __attribute__((aligned(16))) unsigned char lds_raw[];
    LAS unsigned char* lds = (LAS unsigned char*)lds_raw;
    const int G = gridDim.x;
    cg::grid_group grid = cg::this_grid();
    for (int ph = ph_lo; ph < ph_hi; ++ph) {
        int tid = threadIdx.x; asm volatile("" : "+v"(tid));
        p.ws = (unsigned char*)launder_ptr(p.ws);
        const int lane = tid & 63, wave = __builtin_amdgcn_readfirstlane(tid >> 6);
        if (ph == PH_PRO) ph_prologue(p, lds, tid, lane, wave, G);
        else if (ph == PH_H1) ph_h1_first(p, lane, wave, G);
        else {
            const int l = (ph - PH_L0) / PH_PER_LAYER, s = (ph - PH_L0) % PH_PER_LAYER, last = l == 1;
            const float* modl = (const float*)(p.ws + WS_MOD) + (size_t)l * 9 * 6144;
            if (s == 0) {
                pg8::Gemm g{(const bf16*)(p.ws + WS_HB), (const bf16*)(p.ws + WS_WIN) + (size_t)l * INW * D, M, INW, D};
                pg8::DenseOrder S; S.init(M / 256, INW / 256, G, (int)blockIdx.x, 0);
                unsigned char* R = p.ws + WS_R;
                pg8::EpiInProj E{(bf16*)(R + R_QA), (bf16*)(R + R_KB), (bf16*)(R + R_KDT), (bf16*)(R + R_VT), (bf16*)(R + R_SG), (bf16*)(R + R_GU), (bf16*)(R + R_GVT), (float*)(R + R_EREF), (float*)(R + R_DEC),
                                 (float*)(p.ws + WS_ZERO + Z_SSV) + (size_t)l * M, (const float*)(p.ws + WS_LBV) + l * 1024, p.in[I_SGN] + l * 512, (size_t)M * 512, NCH};
                pg8::gemm_phase<pg8::EpiInProj, pg8::DenseOrder, true, true>(lds, g, S, E, tid);
            } else if (s == 1) { if (blockIdx.x < 64) ph_scan(p, last, lane, wave); else ph_sgu(p, l, lane, wave, 64, G - 64); }
            else if (s == 2) ph_out(p, l, last, lane, wave, G);
            else if (s == 3) {
                pg8::Gemm g{(const bf16*)(p.ws + WS_HB), (const bf16*)(p.ws + WS_WOUT) + (size_t)l * D * D, M, D, D};
                pg8::DenseOrder S; S.init(last ? NB * 16 : M / 256, D / 256, G, (int)blockIdx.x, last);
                pg8::EpiResid E{l == 0 ? p.in[I_X] : p.out, l == 0 ? p.in[I_CTX] : (const float*)(p.ws + WS_XC), p.out, (float*)(p.ws + WS_XC), modl, (float*)(p.ws + WS_ZERO + Z_SS2) + (size_t)l * M};
                pg8::gemm_phase<pg8::EpiResid, pg8::DenseOrder, true, true>(lds, g, S, E, tid);
            } else if (s == 4) ph_moe_wconv(p, l, lds, lane, wave, G);
            else if (s == 5) ph_router(p, l, last, lds, tid, lane, wave, G);
            else if (s == 6) ph_place(p, l, last, lds, tid, lane, wave, G);
            else if (s == 7) {
                const int* TILE = (const int*)(p.ws + WS_TILE); const int nt = __builtin_amdgcn_readfirstlane(TILE[MT_MAX]);
                pg8::Gemm g{(const bf16*)(p.ws + WS_R + R_BUF), (const bf16*)(p.ws + WS_R + R_WGU), NSLOT_PAD, 1024, D};
                pg8::MoeOrder S; S.init(TILE, nt, 4, G, (int)blockIdx.x, 4);
                pg8::EpiSwiglu E{(bf16*)(p.ws + WS_R + R_ACT)};
                pg8::gemm_phase<pg8::EpiSwiglu, pg8::MoeOrder, true, true>(lds, g, S, E, tid);
            } else if (s == 8) {
                const int* TILE = (const int*)(p.ws + WS_TILE); const int nt = __builtin_amdgcn_readfirstlane(TILE[MT_MAX]);
                pg8::Gemm g{(const bf16*)(p.ws + WS_R + R_ACT), (const bf16*)(p.ws + WS_R + R_WD), NSLOT_PAD, D, DE};
                pg8::MoeOrder S; S.init(TILE, nt, 4, G, (int)blockIdx.x, 4);
                pg8::EpiStoreBf16 E{(bf16*)(p.ws + WS_R + R_Y), D};
                pg8::gemm_phase<pg8::EpiStoreBf16, pg8::MoeOrder, true, true>(lds, g, S, E, tid);
            } else ph_combine(p, l, last, lane, wave, G);
        }
        if (ph + 1 < ph_hi) grid.sync();
    }
}

extern "C" void kernel_launch(void* const* d_in, const int* in_sizes, int n_in, void* d_out, int out_size, void* d_ws, size_t ws_size, hipStream_t stream) {
    static int grid = 0;
    if (grid == 0) {
        if (n_in != 23 || ws_size < WS_END) { fprintf(stderr, "kernel_launch: n_in %d ws %zu need %zu\n", n_in, ws_size, (size_t)WS_END); grid = -1; return; }
        int dev = 0, cus = 0, per_cu = 0;
        hipGetDevice(&dev); hipDeviceGetAttribute(&cus, hipDeviceAttributeMultiprocessorCount, dev);
        hipFuncSetAttribute((const void*)mk, hipFuncAttributeMaxDynamicSharedMemorySize, LDS_BYTES);
        hipOccupancyMaxActiveBlocksPerMultiprocessor(&per_cu, (const void*)mk, NTHREADS, LDS_BYTES);
        (void)hipGetLastError();
        grid = cus * (per_cu >= 1 ? 1 : 0);
        if (grid <= 0) { fprintf(stderr, "kernel_launch: occupancy %d cus %d\n", per_cu, cus); grid = -1; return; }
    }
    if (grid < 0) return;
    hipMemsetAsync((char*)d_ws + WS_ZERO, 0, ZERO_BYTES, stream);
    Params p{};
    for (int i = 0; i < 23; ++i) p.in[i] = (const float*)d_in[i];
    p.out = (float*)d_out; p.ws = (unsigned char*)d_ws;
    int lo = 0, hi = PH_END;
    void* args[] = {&p, &lo, &hi};
    hipError_t e = hipLaunchCooperativeKernel((const void*)mk, dim3(grid), dim3(NTHREADS), args, LDS_BYTES, stream);
    if (e != hipSuccess) fprintf(stderr, "cooperative launch failed: %s (grid %d)\n", hipGetErrorString(e), grid);
}
```

```cpp
#include <hip/hip_runtime.h>
#include <hip/hip_cooperative_groups.h>
#include <cstdio>
#include <cstdint>
namespace cg = cooperative_groups;

constexpr int D = 1024, NB = 8, SEQ = 4096, CL = 256, RB = SEQ + CL  , M = NB * RB  ;
constexpr int INW = 3584, NEXP = 32, DE = 512, NSLOT = M * 2, NSLOT_PAD = NSLOT + NEXP * 256, MT_MAX = NSLOT_PAD / 256;
constexpr float EPS = 1e-6f;

namespace pg8 {
#define PG8_LAS __attribute__((address_space(3)))
typedef unsigned short bf16_t;
typedef short bf16x8 __attribute__((ext_vector_type(8)));
typedef float f32x4 __attribute__((ext_vector_type(4)));
typedef unsigned u32x4 __attribute__((ext_vector_type(4)));
constexpr int BM = 256, BK = 64, HALF = 128, HTB = HALF * BK * 2  , STAGE_BYTES = 8 * HTB, NXCD = 8, WGM = 8;

__host__ __device__ __forceinline__ int lds_byte(int r, int c) { const int st = (r >> 4) * 2 + (c >> 5), rr = r & 15, cc = c & 31, ob = rr * 64 + cc * 2; return st * 1024 + (ob ^ (((ob >> 9) & 1) << 5)); }
__host__ __device__ __forceinline__ void stage_rc(int b, int& R, int& C) { const int st = b / 1024, sb = b % 1024, swz = sb ^ (((sb >> 9) & 1) << 5); R = (st >> 1) * 16 + swz / 64; C = (st & 1) * 32 + (swz % 64) / 2; }
__host__ __device__ __forceinline__ int perm32(int rho) { const int n = rho >> 4, i = rho & 15; return 8 * (i >> 2) + 4 * n + (i & 3); }

struct Unit { int pm, pn, pb; };
struct Gemm { const bf16_t* A; const bf16_t* Bt; int M, N, K; };

struct StaticOrder {
    int nM, nN, nwg, G, c;
    __host__ __device__ void init(int M, int N, int G_, int c_) { nM = M / BM; nN = N / BM; nwg = nM * nN; G = G_; c = c_; }
    __host__ __device__ bool next(int i, Unit& u) const {
        const long L = (long)i * G + c; if (L >= nwg) return false;
        int wgid = (int)L; { const int q = nwg / NXCD, r = nwg % NXCD, xcd = wgid % NXCD, off = wgid / NXCD; wgid = (xcd < r ? xcd * (q + 1) : r * (q + 1) + (xcd - r) * q) + off; }
        const int nig = WGM * nN, gid = wgid / nig, fm = gid * WGM, gsz = (nM - fm) < WGM ? (nM - fm) : WGM;
        u.pm = fm + ((wgid % nig) % gsz); u.pn = (wgid % nig) / gsz; u.pb = u.pn; return true;
    }
    __device__ __forceinline__ void a_ready(const Unit&) const {}
    __device__ __forceinline__ void done(const Unit&) const {}
};

__device__ __forceinline__ unsigned cvt_pk_bf16(float lo, float hi) { unsigned r; asm volatile("v_cvt_pk_bf16_f32 %0, %1, %2" : "=v"(r) : "v"(lo), "v"(hi)); return r; }
typedef float f32x2 __attribute__((ext_vector_type(2)));
struct DenseOrder {
    int nM, nN, nwg, G, c, lat_only;
    __device__ void init(int nM_, int nN_, int G_, int c_, int lat_only_) { nM = nM_; nN = nN_; nwg = nM * nN; G = G_; c = c_; lat_only = lat_only_; }
    __device__ bool next(int i, Unit& u) const {
        const long L = (long)i * G + c; if (L >= nwg) return false;
        int wgid = (int)L; { const int q = nwg / NXCD, r = nwg % NXCD, xcd = wgid % NXCD, off = wgid / NXCD; wgid = (xcd < r ? xcd * (q + 1) : r * (q + 1) + (xcd - r) * q) + off; }
        const int nig = WGM * nN, gid = wgid / nig, fm = gid * WGM, gsz = (nM - fm) < WGM ? (nM - fm) : WGM;
        int pm = fm + ((wgid % nig) % gsz); u.pn = (wgid % nig) / gsz; u.pb = u.pn;
        if (lat_only) pm = (pm >> 4) * 17 + (pm & 15);
        u.pm = pm; return true;
    }
    __device__ __forceinline__ void a_ready(const Unit&) const {}
    __device__ __forceinline__ void done(const Unit&) const {}
};
struct MoeOrder {
    const int* tile_e; int nM, nN, nwg, G, c, nbt;
    __device__ void init(const int* te, int nM_, int nN_, int G_, int c_, int nbt_) { tile_e = te; nM = nM_; nN = nN_; nwg = nM * nN; G = G_; c = c_; nbt = nbt_; }
    __device__ bool next(int i, Unit& u) const {
        const long L = (long)i * G + c; if (L >= nwg) return false;
        int wgid = (int)L; { const int q = nwg / NXCD, r = nwg % NXCD, xcd = wgid % NXCD, off = wgid / NXCD; wgid = (xcd < r ? xcd * (q + 1) : r * (q + 1) + (xcd - r) * q) + off; }
        const int nig = WGM * nN, gid = wgid / nig, fm = gid * WGM, gsz = (nM - fm) < WGM ? (nM - fm) : WGM;
        u.pm = fm + ((wgid % nig) % gsz); u.pn = (wgid % nig) / gsz;
        u.pb = __builtin_amdgcn_readfirstlane(tile_e[u.pm]) * nbt + u.pn; return true;
    }
    __device__ __forceinline__ void a_ready(const Unit&) const {}
    __device__ __forceinline__ void done(const Unit&) const {}
};

__device__ __forceinline__ float fast_silu(float x) { return x * __builtin_amdgcn_rcpf(1.f + __expf(-x)); }
struct EpiStoreBf16 {
    static constexpr bool PERM = true, AFTER_DRAIN = false;
    bf16_t* O; int ldc;
    __device__ __forceinline__ void operator()(const f32x4 (&acc)[2][2][4][2], const Unit& u, int wr, int wc, int fr, int fq) const {
        const int row0 = u.pm * BM + wr * 64 + fr, col0 = u.pn * BM + wc * 32 + 8 * fq;
#pragma unroll
        for (int ai = 0; ai < 2; ++ai)
#pragma unroll
            for (int m = 0; m < 4; ++m) { bf16_t* rowp = O + (size_t)(row0 + ai * HALF + m * 16) * ldc + col0;
#pragma unroll
                for (int bj = 0; bj < 2; ++bj) { const f32x4 v0 = acc[ai][bj][m][0], v1 = acc[ai][bj][m][1];
                    u32x4 w; w.x = cvt_pk_bf16(v0[0], v0[1]); w.y = cvt_pk_bf16(v0[2], v0[3]); w.z = cvt_pk_bf16(v1[0], v1[1]); w.w = cvt_pk_bf16(v1[2], v1[3]);
                    *(u32x4*)(rowp + bj * HALF) = w; } }
    }
};
struct EpiSwiglu {
    static constexpr bool PERM = true, AFTER_DRAIN = false;
    bf16_t* ACT;
    __device__ __forceinline__ void operator()(const f32x4 (&acc)[2][2][4][2], const Unit& u, int wr, int wc, int fr, int fq) const {
        const int row0 = u.pm * BM + wr * 64 + fr, col0 = u.pn * HALF + wc * 32 + 8 * fq;
#pragma unroll
        for (int ai = 0; ai < 2; ++ai)
#pragma unroll
            for (int m = 0; m < 4; ++m) { bf16_t* rowp = ACT + (size_t)(row0 + ai * HALF + m * 16) * DE + col0;
                const f32x4 g0 = acc[ai][0][m][0], g1 = acc[ai][0][m][1], u0 = acc[ai][1][m][0], u1 = acc[ai][1][m][1];
                u32x4 w; w.x = cvt_pk_bf16(fast_silu(g0[0]) * u0[0], fast_silu(g0[1]) * u0[1]); w.y = cvt_pk_bf16(fast_silu(g0[2]) * u0[2], fast_silu(g0[3]) * u0[3]);
                w.z = cvt_pk_bf16(fast_silu(g1[0]) * u1[0], fast_silu(g1[1]) * u1[1]); w.w = cvt_pk_bf16(fast_silu(g1[2]) * u1[2], fast_silu(g1[3]) * u1[3]);
                *(u32x4*)rowp = w; }
    }
};
#define DPP_F(x, ctrl) __uint_as_float((unsigned)__builtin_amdgcn_update_dpp(0, (int)__float_as_uint(x), (ctrl), 0xf, 0xf, false))
__device__ __forceinline__ float row_allsum16(float x) { x += DPP_F(x, 0xB1); x += DPP_F(x, 0x4E); x += DPP_F(x, 0x141); x += DPP_F(x, 0x140); return x; }
__device__ __forceinline__ float row_incl_scan16(float x) { x += DPP_F(x, 0x111); x += DPP_F(x, 0x112); x += DPP_F(x, 0x114); x += DPP_F(x, 0x118); return x; }
__device__ __forceinline__ float fast_sigmoid(float x) { return __builtin_amdgcn_rcpf(1.f + __expf(-x)); }
__device__ __forceinline__ float fast_gelu(float x) { return x * fast_sigmoid(1.5957691216057308f * (x + 0.044715f * x * x * x)); }
__device__ __forceinline__ bf16_t bf16_1(float x) { return (bf16_t)(cvt_pk_bf16(x, 0.f) & 0xffffu); }
struct EpiInProj {
    static constexpr bool PERM = true, AFTER_DRAIN = false;
    bf16_t *QA, *KB, *KDT, *VT, *SG, *GU, *GVT; float *EREF, *DEC, *SSV; const float* LBV; const float* vgain; size_t dstride; int nch;
    __device__ __forceinline__ void operator()(const f32x4 (&acc)[2][2][4][2], const Unit& u, int wr, int wc, int fr, int fq) const {
        if (u.pn < 8) hgrn(acc, u, wr, wc, fr, fq); else if (u.pn < 12) actv(acc, u, wr, wc, fr, fq); else vtile(acc, u, wr, wc, fr, fq);
    }
    __device__ __forceinline__ void hgrn(const f32x4 (&acc)[2][2][4][2], const Unit& u, int wr, int wc, int fr, int fq) const {
        const int h = u.pn >> 1, dloc = (u.pn & 1) * 64 + 16 * wc + 4 * fq, dcol = h * 128 + dloc;
        const f32x4 lbf = *(const f32x4*)(LBV + dcol), lbb = *(const f32x4*)(LBV + 512 + dcol);
#pragma unroll
        for (int ai = 0; ai < 2; ++ai) {
            const int rowc = u.pm * BM + ai * HALF + wr * 64, gc = rowc >> 6;
            const size_t cb = ((size_t)(gc * 4 + h) * 4 + (dloc >> 5)) * 4;
            const int cl = ((dloc & 31) + 32 * (fr >> 3)) * 8 + (fr & 7);
            unsigned pqa[2][4][2], pkb[2][4][2]; float hqa[2][4], hkb[2][4];
#pragma unroll
            for (int e = 0; e < 4; ++e) {
#pragma unroll
                for (int dir = 0; dir < 2; ++dir) {
                    const float lb = dir ? lbb[e] : lbf[e];
                    float lf[4], kk[4], x[4], T[4];
#pragma unroll
                    for (int m = 0; m < 4; ++m) { const float z = dir ? acc[ai][1][m][0][e] : acc[ai][0][m][1][e]; const float sig = fast_sigmoid(z);
                        lf[m] = __logf(lb + (1.f - lb) * sig); kk[m] = (1.f - lb) * (1.f - sig); x[m] = lf[m]; }
#pragma unroll
                    for (int m = 0; m < 4; ++m) { T[m] = row_allsum16(x[m]); x[m] = row_incl_scan16(x[m]); }
                    const float t01 = T[0] + T[1], tot = t01 + T[2] + T[3];
                    float cum[4] = {x[0], x[1] + T[0], x[2] + t01, x[3] + t01 + T[2]}; float ref = t01;
                    if (dir) {
#pragma unroll
                        for (int m = 0; m < 4; ++m) cum[m] = tot - cum[m] + lf[m];
                        ref = tot - t01; }
                    const float etr = __expf(tot - ref);
#pragma unroll
                    for (int m = 0; m < 4; ++m) { const float q = acc[ai][0][m][0][e];
                        const float qa = q * __expf(cum[m] - ref), kb = kk[m] * __expf(ref - cum[m]), kd = kb * etr;
                        KDT[dir * dstride + ((cb + m) * 64) * 8 + cl + 8 * e] = bf16_1(kd);
                        if (e & 1) { pqa[dir][m][e >> 1] = cvt_pk_bf16(hqa[dir][m], qa); pkb[dir][m][e >> 1] = cvt_pk_bf16(hkb[dir][m], kb); } else { hqa[dir][m] = qa; hkb[dir][m] = kb; } }
                    if (fr == 0) { EREF[((size_t)dir * nch + gc) * 512 + dcol + e] = __expf(ref); DEC[((size_t)dir * nch + gc) * 512 + dcol + e] = __expf(tot); }
                }
#pragma unroll
                for (int m = 0; m < 4; ++m) VT[((cb + m) * 64) * 8 + cl + 8 * e] = bf16_1(acc[ai][1][m][1][e]);
            }
#pragma unroll
            for (int dir = 0; dir < 2; ++dir)
#pragma unroll
                for (int m = 0; m < 4; ++m) {
                    const size_t o = dir * dstride + (((((size_t)(gc * 4 + h) * 2 + (m >> 1)) * 8 + (dloc >> 4)) * 64) + 16 * (m & 1) + fr + 32 * (fq & 1)) * 8 + 4 * (fq >> 1);
                    typedef unsigned u32x2v __attribute__((ext_vector_type(2)));
                    *(u32x2v*)(QA + o) = (u32x2v){pqa[dir][m][0], pqa[dir][m][1]}; *(u32x2v*)(KB + o) = (u32x2v){pkb[dir][m][0], pkb[dir][m][1]}; }
        }
    }
    __device__ __forceinline__ void actv(const f32x4 (&acc)[2][2][4][2], const Unit& u, int wr, int wc, int fr, int fq) const {
        const bool isu = u.pn >= 10; bf16_t* O = isu ? GU : SG;
        const int row0 = u.pm * BM + wr * 64 + fr, col0 = (u.pn & 1) * 256 + wc * 32 + 8 * fq;
#pragma unroll
        for (int ai = 0; ai < 2; ++ai)
#pragma unroll
            for (int m = 0; m < 4; ++m) { bf16_t* rowp = O + (size_t)(row0 + ai * HALF + m * 16) * 512 + col0;
#pragma unroll
                for (int bj = 0; bj < 2; ++bj) { float v[8];
#pragma unroll
                    for (int i = 0; i < 8; ++i) { const float x = acc[ai][bj][m][i >> 2][i & 3]; v[i] = isu ? fast_gelu(x) : x * fast_sigmoid(x); }
                    u32x4 w; w.x = cvt_pk_bf16(v[0], v[1]); w.y = cvt_pk_bf16(v[2], v[3]); w.z = cvt_pk_bf16(v[4], v[5]); w.w = cvt_pk_bf16(v[6], v[7]);
                    *(u32x4*)(rowp + bj * HALF) = w; } }
    }
    __device__ __forceinline__ void vtile(const f32x4 (&acc)[2][2][4][2], const Unit& u, int wr, int wc, int fr, int fq) const {
        const int ch0 = (u.pn & 1) * 256 + wc * 32 + 8 * fq;
        f32x4 gn[2][2];
#pragma unroll
        for (int bj = 0; bj < 2; ++bj)
#pragma unroll
            for (int n = 0; n < 2; ++n) gn[bj][n] = *(const f32x4*)(vgain + ch0 + bj * HALF + 4 * n);
#pragma unroll
        for (int ai = 0; ai < 2; ++ai) { const int gc2 = u.pm * 2 + ai;
#pragma unroll
            for (int m = 0; m < 4; ++m) { const int tok = wr * 64 + 16 * m + fr; float s = 0.f;
#pragma unroll
                for (int bj = 0; bj < 2; ++bj)
#pragma unroll
                    for (int n = 0; n < 2; ++n)
#pragma unroll
                        for (int e = 0; e < 4; ++e) { const float g = fast_gelu(acc[ai][bj][m][n][e]); s += g * g;
                            GVT[(((((size_t)(gc2 * 4 + 2 * (u.pn & 1) + bj) * 4 + wc) * 8 + (tok >> 4)) * 64) + 8 * fq + 4 * n + e + 32 * (fr >> 3)) * 8 + (fr & 7)] = bf16_1(g * gn[bj][n][e]); }
                s += __shfl_xor(s, 16); s += __shfl_xor(s, 32);
                if (fq == 0) atomicAdd(SSV + gc2 * 128 + tok, s); } }
    }
};
struct EpiResid {
    static constexpr bool PERM = false, AFTER_DRAIN = false;
    const float* src_lat; const float* src_ctx; float* dst_lat; float* dst_ctx; const float* modl; float* ss;
    __device__ __forceinline__ void operator()(const f32x4 (&acc)[2][2][4][2], const Unit& u, int wr, int wc, int fr, int fq) const {
        const int b = u.pm / 17, j = u.pm % 17; const bool isctx = j == 16;
        const size_t trow = isctx ? (size_t)b * CL : (size_t)b * SEQ + (size_t)j * 256;
        const float* sb = (isctx ? src_ctx : src_lat) + trow * D; float* db = (isctx ? dst_ctx : dst_lat) + trow * D;
        const float* g1 = modl + (size_t)(isctx ? 8 : b) * 6144 + 2 * 1024;
        const int col0 = u.pn * BM + wc * 32 + 4 * fq;
        f32x4 gv[2][2];
#pragma unroll
        for (int bj = 0; bj < 2; ++bj)
#pragma unroll
            for (int n = 0; n < 2; ++n) gv[bj][n] = *(const f32x4*)(g1 + col0 + bj * HALF + n * 16);
#pragma unroll
        for (int ai = 0; ai < 2; ++ai) {
            f32x4 xs[4][2][2];
#pragma unroll
            for (int m = 0; m < 4; ++m) { const size_t off = (size_t)(ai * HALF + wr * 64 + m * 16 + fr) * D + col0;
#pragma unroll
                for (int bj = 0; bj < 2; ++bj)
#pragma unroll
                    for (int n = 0; n < 2; ++n) xs[m][bj][n] = *(const f32x4*)(sb + off + bj * HALF + n * 16); }
            __builtin_amdgcn_sched_barrier(0);
#pragma unroll
            for (int m = 0; m < 4; ++m) { const int rt = ai * HALF + wr * 64 + m * 16 + fr; const size_t off = (size_t)rt * D + col0; float s = 0.f;
#pragma unroll
                for (int bj = 0; bj < 2; ++bj)
#pragma unroll
                    for (int n = 0; n < 2; ++n) { const f32x4 o = xs[m][bj][n] + gv[bj][n] * acc[ai][bj][m][n];
                        *(f32x4*)(db + off + bj * HALF + n * 16) = o; s += (o[0] * o[0] + o[1] * o[1]) + (o[2] * o[2] + o[3] * o[3]); }
                s += __shfl_xor(s, 16); s += __shfl_xor(s, 32);
                if (fq == 0) atomicAdd(ss + u.pm * BM + rt, s); } }
    }
};
template <class Epi, class Sched, bool ALIGN_EPI = false, bool SP2 = false>
__device__ __forceinline__ void gemm_phase(PG8_LAS unsigned char* lds, const Gemm g, const Sched& S, const Epi& E, const int tid_in) {
    const int tid = tid_in, wid = __builtin_amdgcn_readfirstlane(tid >> 6), lane = tid & 63, wr = wid >> 2, wc = wid & 3, fr = lane & 15, fq = lane >> 4;
    const int K = g.K, nt = K / BK;
    unsigned voffA[2], voffB[2];
#pragma unroll
    for (int i = 0; i < 2; ++i) { int R, C; stage_rc(tid * 16 + i * 8192, R, C); const int Rb = Epi::PERM ? ((R & ~31) + perm32(R & 31)) : R;
        voffA[i] = (unsigned)(R * K + C) * 2u; voffB[i] = (unsigned)(Rb * K + C) * 2u; }
    const size_t kstep = (size_t)(BK * 2);
    const size_t hstep = (size_t)HALF * K * 2;
    const size_t tstep = 2 * hstep;
    const unsigned ldsw = (unsigned)wid * 1024u;
    const int aoff = lds_byte(wr * 64 + fr, fq * 8), boff = lds_byte(wc * 32 + fr, fq * 8);
#define PG8_SA(b, h) (((b) * 2 + (h)) * HTB)
#define PG8_SB(b, h) ((4 + (b) * 2 + (h)) * HTB)
#define PG8_STAGE(bufoff, gbase, voff) do { _Pragma("unroll") for (int _i = 0; _i < 2; ++_i) \
        __builtin_amdgcn_global_load_lds((const unsigned*)((const char*)(gbase) + (voff)[_i]), (PG8_LAS unsigned*)(lds + (bufoff) + ldsw + _i * 8192), 16, 0, 0); } while (0)
#define PG8_LDA(dst, b, h) do { _Pragma("unroll") for (int m = 0; m < 4; ++m) _Pragma("unroll") for (int k = 0; k < 2; ++k) dst[m][k] = *(const PG8_LAS bf16x8*)(lds + PG8_SA(b, h) + aoff + m * 2048 + k * 1024); } while (0)
#define PG8_LDB(dst, b, h) do { _Pragma("unroll") for (int n = 0; n < 2; ++n) _Pragma("unroll") for (int k = 0; k < 2; ++k) dst[n][k] = *(const PG8_LAS bf16x8*)(lds + PG8_SB(b, h) + boff + n * 2048 + k * 1024); } while (0)
#define PG8_MMA(ai, bj, At, Bt) do { __builtin_amdgcn_s_setprio(1); _Pragma("unroll") for (int m = 0; m < 4; ++m) _Pragma("unroll") for (int n = 0; n < 2; ++n) _Pragma("unroll") for (int k = 0; k < 2; ++k) \
        acc[ai][bj][m][n] = __builtin_amdgcn_mfma_f32_16x16x32_bf16(Bt[n][k], At[m][k], acc[ai][bj][m][n], 0, 0, 0); __builtin_amdgcn_s_setprio(0); } while (0)
#define PG8_WAIT_V(n) asm volatile("s_waitcnt vmcnt(" #n ")" ::: "memory")
#define PG8_WAIT_L(n) asm volatile("s_waitcnt lgkmcnt(" #n ")" ::: "memory")
#define PG8_BAR __builtin_amdgcn_s_barrier()
#define PG8_SCHED __builtin_amdgcn_sched_barrier(0)
    Unit cur, nxt; int ui = 0;
    if (!S.next(0, cur)) return;
    f32x4 acc[2][2][4][2];
#pragma unroll
    for (int a = 0; a < 2; ++a)
#pragma unroll
        for (int b = 0; b < 2; ++b)
#pragma unroll
            for (int m = 0; m < 4; ++m)
#pragma unroll
                for (int n = 0; n < 2; ++n) acc[a][b][m][n] = (f32x4){0.f, 0.f, 0.f, 0.f};
    bf16x8 At[4][2], B0[2][2], B1[2][2];
    const char* cA = (const char*)g.A + (size_t)cur.pm * tstep; const char* cB = (const char*)g.Bt + (size_t)cur.pb * tstep;
    S.a_ready(cur);
    if constexpr (SP2) {
        PG8_STAGE(PG8_SB(0, 0), cB, voffB); PG8_STAGE(PG8_SB(0, 1), cB + hstep, voffB); PG8_STAGE(PG8_SA(0, 0), cA, voffA); PG8_STAGE(PG8_SA(0, 1), cA + hstep, voffA);
        if (wr == 1) PG8_BAR;
        PG8_WAIT_V(2); PG8_BAR;
        PG8_STAGE(PG8_SB(1, 0), cB + kstep, voffB); PG8_STAGE(PG8_SA(1, 0), cA + kstep, voffA); PG8_STAGE(PG8_SB(1, 1), cB + hstep + kstep, voffB);
        PG8_WAIT_V(6); PG8_BAR;
    } else {
        PG8_STAGE(PG8_SB(0, 0), cB, voffB); PG8_STAGE(PG8_SA(0, 0), cA, voffA); PG8_STAGE(PG8_SB(0, 1), cB + hstep, voffB); PG8_STAGE(PG8_SA(0, 1), cA + hstep, voffA);
        if (wr == 1) PG8_BAR;
        PG8_WAIT_V(4); PG8_BAR;
        PG8_STAGE(PG8_SB(1, 0), cB + kstep, voffB); PG8_STAGE(PG8_SA(1, 0), cA + kstep, voffA); PG8_STAGE(PG8_SB(1, 1), cB + hstep + kstep, voffB);
        PG8_WAIT_V(6); PG8_BAR;
    }
    for (;;) {
        const bool has_next = S.next(ui + 1, nxt);
        const char* nA = has_next ? (const char*)g.A + (size_t)nxt.pm * tstep : cA; const char* nB = has_next ? (const char*)g.Bt + (size_t)nxt.pb * tstep : cB;
        for (int t = 0; t < nt; t += 2) {
            const bool last = (t == nt - 2);
            const char* a1 = cA + (size_t)(t + 1) * kstep;
            const char* a2 = last ? nA : cA + (size_t)(t + 2) * kstep; const char* b2 = last ? nB : cB + (size_t)(t + 2) * kstep;
            const char* a3 = a2 + kstep; const char* b3 = b2 + kstep;
            if (last && has_next) S.a_ready(nxt);
            if constexpr (SP2) {
            PG8_LDB(B0, 0, 0); PG8_LDB(B1, 0, 1); PG8_SCHED; PG8_LDA(At, 0, 0); PG8_STAGE(PG8_SA(1, 1), a1 + hstep, voffA);
            PG8_WAIT_V(8); PG8_WAIT_L(0); PG8_BAR; PG8_MMA(0, 0, At, B0); PG8_MMA(0, 1, At, B1); PG8_BAR; PG8_SCHED;
            PG8_LDA(At, 0, 1); PG8_STAGE(PG8_SB(0, 0), b2, voffB); PG8_STAGE(PG8_SB(0, 1), b2 + hstep, voffB); PG8_STAGE(PG8_SA(0, 0), a2, voffA);
            PG8_WAIT_V(8); PG8_WAIT_L(0); PG8_BAR; PG8_MMA(1, 0, At, B0); PG8_MMA(1, 1, At, B1); PG8_BAR; PG8_SCHED;
            PG8_LDB(B0, 1, 0); PG8_LDB(B1, 1, 1); PG8_SCHED; PG8_LDA(At, 1, 0); PG8_STAGE(PG8_SA(0, 1), a2 + hstep, voffA);
            PG8_WAIT_V(8); PG8_WAIT_L(0); PG8_BAR; PG8_MMA(0, 0, At, B0); PG8_MMA(0, 1, At, B1); PG8_BAR; PG8_SCHED;
            PG8_LDA(At, 1, 1); PG8_STAGE(PG8_SB(1, 0), b3, voffB); PG8_STAGE(PG8_SB(1, 1), b3 + hstep, voffB); PG8_STAGE(PG8_SA(1, 0), a3, voffA);
            PG8_WAIT_V(8); PG8_WAIT_L(0); PG8_BAR; PG8_MMA(1, 0, At, B0); PG8_MMA(1, 1, At, B1); PG8_BAR; PG8_SCHED;
            } else {
            PG8_LDB(B0, 0, 0); PG8_SCHED; PG8_LDA(At, 0, 0); PG8_STAGE(PG8_SA(1, 1), a1 + hstep, voffA);
            PG8_WAIT_L(8); PG8_BAR; PG8_WAIT_L(0); PG8_MMA(0, 0, At, B0); PG8_BAR; PG8_SCHED;
            PG8_LDB(B1, 0, 1); PG8_STAGE(PG8_SB(0, 0), b2, voffB);
            PG8_BAR; PG8_WAIT_L(0); PG8_MMA(0, 1, At, B1); PG8_BAR;
            PG8_LDA(At, 0, 1); PG8_STAGE(PG8_SA(0, 0), a2, voffA);
            PG8_BAR; PG8_WAIT_L(0); PG8_MMA(1, 0, At, B0); PG8_BAR; PG8_SCHED;
            PG8_STAGE(PG8_SB(0, 1), b2 + hstep, voffB);
            PG8_WAIT_V(6); PG8_BAR; PG8_MMA(1, 1, At, B1); PG8_BAR;
            PG8_LDB(B0, 1, 0); PG8_SCHED; PG8_LDA(At, 1, 0); PG8_STAGE(PG8_SA(0, 1), a2 + hstep, voffA);
            PG8_WAIT_L(8); PG8_BAR; PG8_WAIT_L(0); PG8_MMA(0, 0, At, B0); PG8_BAR; PG8_SCHED;
            PG8_LDB(B1, 1, 1); PG8_STAGE(PG8_SB(1, 0), b3, voffB);
            PG8_BAR; PG8_WAIT_L(0); PG8_MMA(0, 1, At, B1); PG8_BAR;
            PG8_LDA(At, 1, 1); PG8_STAGE(PG8_SA(1, 0), a3, voffA);
            PG8_BAR; PG8_WAIT_L(0); PG8_MMA(1, 0, At, B0); PG8_BAR; PG8_SCHED;
            PG8_STAGE(PG8_SB(1, 1), b3 + hstep, voffB);
            PG8_WAIT_V(6); PG8_BAR; PG8_MMA(1, 1, At, B1); PG8_BAR;
            }
        }
        if constexpr (ALIGN_EPI) { if (wr == 0) PG8_BAR; }
        if constexpr (!Epi::AFTER_DRAIN) { E(acc, cur, wr, wc, fr, fq); S.done(cur); }
        if (!has_next) break;
#pragma unroll
        for (int a = 0; a < 2; ++a)
#pragma unroll
            for (int b = 0; b < 2; ++b)
#pragma unroll
                for (int m = 0; m < 4; ++m)
#pragma unroll
                    for (int n = 0; n < 2; ++n) acc[a][b][m][n] = (f32x4){0.f, 0.f, 0.f, 0.f};
        cur = nxt; cA = nA; cB = nB; ++ui;
        if constexpr (ALIGN_EPI) { if (wr == 1) PG8_BAR; }
    }
    PG8_WAIT_V(0);
    if constexpr (!ALIGN_EPI) { if (wr == 0) PG8_BAR; }
    PG8_BAR;
    if constexpr (Epi::AFTER_DRAIN) { E.fused(acc, cur, wr, wc, fr, fq, lds, wid, lane); S.done(cur); }
#undef PG8_SA
#undef PG8_SB
#undef PG8_STAGE
#undef PG8_LDA
#undef PG8_LDB
#undef PG8_MMA
#undef PG8_WAIT_V
#undef PG8_WAIT_L
#undef PG8_BAR
#undef PG8_SCHED
}
}

#define LAS __attribute__((address_space(3)))
typedef unsigned short bf16;
typedef float f32x4 __attribute__((ext_vector_type(4)));
typedef unsigned u32x4 __attribute__((ext_vector_type(4)));
typedef unsigned u32x2 __attribute__((ext_vector_type(2)));
constexpr int NWAVES = 8, NTHREADS = 512, LDS_BYTES = 160 * 1024;
#define SCHED_FENCE() __builtin_amdgcn_sched_barrier(0)

__device__ __forceinline__ unsigned f2bf(float f) { unsigned u = __float_as_uint(f); return (u + 0x7fffu + ((u >> 16) & 1u)) >> 16; }
__device__ __forceinline__ unsigned pk2(float lo, float hi) { return f2bf(lo) | (f2bf(hi) << 16); }
__device__ __forceinline__ unsigned cvt2(float lo, float hi) { return pg8::cvt_pk_bf16(lo, hi); }
__device__ __forceinline__ float bf2f(unsigned h) { return __uint_as_float(h << 16); }
#define DPPF(x, ctrl) __uint_as_float((unsigned)__builtin_amdgcn_update_dpp(0, (int)__float_as_uint(x), (ctrl), 0xf, 0xf, false))
__device__ __forceinline__ float wave_sum(float v) {
    v += DPPF(v, 0xB1); v += DPPF(v, 0x4E); v += DPPF(v, 0x141); v += DPPF(v, 0x140);
    const float s0 = __uint_as_float(__builtin_amdgcn_readlane(__float_as_uint(v), 0)), s1 = __uint_as_float(__builtin_amdgcn_readlane(__float_as_uint(v), 16));
    const float s2 = __uint_as_float(__builtin_amdgcn_readlane(__float_as_uint(v), 32)), s3 = __uint_as_float(__builtin_amdgcn_readlane(__float_as_uint(v), 48));
    return (s0 + s1) + (s2 + s3);
}
__device__ __forceinline__ float siluf(float x) { return x / (1.f + expf(-x)); }
__device__ __forceinline__ float gelu_tanh(float x) { return 0.5f * x * (1.f + tanhf(0.7978845608028654f * (x + 0.044715f * x * x * x))); }
__device__ __forceinline__ int mod_row(int row) { return ((row % RB) < SEQ) ? row / RB : 8; }
__device__ __forceinline__ bool is_ctx_row(int row) { return (row % RB) >= SEQ; }

typedef __attribute__((address_space(1))) unsigned gu32;
#define RLX_AGENT __ATOMIC_RELAXED, __HIP_MEMORY_SCOPE_AGENT
#define XB_TMO      128
#define XB_XCNT(j)  (256  + 64 * (j))
#define XB_XSUB(j)  (1280 + 64 * (j))
#define XB_XGEN(j)  (2304 + 64 * (j))
#define XB_TOP      3328
#define XB_TOPGEN   3392
#define XCD_BAR_WORDS 3456
#define XB_SPIN_CAP (1u << 18)

__device__ __forceinline__ unsigned xb_ld(unsigned* p)              { return __hip_atomic_load(p, __ATOMIC_RELAXED, __HIP_MEMORY_SCOPE_AGENT); }
__device__ __forceinline__ unsigned xb_add(unsigned* p, unsigned v) { return __hip_atomic_fetch_add(p, v, __ATOMIC_RELAXED, __HIP_MEMORY_SCOPE_AGENT); }
__device__ __forceinline__ unsigned xb_xcc_id() { return (unsigned)__builtin_amdgcn_s_getreg((3 << 11) | 20) & 0xFu; }
#define XB_SPIN(cond, bar) do { unsigned _sp = 0; while (cond) { __builtin_amdgcn_s_sleep(1); \
    if ((++_sp & 255u) == 0u) { if (xb_ld(&(bar)[XB_TMO])) break; if (_sp > XB_SPIN_CAP) { atomicAdd(&(bar)[XB_TMO], 1u); break; } } } } while (0)

struct XcdBarrier {
    unsigned* bar; unsigned x;
    volatile LAS unsigned* st;
};

__device__ __forceinline__ XcdBarrier xcd_barrier_post(unsigned* bar, volatile LAS unsigned* st) {
    XcdBarrier b; b.bar = bar; b.x = xb_xcc_id(); b.st = st;
    if (threadIdx.x == 0) (void)xb_add(&bar[XB_XCNT(b.x)], 1u);
    return b;
}
__device__ __forceinline__ void xcd_barrier_complete(unsigned* bar, unsigned x, unsigned& nloc, unsigned& nx) {
    const unsigned G = gridDim.x * gridDim.y * gridDim.z;
    unsigned sum, cnt, mine, sp = 0u;
    for (;;) {
        sum = 0u; cnt = 0u; mine = 0u;
#pragma unroll
        for (unsigned j = 0; j < 16; ++j) { const unsigned c = xb_ld(&bar[XB_XCNT(j)]); sum += c; cnt += (c > 0u) ? 1u : 0u; mine = (j == x) ? c : mine; }
        if (sum == G) break;
        __builtin_amdgcn_s_sleep(1);
        if ((++sp & 255u) == 0u) { if (xb_ld(&bar[XB_TMO])) break; if (sp > XB_SPIN_CAP) { atomicAdd(&bar[XB_TMO], 1u); break; } }
    }
    nloc = mine > 0u ? mine : 1u; nx = cnt > 0u ? cnt : 1u;
}

__device__ __forceinline__ void xcd_barrier(const XcdBarrier& b, const int xb_tid) {
    asm volatile("s_waitcnt vmcnt(0)" ::: "memory");
    __syncthreads();
    if (xb_tid == 0) {
        unsigned* bar = b.bar;
        __builtin_amdgcn_s_waitcnt(0);
        unsigned nloc = b.st[0], nx = b.st[1];
        if (nloc == 0u) { xcd_barrier_complete(bar, b.x, nloc, nx); b.st[0] = nloc; b.st[1] = nx; }
        const unsigned old = xb_add(&bar[XB_XSUB(b.x)], 1u);
        const unsigned gen = old / nloc;
        if (old + 1u == (gen + 1u) * nloc) {
            __builtin_amdgcn_fence(__ATOMIC_RELEASE, "agent");
            asm volatile("s_waitcnt vmcnt(0)" ::: "memory");
            const unsigned og = xb_add(&bar[XB_TOP], 1u);
            const unsigned tg = og / nx;
            if (og + 1u == (tg + 1u) * nx) xb_add(&bar[XB_TOPGEN], 1u);
            else XB_SPIN(xb_ld(&bar[XB_TOPGEN]) == tg, bar);
            __builtin_amdgcn_fence(__ATOMIC_ACQUIRE, "agent");
            xb_add(&bar[XB_XGEN(b.x)], 1u);
            asm volatile("s_waitcnt vmcnt(0)" ::: "memory");
        } else {
            XB_SPIN(xb_ld(&bar[XB_XGEN(b.x)]) == gen, bar);
            __builtin_amdgcn_fence(__ATOMIC_ACQUIRE, "agent");
            asm volatile("s_waitcnt vmcnt(0)" ::: "memory");
        }
    }
    __syncthreads();
}

constexpr size_t al256(size_t x) { return (x + 255) & ~(size_t)255; }
constexpr size_t WS_ZERO = 0, ZERO_BYTES = 2u << 20;
constexpr size_t Z_GCNT = 0;
constexpr size_t Z_SS2 = 4096;
constexpr size_t WS_MOD = ZERO_BYTES;
constexpr size_t WS_WRT = WS_MOD + al256((size_t)2 * 9 * 6144 * 4);
constexpr size_t WS_TOKE = WS_WRT + al256((size_t)2 * 36 * 1024 * 4);
constexpr size_t WS_TOKP = WS_TOKE + al256((size_t)NSLOT * 4);
constexpr size_t WS_TOKC = WS_TOKP + al256((size_t)NSLOT * 4);
constexpr size_t WS_TOKS = WS_TOKC + al256((size_t)NSLOT * 4);
constexpr size_t WS_TILE = WS_TOKS + al256((size_t)NSLOT * 4);
constexpr size_t WS_XC = WS_TILE + al256((size_t)(MT_MAX + 64) * 4);
constexpr size_t WS_WIN = WS_XC + al256((size_t)NB * CL * D * 4);
constexpr size_t WS_WOUT = WS_WIN + al256((size_t)2 * INW * D * 2);
constexpr size_t WS_WSB = WS_WOUT + al256((size_t)2 * D * D * 2);
constexpr size_t WS_LBV = WS_WSB + al256((size_t)2 * 4 * 128 * 128 * 2);
constexpr size_t WS_HB = WS_LBV + al256((size_t)2 * 2 * 512 * 4);
constexpr size_t WS_R = WS_HB + al256((size_t)M * D * 2);
constexpr int NCH = M / 64  , NCH2 = M / 128;
constexpr size_t R_QA = 0;
constexpr size_t R_KB = R_QA + al256((size_t)2 * M * 512 * 2);
constexpr size_t R_KDT = R_KB + al256((size_t)2 * M * 512 * 2);
constexpr size_t R_VT = R_KDT + al256((size_t)2 * M * 512 * 2);
constexpr size_t R_SG = R_VT + al256((size_t)M * 512 * 2);
constexpr size_t R_GU = R_SG + al256((size_t)M * 512 * 2);
constexpr size_t R_GVT = R_GU + al256((size_t)M * 512 * 2);
constexpr size_t R_EREF = R_GVT + al256((size_t)M * 512 * 2);
constexpr size_t R_DEC = R_EREF + al256((size_t)2 * NCH * 512 * 4);
constexpr size_t R_ST = R_DEC + al256((size_t)2 * NCH * 512 * 4);
constexpr size_t R_MIX_END = R_ST + al256((size_t)(NCH + 1) * 2 * 4 * 128 * 128 * 2);
constexpr size_t R_HS_DUMMY = 0;
constexpr size_t R_WGU = 0;
constexpr size_t R_WD = R_WGU + al256((size_t)NEXP * 1024 * D * 2);
constexpr size_t R_BUF = R_WD + al256((size_t)NEXP * D * DE * 2);
constexpr size_t R_ACT = R_BUF + al256((size_t)NSLOT_PAD * D * 2);
constexpr size_t R_Y = R_ACT + al256((size_t)NSLOT_PAD * DE * 2);
constexpr size_t R_MOE_END = R_Y + al256((size_t)NSLOT_PAD * D * 2);
constexpr size_t WS_END = WS_R + (R_MIX_END > R_MOE_END ? R_MIX_END : R_MOE_END);
static_assert(WS_END <= (size_t)634 * 1000 * 1000, "workspace budget (sum of inputs = 634.3 MB)");
constexpr size_t Z_SSV = Z_SS2 + (size_t)2 * M * 4;
constexpr size_t Z_XC = Z_GCNT + 256;
constexpr size_t Z_BAR = Z_SSV + (size_t)2 * M * 4;
static_assert(Z_BAR % 256 == 0 && Z_BAR + (size_t)XCD_BAR_WORDS * 4 <= ZERO_BYTES, "zeroed region");
constexpr int LDS_BARST = LDS_BYTES - 64, LDS_VBLK = LDS_BYTES - 32, LDS_STAMP = LDS_BYTES - 1024;

struct Params { const float* in[23]; float* out; unsigned char* ws; };
enum { I_X = 0, I_C, I_CTX, I_CCTX, I_NORM1, I_NORM2, I_WMOD, I_BMOD, I_WIN, I_LB, I_HGN, I_SGN, I_SGW, I_SGB, I_WOUT, I_WG, I_BG, I_WR, I_BR, I_WGATE, I_WUP, I_WDOWN, I_FN };

__device__ __forceinline__ void transpose_item(const float* W, int K, int N, bf16* WT, int k0, int n0, int rowbase, LAS float* scr, int lane) {
    float t[32];
#pragma unroll
    for (int i = 0; i < 32; ++i) t[i] = W[(size_t)(k0 + 2 * i + (lane >> 5)) * N + n0 + (lane & 31)];
    SCHED_FENCE();
#pragma unroll
    for (int i = 0; i < 32; ++i) scr[(2 * i + (lane >> 5)) * 33 + (lane & 31)] = t[i];
    asm volatile("s_waitcnt lgkmcnt(0)" ::: "memory");
    const int c = lane & 7;
#pragma unroll
    for (int j = 0; j < 4; ++j) { const int n = (lane >> 3) + 8 * j; const LAS float* s = scr + (8 * c) * 33 + n;
        u32x4 o; o.x = cvt2(s[0 * 33], s[1 * 33]); o.y = cvt2(s[2 * 33], s[3 * 33]); o.z = cvt2(s[4 * 33], s[5 * 33]); o.w = cvt2(s[6 * 33], s[7 * 33]);
        *(u32x4*)(WT + (size_t)(rowbase + n) * K + k0 + 8 * c) = o; }
    asm volatile("s_waitcnt lgkmcnt(0)" ::: "memory");
}
__device__ __forceinline__ void transpose_item_g(const float* W, int K, int N, bf16* WT, int k0, int srccol_lane, int rowbase, LAS float* scr, int lane) {
    float t[32];
#pragma unroll
    for (int i = 0; i < 32; ++i) t[i] = W[(size_t)(k0 + 2 * i + (lane >> 5)) * N + srccol_lane];
    SCHED_FENCE();
#pragma unroll
    for (int i = 0; i < 32; ++i) scr[(2 * i + (lane >> 5)) * 33 + (lane & 31)] = t[i];
    asm volatile("s_waitcnt lgkmcnt(0)" ::: "memory");
    const int c = lane & 7;
#pragma unroll
    for (int j = 0; j < 4; ++j) { const int n = (lane >> 3) + 8 * j; const LAS float* s = scr + (8 * c) * 33 + n;
        u32x4 o; o.x = cvt2(s[0 * 33], s[1 * 33]); o.y = cvt2(s[2 * 33], s[3 * 33]); o.z = cvt2(s[4 * 33], s[5 * 33]); o.w = cvt2(s[6 * 33], s[7 * 33]);
        *(u32x4*)(WT + (size_t)(rowbase + n) * K + k0 + 8 * c) = o; }
    asm volatile("s_waitcnt lgkmcnt(0)" ::: "memory");
}
__device__ __forceinline__ int win_srccol(int r) {
    const int pn = r >> 8, c = r & 255;
    if (pn >= 8) return 2048 + (pn - 8) * 256 + c;
    const int bj = c >> 7, wc = (c >> 5) & 3, fq = (c >> 3) & 3, n = (c >> 2) & 1, e = c & 3;
    return (2 * bj + n) * 512 + (pn >> 1) * 128 + (pn & 1) * 64 + 16 * wc + 4 * fq + e;
}
__device__ __forceinline__ void norm_mod_row(const float* xr, const float* gain, const float* sh, const float* sc, bf16* orow, int lane) {
    f32x4 v[4]; float ss = 0.f;
#pragma unroll
    for (int j = 0; j < 4; ++j) { v[j] = *(const f32x4*)(xr + 4 * lane + 256 * j); ss += (v[j][0] * v[j][0] + v[j][1] * v[j][1]) + (v[j][2] * v[j][2] + v[j][3] * v[j][3]); }
    const float rs = rsqrtf(wave_sum(ss) * (1.f / D) + EPS);
#pragma unroll
    for (int j = 0; j < 4; ++j) { const int k = 4 * lane + 256 * j; const f32x4 g = *(const f32x4*)(gain + k), s1 = *(const f32x4*)(sc + k), s0 = *(const f32x4*)(sh + k);
        const f32x4 o = v[j] * rs * g * (s1 + 1.f) + s0; u32x2 w; w.x = cvt2(o[0], o[1]); w.y = cvt2(o[2], o[3]); *(u32x2*)(orow + k) = w; }
}
__device__ __forceinline__ const float* xrow_in(const Params& p, int row) { const int b = row / RB, t = row % RB; return t < SEQ ? p.in[I_X] + ((size_t)b * SEQ + t) * D : p.in[I_CTX] + ((size_t)b * CL + (t - SEQ)) * D; }
__device__ __forceinline__ float* xrow_cur(const Params& p, int row) { const int b = row / RB, t = row % RB; return t < SEQ ? p.out + ((size_t)b * SEQ + t) * D : (float*)(p.ws + WS_XC) + ((size_t)b * CL + (t - SEQ)) * D; }

__device__ __forceinline__ int vblk() { return __builtin_amdgcn_readfirstlane(*(const LAS int*)(unsigned)LDS_VBLK); }
__device__ __forceinline__ void ph_prologue(const Params& p, LAS unsigned char* lds, int tid, int lane, int wave, int G) {
    float* MOD = (float*)(p.ws + WS_MOD);
    if (blockIdx.x < 192) {
        const int l = blockIdx.x / 96, col0 = (blockIdx.x % 96) * 64;
        LAS float* sc = (LAS float*)lds; LAS float* red = (LAS float*)(lds + 36864);
        for (int i = tid; i < 9 * 1024; i += NTHREADS) { const int r = i >> 10, k = i & 1023; sc[i] = siluf(r < 8 ? p.in[I_C][r * 1024 + k] : p.in[I_CCTX][k]); }
        __syncthreads();
        const int c4 = tid & 15, kg = tid >> 4;
        f32x4 acc[9];
#pragma unroll
        for (int r = 0; r < 9; ++r) acc[r] = (f32x4){0.f, 0.f, 0.f, 0.f};
        const float* w = p.in[I_WMOD] + (size_t)l * 1024 * 6144 + col0 + 4 * c4;
#pragma unroll 8
        for (int k = kg; k < 1024; k += 32) { const f32x4 wv = *(const f32x4*)(w + (size_t)k * 6144);
#pragma unroll
            for (int r = 0; r < 9; ++r) acc[r] += wv * sc[r * 1024 + k]; }
#pragma unroll
        for (int r = 0; r < 9; ++r) *(LAS f32x4*)&red[(kg * 9 + r) * 64 + 4 * c4] = acc[r];
        __syncthreads();
        for (int i = tid; i < 576; i += NTHREADS) { const int r = i >> 6, cc = i & 63; float s = 0.f;
            for (int g = 0; g < 32; ++g) s += red[(g * 9 + r) * 64 + cc];
            MOD[(size_t)(l * 9 + r) * 6144 + col0 + cc] = s + p.in[I_BMOD][l * 6144 + col0 + cc]; }
        __syncthreads();
    }
    {
        float* WRT = (float*)(p.ws + WS_WRT);
        for (int i = blockIdx.x * NTHREADS + tid; i < 2 * 36 * 1024; i += G * NTHREADS) { const int l = i / (36 * 1024), o = (i / 1024) % 36, k = i & 1023;
            WRT[i] = o < 4 ? p.in[I_WG][((size_t)l * 1024 + k) * 4 + o] : p.in[I_WR][((size_t)l * 1024 + k) * 32 + (o - 4)]; }
    }
    {
        float* LBV = (float*)(p.ws + WS_LBV); bf16* WSB = (bf16*)(p.ws + WS_WSB);
        for (int i = blockIdx.x * NTHREADS + tid; i < 1024; i += G * NTHREADS) { LBV[i] = 0.f; LBV[1024 + i] = 1.f / (1.f + expf(p.in[I_LB][i] - p.in[I_LB][1024 + i])); }
        for (int i = blockIdx.x * NTHREADS + tid; i < 2 * 4 * 128 * 128; i += G * NTHREADS) {
            const int jj = i & 7, L = (i >> 3) & 63, sidx = (i >> 9) & 7, itile = (i >> 12) & 3, lh = i >> 14;
            WSB[i] = (bf16)f2bf(p.in[I_SGW][(size_t)lh * 128 * 128 + (32 * itile + (L & 31)) * 128 + 16 * sidx + 8 * (L >> 5) + jj]); }
    }
    LAS float* scr = (LAS float*)(lds + wave * 16384);
    const int gw = blockIdx.x * NWAVES + wave, NGW = G * NWAVES;
    constexpr int I_IN = (D / 64) * (INW / 32), I_OUT = (D / 64) * (D / 32);
    for (int it = gw; it < 2 * (I_IN + I_OUT); it += NGW) {
        const int l = it / (I_IN + I_OUT); int r = it % (I_IN + I_OUT);
        if (r < I_IN) { const int nblk = INW / 32, kb = r / nblk, nb = r % nblk; transpose_item_g(p.in[I_WIN] + (size_t)l * D * INW, D, INW, (bf16*)(p.ws + WS_WIN) + (size_t)l * INW * D, 64 * kb, win_srccol(32 * nb + (lane & 31)), 32 * nb, scr, lane); }
        else { r -= I_IN; const int nblk = D / 32, kb = r / nblk, nb = r % nblk; transpose_item(p.in[I_WOUT] + (size_t)l * D * D, D, D, (bf16*)(p.ws + WS_WOUT) + (size_t)l * D * D, 64 * kb, 32 * nb, 32 * nb, scr, lane); }
    }
}
__device__ __forceinline__ void ph_h1_first(const Params& p, LAS unsigned char* lds, int tid, int lane, int wave, int G) {
    const float* MOD = (const float*)(p.ws + WS_MOD); bf16* HB = (bf16*)(p.ws + WS_HB); const float* gain = p.in[I_NORM1];
    LAS f32x4* sm = (LAS f32x4*)lds;
    { f32x4 t[10];
#pragma unroll
      for (int i = 0; i < 10; ++i) { const int e = tid + i * NTHREADS; if (e < 19 * 256) { const int blk = e >> 8, c = e & 255; t[i] = blk < 18 ? *(const f32x4*)(MOD + (size_t)(blk >> 1) * 6144 + (blk & 1) * 1024 + 4 * c) : *(const f32x4*)(gain + 4 * c); } }
      SCHED_FENCE();
#pragma unroll
      for (int i = 0; i < 10; ++i) { const int e = tid + i * NTHREADS; if (e < 19 * 256) sm[e] = t[i]; } }
    __syncthreads();
    const int stride = G * NWAVES;
    for (int row0 = vblk() * NWAVES + wave; row0 < M; row0 += 4 * stride) {
        f32x4 v[4][4]; bool act[4]; int rows[4];
#pragma unroll
        for (int rr = 0; rr < 4; ++rr) { const int row = row0 + rr * stride; act[rr] = row < M; rows[rr] = act[rr] ? row : row0; const float* xr = xrow_in(p, rows[rr]);
#pragma unroll
            for (int j = 0; j < 4; ++j) v[rr][j] = *(const f32x4*)(xr + 4 * lane + 256 * j); }
        SCHED_FENCE();
#pragma unroll
        for (int rr = 0; rr < 4; ++rr) { float ss = 0.f;
#pragma unroll
            for (int j = 0; j < 4; ++j) ss += (v[rr][j][0] * v[rr][j][0] + v[rr][j][1] * v[rr][j][1]) + (v[rr][j][2] * v[rr][j][2] + v[rr][j][3] * v[rr][j][3]);
            const float rs = rsqrtf(wave_sum(ss) * (1.f / D) + EPS); const int mr = mod_row(rows[rr]);
            if (act[rr]) {
#pragma unroll
                for (int j = 0; j < 4; ++j) { const int c = lane + 64 * j; const f32x4 o = v[rr][j] * rs * sm[18 * 256 + c] * (sm[(mr * 2 + 1) * 256 + c] + 1.f) + sm[(mr * 2) * 256 + c];
                    u32x2 w; w.x = cvt2(o[0], o[1]); w.y = cvt2(o[2], o[3]); *(u32x2*)(HB + (size_t)rows[rr] * D + 4 * c) = w; } } }
    }
}
__device__ __forceinline__ void ph_moe_wconv(const Params& p, int l, LAS unsigned char* lds, int lane, int wave, int blk, int nblk) {
    LAS float* scr = (LAS float*)(lds + wave * 16384);
    bf16* WGU = (bf16*)(p.ws + WS_R + R_WGU); bf16* WD = (bf16*)(p.ws + WS_R + R_WD);
    constexpr int I_G = (D / 64) * (DE / 32)  , I_D = (DE / 64) * (D / 32)  , PER_E = 2 * I_G + I_D;
    for (int it = blk * NWAVES + wave; it < NEXP * PER_E; it += nblk * NWAVES) {
        const int e = it / PER_E; int r = it % PER_E;
        if (r < 2 * I_G) { const int isup = r >= I_G; r -= isup * I_G; const int nblk = DE / 32, kb = r / nblk, nb = r % nblk, n0 = 32 * nb;
            const float* W = p.in[isup ? I_WUP : I_WGATE] + ((size_t)l * NEXP + e) * D * DE;
            transpose_item(W, D, DE, WGU + (size_t)e * 1024 * D, 64 * kb, n0, 256 * (n0 >> 7) + 128 * isup + (n0 & 127), scr, lane); }
        else { r -= 2 * I_G; const int nblk = D / 32, kb = r / nblk, nb = r % nblk;
            transpose_item(p.in[I_WDOWN] + ((size_t)l * NEXP + e) * DE * D, DE, D, WD + (size_t)e * D * DE, 64 * kb, 32 * nb, 32 * nb, scr, lane); }
    }
}
__device__ __forceinline__ float opaque_v(float x) { asm volatile("" : "+v"(x)); return x; }
__device__ __forceinline__ void ph_router(const Params& p, int l, int last, LAS unsigned char* lds, int tid, int lane, int wave, int G) {
    LAS float* W = (LAS float*)lds; LAS int* hist = (LAS int*)(lds + 147456); LAS int* base = hist + 32; LAS int* sinfo = base + 32 + wave * 40;
    const float* WRT = (const float*)(p.ws + WS_WRT) + (size_t)l * 36 * 1024;
    { f32x4 wt[18];
#pragma unroll
      for (int i = 0; i < 18; ++i) wt[i] = ((const f32x4*)WRT)[tid + i * NTHREADS];
      SCHED_FENCE();
#pragma unroll
      for (int i = 0; i < 18; ++i) ((LAS f32x4*)W)[tid + i * NTHREADS] = wt[i]; }
    if (tid < 32) hist[tid] = 0;
    const float* MOD = (const float*)(p.ws + WS_MOD) + (size_t)l * 9 * 6144; const float* SS2 = (const float*)(p.ws + WS_ZERO + Z_SS2) + (size_t)l * M;
    bf16* HB = (bf16*)(p.ws + WS_HB); int* TOKE = (int*)(p.ws + WS_TOKE); float* TOKC = (float*)(p.ws + WS_TOKC); int* TOKP = (int*)(p.ws + WS_TOKP);
    int* gcnt = (int*)(p.ws + WS_ZERO + Z_GCNT) + l * 64;
    const float* gain = p.in[I_NORM2] + l * D;
    LAS float* Bv = (LAS float*)(lds + 147456 + 2048);
    if (tid < 36) Bv[tid] = tid < 4 ? p.in[I_BG][l * 4 + tid] : p.in[I_BR][l * 32 + tid - 4];
    __syncthreads();
    int nloc = 0;
    const int stride = G * NWAVES;
    for (int row0 = vblk() * NWAVES + wave; row0 < M; row0 += 2 * stride) {
        const bool two = row0 + stride < M; const int rows[2] = {row0, two ? row0 + stride : row0};
        bool act[2]; f32x4 h[2][4];
        {
            f32x4 xv[2][4], s1v[2][4], s0v[2][4], gv[4]; float ssq[2];
#pragma unroll
            for (int rr = 0; rr < 2; ++rr) { const int row = rows[rr]; act[rr] = (rr == 0 || two) && !(last && is_ctx_row(row));
                const float* xr = xrow_cur(p, row); const float* mr = MOD + (size_t)mod_row(row) * 6144; ssq[rr] = SS2[row];
#pragma unroll
                for (int j = 0; j < 4; ++j) { const int k = 4 * lane + 256 * j; xv[rr][j] = *(const f32x4*)(xr + k); s1v[rr][j] = *(const f32x4*)(mr + 4 * 1024 + k); s0v[rr][j] = *(const f32x4*)(mr + 3 * 1024 + k); } }
#pragma unroll
            for (int j = 0; j < 4; ++j) gv[j] = *(const f32x4*)(gain + 4 * lane + 256 * j);
            SCHED_FENCE();
#pragma unroll
            for (int rr = 0; rr < 2; ++rr) { const float rs = rsqrtf(ssq[rr] * (1.f / D) + EPS);
#pragma unroll
                for (int j = 0; j < 4; ++j) { const int k = 4 * lane + 256 * j; h[rr][j] = xv[rr][j] * rs * gv[j] * (s1v[rr][j] + 1.f) + s0v[rr][j];
                    if (act[rr]) { u32x2 w; w.x = cvt2(h[rr][j][0], h[rr][j][1]); w.y = cvt2(h[rr][j][2], h[rr][j][3]); *(u32x2*)(HB + (size_t)rows[rr] * D + k) = w; } } }
        }
        typedef float f32x2 __attribute__((ext_vector_type(2)));
        float gl[2][4];
        { f32x4 wg[16];
#pragma unroll
          for (int q = 0; q < 16; ++q) wg[q] = *(const LAS f32x4*)&W[(q >> 2) * 1024 + 4 * lane + 256 * (q & 3)];
          SCHED_FENCE();
#pragma unroll
          for (int o = 0; o < 4; ++o)
#pragma unroll
              for (int rr = 0; rr < 2; ++rr) { f32x2 a2 = {0.f, 0.f};
#pragma unroll
                  for (int j = 0; j < 4; ++j) { const f32x4 wv = wg[o * 4 + j], hv = h[rr][j];
                      a2 = __builtin_elementwise_fma((f32x2){hv[0], hv[1]}, (f32x2){wv[0], wv[1]}, a2); a2 = __builtin_elementwise_fma((f32x2){hv[2], hv[3]}, (f32x2){wv[2], wv[3]}, a2); }
                  gl[rr][o] = opaque_v(wave_sum(a2[0] + a2[1]) + Bv[o]); } }
#pragma unroll
        for (int rr = 0; rr < 2; ++rr) {
            const int row = rows[rr];
            int gs = 0; float gmax = gl[rr][0];
#pragma unroll
            for (int o = 1; o < 4; ++o) if (gl[rr][o] > gmax) { gmax = gl[rr][o]; gs = o; }
            float den = 0.f;
#pragma unroll
            for (int o = 0; o < 4; ++o) den += __expf(gl[rr][o] - gmax);
            const float psel = 1.f / den;
            const int gsu = __builtin_amdgcn_readfirstlane(gs);
            const LAS float* wb = W + (4 + 8 * gsu) * 1024 + 4 * lane; const LAS float* bb = Bv + 4 + 8 * gsu;
            float li[8];
#pragma unroll
            for (int half = 0; half < 2; ++half) { f32x4 we[16];
#pragma unroll
                for (int q = 0; q < 16; ++q) we[q] = *(const LAS f32x4*)&wb[(4 * half + (q >> 2)) * 1024 + 256 * (q & 3)];
                SCHED_FENCE();
#pragma unroll
                for (int o = 0; o < 4; ++o) { f32x2 a2 = {0.f, 0.f};
#pragma unroll
                    for (int j = 0; j < 4; ++j) { const f32x4 wv = we[o * 4 + j], hv = h[rr][j];
                        a2 = __builtin_elementwise_fma((f32x2){hv[0], hv[1]}, (f32x2){wv[0], wv[1]}, a2); a2 = __builtin_elementwise_fma((f32x2){hv[2], hv[3]}, (f32x2){wv[2], wv[3]}, a2); }
                    li[4 * half + o] = opaque_v(wave_sum(a2[0] + a2[1]) + bb[4 * half + o]); } }
            int i0 = 0; float m0 = li[0];
#pragma unroll
            for (int j = 1; j < 8; ++j) if (li[j] > m0) { m0 = li[j]; i0 = j; }
            int i1 = 0; float m1 = -3.0e38f;
#pragma unroll
            for (int j = 0; j < 8; ++j) if (j != i0 && li[j] > m1) { m1 = li[j]; i1 = j; }
            const float e1 = __expf(m1 - m0);
            if (act[rr]) {
                if (lane < 2) { const int e = gs * 8 + (lane ? i1 : i0); const float c = lane ? psel * e1 / (1.f + e1) : psel / (1.f + e1);
                    const int lp = __hip_atomic_fetch_add(&hist[e], 1, __ATOMIC_RELAXED, __HIP_MEMORY_SCOPE_WORKGROUP); TOKE[row * 2 + lane] = e; TOKC[row * 2 + lane] = c; sinfo[nloc * 2 + lane] = (e << 16) | lp; }
                ++nloc; }
        }
    }
    __syncthreads();
    if (tid < 32) base[tid] = atomicAdd(&gcnt[tid], hist[tid]);
    __syncthreads();
    nloc = 0;
    for (int row0 = vblk() * NWAVES + wave; row0 < M; row0 += 2 * stride) {
        const bool two = row0 + stride < M;
#pragma unroll
        for (int rr = 0; rr < 2; ++rr) { const int row = rr ? row0 + stride : row0; if ((rr == 0 || two) && !(last && is_ctx_row(row))) {
            if (lane < 2) { const int info = sinfo[nloc * 2 + lane]; TOKP[row * 2 + lane] = base[info >> 16] + (info & 0xffff); }
            ++nloc; } }
    }
}
__device__ __forceinline__ void ph_place(const Params& p, int l, int last, LAS unsigned char* lds, int tid, int lane, int wave, int G) {
    LAS int* ps = (LAS int*)lds;
    const int* gcnt = (const int*)(p.ws + WS_ZERO + Z_GCNT) + l * 64; int* TILE = (int*)(p.ws + WS_TILE);
    if (tid == 0) { int s = 0; for (int e = 0; e < NEXP; ++e) { ps[e] = s; s += (gcnt[e] + 255) / 256 * 256; } ps[32] = s; }
    __syncthreads();
    if (vblk() == 0 && tid < 32) { for (int t = ps[tid] / 256; t < ps[tid + 1] / 256; ++t) TILE[t] = tid; if (tid == 0) TILE[MT_MAX] = ps[32] / 256; }
    const bf16* HB = (const bf16*)(p.ws + WS_HB); bf16* BUF = (bf16*)(p.ws + WS_R + R_BUF);
    const int* TOKE = (const int*)(p.ws + WS_TOKE); const int* TOKP = (const int*)(p.ws + WS_TOKP); int* TOKS = (int*)(p.ws + WS_TOKS);
    const int stride = G * NWAVES;
    for (int row0 = vblk() * NWAVES + wave; row0 < M; row0 += 2 * stride) {
        const bool two = row0 + stride < M; const int rows[2] = {row0, two ? row0 + stride : row0};
        bool act[2]; int s0[2], s1[2]; u32x4 a[2], b[2];
#pragma unroll
        for (int rr = 0; rr < 2; ++rr) { const int row = rows[rr]; act[rr] = (rr == 0 || two) && !(last && is_ctx_row(row));
            const int e0 = act[rr] ? TOKE[row * 2] : 0, e1 = act[rr] ? TOKE[row * 2 + 1] : 0;
            s0[rr] = ps[e0] + TOKP[row * 2]; s1[rr] = ps[e1] + TOKP[row * 2 + 1];
            a[rr] = ((const u32x4*)(HB + (size_t)row * D))[lane]; b[rr] = ((const u32x4*)(HB + (size_t)row * D))[lane + 64]; }
#pragma unroll
        for (int rr = 0; rr < 2; ++rr) if (act[rr]) { const int row = rows[rr];
            ((u32x4*)(BUF + (size_t)s0[rr] * D))[lane] = a[rr]; ((u32x4*)(BUF + (size_t)s0[rr] * D))[lane + 64] = b[rr];
            ((u32x4*)(BUF + (size_t)s1[rr] * D))[lane] = a[rr]; ((u32x4*)(BUF + (size_t)s1[rr] * D))[lane + 64] = b[rr];
            if (lane == 0) { TOKS[row * 2] = s0[rr]; TOKS[row * 2 + 1] = s1[rr]; } }
    }
}
__device__ __forceinline__ void ph_combine(const Params& p, int l, int last, LAS unsigned char* lds, int tid, int lane, int wave, int G) {
    const float* MOD = (const float*)(p.ws + WS_MOD); const bf16* Y = (const bf16*)(p.ws + WS_R + R_Y); bf16* HB = (bf16*)(p.ws + WS_HB);
    const int* TOKS = (const int*)(p.ws + WS_TOKS); const float* TOKC = (const float*)(p.ws + WS_TOKC);
    const float* gain = last ? p.in[I_FN] : p.in[I_NORM1] + (l + 1) * D;
    LAS f32x4* sm = (LAS f32x4*)lds;
    { f32x4 t[14];
#pragma unroll
      for (int i = 0; i < 14; ++i) { const int e = tid + i * NTHREADS; if (e < 28 * 256) { const int blk = e >> 8, c = e & 255, mr = blk / 3, wh = blk % 3;
          t[i] = blk < 27 ? *(const f32x4*)(MOD + ((size_t)(wh == 0 ? l : (last ? l : l + 1)) * 9 + mr) * 6144 + (wh == 0 ? 5 : wh - 1) * 1024 + 4 * c) : *(const f32x4*)(gain + 4 * c); } }
      SCHED_FENCE();
#pragma unroll
      for (int i = 0; i < 14; ++i) { const int e = tid + i * NTHREADS; if (e < 28 * 256) sm[e] = t[i]; } }
    __syncthreads();
    const int stride = G * NWAVES;
    for (int row0 = vblk() * NWAVES + wave; row0 < M; row0 += 4 * stride) {
        bool act[4]; int rows[4]; float* xr[4]; f32x4 x[4][4]; u32x2 y0[4][4], y1[4][4]; float c0[4], c1[4];
#pragma unroll
        for (int rr = 0; rr < 4; ++rr) { const int rw = row0 + rr * stride; const bool in = rw < M; const int row = in ? rw : row0; rows[rr] = row; act[rr] = in && !(last && is_ctx_row(row)); xr[rr] = xrow_cur(p, row);
            const int s0 = act[rr] ? TOKS[row * 2] : 0, s1 = act[rr] ? TOKS[row * 2 + 1] : 0; c0[rr] = TOKC[row * 2]; c1[rr] = TOKC[row * 2 + 1];
#pragma unroll
            for (int j = 0; j < 4; ++j) { const int k = 4 * lane + 256 * j; x[rr][j] = *(const f32x4*)(xr[rr] + k); y0[rr][j] = *(const u32x2*)(Y + (size_t)s0 * D + k); y1[rr][j] = *(const u32x2*)(Y + (size_t)s1 * D + k); } }
        SCHED_FENCE();
#pragma unroll
        for (int rr = 0; rr < 4; ++rr) { f32x4 v[4]; float ss = 0.f; const int mr = mod_row(rows[rr]);
#pragma unroll
            for (int j = 0; j < 4; ++j) { const u32x2 a = y0[rr][j], b = y1[rr][j]; f32x4 f;
                f[0] = c0[rr] * bf2f(a.x & 0xffffu) + c1[rr] * bf2f(b.x & 0xffffu); f[1] = c0[rr] * bf2f(a.x >> 16) + c1[rr] * bf2f(b.x >> 16);
                f[2] = c0[rr] * bf2f(a.y & 0xffffu) + c1[rr] * bf2f(b.y & 0xffffu); f[3] = c0[rr] * bf2f(a.y >> 16) + c1[rr] * bf2f(b.y >> 16);
                v[j] = x[rr][j] + sm[(mr * 3) * 256 + lane + 64 * j] * f; ss += (v[j][0] * v[j][0] + v[j][1] * v[j][1]) + (v[j][2] * v[j][2] + v[j][3] * v[j][3]); }
            const float rs = rsqrtf(wave_sum(ss) * (1.f / D) + EPS);
            if (act[rr]) {
                if (!last) {
#pragma unroll
                    for (int j = 0; j < 4; ++j) { const int c = lane + 64 * j, k = 4 * c; *(f32x4*)(xr[rr] + k) = v[j];
                        const f32x4 o = v[j] * rs * sm[27 * 256 + c] * (sm[(mr * 3 + 2) * 256 + c] + 1.f) + sm[(mr * 3 + 1) * 256 + c];
                        u32x2 w; w.x = cvt2(o[0], o[1]); w.y = cvt2(o[2], o[3]); *(u32x2*)(HB + (size_t)rows[rr] * D + k) = w; } }
                else {
#pragma unroll
                    for (int j = 0; j < 4; ++j) { const int c = lane + 64 * j; *(f32x4*)(xr[rr] + 4 * c) = v[j] * rs * sm[27 * 256 + c]; } } } }
    }
}
__device__ __forceinline__ int scan_chunk(int step, int dir) { return dir == 0 ? (step < 4 ? 64 + step : step - 4) : 67 - step; }
typedef short bf16x8 __attribute__((ext_vector_type(8)));
typedef short s16x4 __attribute__((ext_vector_type(4)));
typedef float f32x16 __attribute__((ext_vector_type(16)));
#define MFMA32(a, b, c) __builtin_amdgcn_mfma_f32_32x32x16_bf16((a), (b), (c), 0, 0, 0)
__device__ __forceinline__ bf16x8 ld8(const bf16* q) { return *(const bf16x8*)q; }
__device__ __forceinline__ bf16x8 ld44(const bf16* q0, const bf16* q1) { const s16x4 lo = *(const s16x4*)q0, hi = *(const s16x4*)q1; return __builtin_shufflevector(lo, hi, 0, 1, 2, 3, 4, 5, 6, 7); }
__device__ __forceinline__ f32x16 zero16() { f32x16 z;
#pragma unroll
    for (int i = 0; i < 16; ++i) z[i] = 0.f; return z; }
__device__ __forceinline__ bf16x8 pack_acc(const f32x16& x, int s) { u32x4 w; w.x = pk2(x[8 * s], x[8 * s + 1]); w.y = pk2(x[8 * s + 2], x[8 * s + 3]); w.z = pk2(x[8 * s + 4], x[8 * s + 5]); w.w = pk2(x[8 * s + 6], x[8 * s + 7]); return __builtin_bit_cast(bf16x8, w); }
__device__ __forceinline__ bf16x8 scale8(bf16x8 f, f32x4 a, f32x4 b) { const u32x4 w = __builtin_bit_cast(u32x4, f); u32x4 o;
    o.x = cvt2(bf2f(w.x & 0xffffu) * a[0], bf2f(w.x >> 16) * a[1]); o.y = cvt2(bf2f(w.y & 0xffffu) * a[2], bf2f(w.y >> 16) * a[3]);
    o.z = cvt2(bf2f(w.z & 0xffffu) * b[0], bf2f(w.z >> 16) * b[1]); o.w = cvt2(bf2f(w.w & 0xffffu) * b[2], bf2f(w.w >> 16) * b[3]); return __builtin_bit_cast(bf16x8, o); }

constexpr int SCAN_DE_BYTES = 69 * 256 * 4, SCAN_RING_OFF = 71680, SCAN_BUF_BYTES = 24 * 1024;
__device__ __forceinline__ void scan_item(int item, int& b, int& h, int& dir, int& eh) {
    const int xcd = item & 7, j = item >> 3, pair = (j >> 2) * 8 + xcd; eh = j & 1; dir = (j >> 1) & 1; h = pair & 3; b = pair >> 2;
}
__device__ __forceinline__ void scan_preload(const Params& p, LAS unsigned char* lds, int tid, int item) {
    int b, h, dir, eh; scan_item(item, b, h, dir, eh);
    const float* DEC = (const float*)(p.ws + WS_R + R_DEC) + (size_t)dir * NCH * 512 + h * 128; const float* ER = (const float*)(p.ws + WS_R + R_EREF) + (size_t)dir * NCH * 512 + h * 128;
    LAS float* de = (LAS float*)lds;
    for (int i = tid; i < 69 * 256; i += NTHREADS) { const int step = i >> 8, w = i & 255; const size_t gc = (size_t)(b * 68 + scan_chunk(step < 68 ? step : 67, dir));
        de[i] = w < 128 ? DEC[gc * 512 + w] : ER[gc * 512 + (w - 128)]; }
}
struct ScanRegs { bf16x8 f[3]; };
__device__ __forceinline__ void ph_scan(const Params& p, LAS unsigned char* lds, int lane, int wave, int item) {
    int b, h, dir, eh; scan_item(item, b, h, dir, eh);
    const int dt = wave & 3, etl = wave >> 2, et = 2 * eh + etl, hh = lane >> 5;
    const bf16* KD = (const bf16*)(p.ws + WS_R + R_KDT) + (size_t)dir * M * 512; const bf16* V = (const bf16*)(p.ws + WS_R + R_VT);
    const bf16* src[3];
#pragma unroll
    for (int i = 0; i < 3; ++i) { const int f = 3 * wave + i; src[i] = f < 16 ? KD + ((((size_t)h * 4 + (f >> 2)) * 4 + (f & 3)) * 64 + lane) * 8 : V + ((((size_t)h * 4 + 2 * eh + ((f - 16) >> 2)) * 4 + (f & 3)) * 64 + lane) * 8; }
    const LAS float* de = (const LAS float*)lds + 32 * dt + 4 * hh;
    LAS unsigned char* ring = lds + SCAN_RING_OFF;
    const int wofs = 3 * wave * 1024 + lane * 16, aofs = dt * 4 * 1024 + lane * 16, bofs = (16 + etl * 4) * 1024 + lane * 16;
    bf16* ST = (bf16*)(p.ws + WS_R + R_ST) + (((size_t)dir * 4 + h) * 16 + dt * 4 + et) * 1024 + lane * 8;
    f32x16 S = zero16();
#define SCAN_GC(step) ((size_t)(b * 68 + scan_chunk((step) < 68 ? (step) : 67, dir)))
#define SCAN_LOAD(R, step) { const size_t g_ = SCAN_GC(step) * (4 * 4 * 4 * 512); _Pragma("unroll") for (int i = 0; i < 3; ++i) R.f[i] = ld8(src[i] + g_); }
#define SCAN_WRITE(R, buf) { _Pragma("unroll") for (int i = 0; i < 3; ++i) *(LAS bf16x8*)(ring + (buf) * SCAN_BUF_BYTES + wofs + i * 1024) = R.f[i]; }
#define SCAN_BAR() { asm volatile("s_waitcnt lgkmcnt(0)" ::: "memory"); __builtin_amdgcn_s_barrier(); asm volatile("" ::: "memory"); }
    ScanRegs P0, P1;
    SCAN_LOAD(P0, 0); SCAN_LOAD(P1, 1);
    SCAN_WRITE(P0, 0); SCAN_LOAD(P0, 2);
    for (int k0 = 0; k0 < 72; k0 += 6) {
#pragma unroll
        for (int j = 0; j < 6; ++j) { const int k = k0 + j;
            SCAN_BAR();
            if ((j + 1) & 1) { SCAN_WRITE(P1, (j + 1) % 3); SCAN_LOAD(P1, k + 3); } else { SCAN_WRITE(P0, (j + 1) % 3); SCAN_LOAD(P0, k + 3); }
            const LAS unsigned char* buf = ring + (j % 3) * SCAN_BUF_BYTES;
            bf16x8 fa[4], fb[4]; f32x4 dc[4], er[4]; const LAS float* dk = de + (k < 69 ? k : 68) * 256;
#pragma unroll
            for (int s = 0; s < 4; ++s) { fa[s] = *(const LAS bf16x8*)(buf + aofs + s * 1024); fb[s] = *(const LAS bf16x8*)(buf + bofs + s * 1024); dc[s] = *(const LAS f32x4*)(dk + 8 * s); er[s] = *(const LAS f32x4*)(dk + 128 + 8 * s); }
            { bf16* st = ST + (k < 68 ? SCAN_GC(k) : (size_t)NCH) * (2 * 4 * 16384); u32x4 w0, w1;
              w0.x = cvt2(S[0] * er[0][0], S[1] * er[0][1]); w0.y = cvt2(S[2] * er[0][2], S[3] * er[0][3]); w0.z = cvt2(S[4] * er[1][0], S[5] * er[1][1]); w0.w = cvt2(S[6] * er[1][2], S[7] * er[1][3]);
              w1.x = cvt2(S[8] * er[2][0], S[9] * er[2][1]); w1.y = cvt2(S[10] * er[2][2], S[11] * er[2][3]); w1.z = cvt2(S[12] * er[3][0], S[13] * er[3][1]); w1.w = cvt2(S[14] * er[3][2], S[15] * er[3][3]);
              *(u32x4*)st = w0; *(u32x4*)(st + 512) = w1; }
#pragma unroll
            for (int g = 0; g < 4; ++g)
#pragma unroll
                for (int q = 0; q < 4; ++q) S[4 * g + q] *= dc[g][q];
#pragma unroll
            for (int s = 0; s < 4; ++s) S = MFMA32(fa[s], fb[s], S);
        }
    }
#undef SCAN_GC
#undef SCAN_LOAD
#undef SCAN_WRITE
#undef SCAN_BAR
}
__device__ __forceinline__ void ph_sgu(const Params& p, int l, int lane, int widx, int nw) {
    const bf16* GVT = (const bf16*)(p.ws + WS_R + R_GVT); const bf16* GU = (const bf16*)(p.ws + WS_R + R_GU); bf16* HS = (bf16*)(p.ws + WS_HB);
    const float* SSV = (const float*)(p.ws + WS_ZERO + Z_SSV) + (size_t)l * M; const bf16* WSB = (const bf16*)(p.ws + WS_WSB) + (size_t)l * 4 * 128 * 128; const float* bs = p.in[I_SGB] + l * 512;
    const int r = lane & 31, hh = lane >> 5;
    for (int it = widx; it < NCH2 * 16; it += nw) { const int gc2 = it >> 4, h = (it >> 2) & 3, cht = it & 3;
        const bf16* ap = GVT + ((((size_t)(gc2 * 4 + h) * 4 + cht) * 8) * 64 + lane) * 8; const float* sp = SSV + gc2 * 128 + 8 * hh; const bf16* wp = WSB + ((((size_t)h * 4) * 8) * 64 + lane) * 8;
        f32x16 acc[4] = {zero16(), zero16(), zero16(), zero16()};
        bf16x8 av[8]; f32x4 sv[16];
#pragma unroll
        for (int s = 0; s < 8; ++s) { av[s] = ld8(ap + s * 512); sv[2 * s] = *(const f32x4*)(sp + 16 * s); sv[2 * s + 1] = *(const f32x4*)(sp + 16 * s + 4); }
        bf16x8 wa[4], wb[4];
#pragma unroll
        for (int t = 0; t < 4; ++t) wa[t] = ld8(wp + (size_t)t * 8 * 512);
#pragma unroll
        for (int s = 0; s < 8; ++s) {
            SCHED_FENCE();
            if (s < 7) {
#pragma unroll
                for (int t = 0; t < 4; ++t) { const bf16x8 w = ld8(wp + (size_t)t * 8 * 512 + (s + 1) * 512); if (s & 1) wa[t] = w; else wb[t] = w; } }
            SCHED_FENCE();
            f32x4 s0 = sv[2 * s], s1 = sv[2 * s + 1];
#pragma unroll
            for (int q = 0; q < 4; ++q) { s0[q] = rsqrtf(s0[q] * (1.f / 512.f) + EPS); s1[q] = rsqrtf(s1[q] * (1.f / 512.f) + EPS); }
            const bf16x8 a = scale8(av[s], s0, s1);
#pragma unroll
            for (int t = 0; t < 4; ++t) acc[t] = MFMA32(a, (s & 1) ? wb[t] : wa[t], acc[t]); }
        u32x2 gu[4][4]; float bias[4];
#pragma unroll
        for (int t = 0; t < 4; ++t) { const size_t row = (size_t)gc2 * 128 + 32 * t + r; bias[t] = bs[h * 128 + 32 * t + r];
#pragma unroll
            for (int g = 0; g < 4; ++g) gu[t][g] = *(const u32x2*)(GU + row * 512 + h * 128 + 32 * cht + 8 * g + 4 * hh); }
        SCHED_FENCE();
#pragma unroll
        for (int t = 0; t < 4; ++t) { const size_t row = (size_t)gc2 * 128 + 32 * t + r;
#pragma unroll
            for (int g = 0; g < 4; ++g) { const int ch = h * 128 + 32 * cht + 8 * g + 4 * hh; const u32x2 u = gu[t][g];
                u32x2 w; w.x = cvt2(bf2f(u.x & 0xffffu) * (acc[t][4 * g] + bias[t]), bf2f(u.x >> 16) * (acc[t][4 * g + 1] + bias[t])); w.y = cvt2(bf2f(u.y & 0xffffu) * (acc[t][4 * g + 2] + bias[t]), bf2f(u.y >> 16) * (acc[t][4 * g + 3] + bias[t]));
                *(u32x2*)(HS + row * D + 512 + ch) = w; } }
    }
}
__device__ __forceinline__ void ph_out(const Params& p, int l, int last, int lane, int wave, int G) {
    const bf16* QA = (const bf16*)(p.ws + WS_R + R_QA); const bf16* KB = (const bf16*)(p.ws + WS_R + R_KB); const bf16* VT = (const bf16*)(p.ws + WS_R + R_VT);
    const bf16* ST = (const bf16*)(p.ws + WS_R + R_ST); const bf16* SG = (const bf16*)(p.ws + WS_R + R_SG);
    bf16* HS = (bf16*)(p.ws + WS_HB); const float* gain = p.in[I_HGN] + l * 512;
    const int r = lane & 31, hh = lane >> 5;
    for (int it = vblk() * NWAVES + wave; it < NCH * 8; it += G * NWAVES) { const int gc = it >> 3, h = (it >> 1) & 3, ih = it & 1;
        if (last && (gc % 68) >= 64) continue;
        f32x16 o[4] = {zero16(), zero16(), zero16(), zero16()}; f32x16 Pd, Po;
#pragma unroll
        for (int dir = 0; dir < 2; ++dir) {
            const bf16* qp = QA + (size_t)dir * M * 512 + ((((size_t)(gc * 4 + h) * 2 + ih) * 8) * 64 + lane) * 8;
            const bf16* kd = KB + (size_t)dir * M * 512 + ((((size_t)(gc * 4 + h) * 2 + ih) * 8) * 64 + lane) * 8;
            const bf16* ko = KB + (size_t)dir * M * 512 + ((((size_t)(gc * 4 + h) * 2 + (1 - ih)) * 8) * 64 + lane) * 8;
            const bf16* sp = ST + (((size_t)gc * 2 + dir) * 4 + h) * 16384 + lane * 8;
            const bool off = (dir == 0) == (ih == 1);
            bf16x8 qa[8], ka[8], sa[8], sb[8];
#pragma unroll
            for (int s = 0; s < 8; ++s) { qa[s] = ld8(qp + s * 512); ka[s] = ld8(kd + s * 512); }
            if (off) {
#pragma unroll
                for (int s = 0; s < 8; ++s) sb[s] = ld8(ko + s * 512); }
            SCHED_FENCE();
            { f32x16 t = zero16();
#pragma unroll
              for (int s = 0; s < 8; ++s) t = MFMA32(ka[s], qa[s], t);
              SCHED_FENCE();
#pragma unroll
              for (int s = 0; s < 8; ++s) sa[s] = ld8(sp + (size_t)((s >> 1) * 4 + 0) * 1024 + 512 * (s & 1));
              SCHED_FENCE();
#pragma unroll
              for (int q = 0; q < 16; ++q) { const int j = (q & 3) + 8 * (q >> 2) + 4 * hh; const bool keep = dir == 0 ? (j <= r) : (j >= r); const float v = keep ? t[q] : 0.f; if (dir == 0) Pd[q] = v; else Pd[q] += v; } }
            if (off) { f32x16 t = zero16();
#pragma unroll
              for (int s = 0; s < 8; ++s) t = MFMA32(sb[s], qa[s], t);
              Po = t; }
#pragma unroll
            for (int et = 0; et < 4; ++et) {
                SCHED_FENCE();
                if (et < 3) {
#pragma unroll
                    for (int s = 0; s < 8; ++s) { const bf16x8 w = ld8(sp + (size_t)((s >> 1) * 4 + et + 1) * 1024 + 512 * (s & 1)); if (et & 1) sa[s] = w; else sb[s] = w; } }
                SCHED_FENCE();
#pragma unroll
                for (int s = 0; s < 8; ++s) o[et] = MFMA32((et & 1) ? sb[s] : sa[s], qa[s], o[et]);
            }
        }
        {
            const bf16* vp = VT + (((size_t)(gc * 4 + h) * 4 * 4) * 64 + r) * 8 + 4 * hh;
            bf16x8 va[4][4];
#pragma unroll
            for (int et = 0; et < 4; ++et)
#pragma unroll
                for (int k = 0; k < 4; ++k) { const bf16* v = vp + (size_t)(et * 4 + k) * 512; va[et][k] = ld44(v, v + 32 * 8); }
            SCHED_FENCE();
#pragma unroll
            for (int s = 0; s < 2; ++s) { const bf16x8 pd = pack_acc(Pd, s), po = pack_acc(Po, s);
#pragma unroll
                for (int et = 0; et < 4; ++et) { o[et] = MFMA32(ih ? va[et][2 + s] : va[et][s], pd, o[et]); o[et] = MFMA32(ih ? va[et][s] : va[et][2 + s], po, o[et]); } }
        }
        const size_t row = (size_t)gc * 64 + 32 * ih + r;
        u32x2 sgv[4][4]; f32x4 gnv[4][4];
#pragma unroll
        for (int et = 0; et < 4; ++et)
#pragma unroll
            for (int g = 0; g < 4; ++g) { sgv[et][g] = *(const u32x2*)(SG + row * 512 + h * 128 + 32 * et + 8 * g + 4 * hh); gnv[et][g] = *(const f32x4*)(gain + h * 128 + 32 * et + 8 * g + 4 * hh); }
        float ss = 0.f;
#pragma unroll
        for (int et = 0; et < 4; ++et)
#pragma unroll
            for (int q = 0; q < 16; ++q) ss += o[et][q] * o[et][q];
        ss += __shfl_xor(ss, 32);
        const float rs = rsqrtf(ss * (1.f / 128.f) + EPS);
#pragma unroll
        for (int et = 0; et < 4; ++et)
#pragma unroll
            for (int g = 0; g < 4; ++g) { const int c = h * 128 + 32 * et + 8 * g + 4 * hh; const f32x4 gn = gnv[et][g]; const u32x2 sg = sgv[et][g];
                u32x2 w; w.x = cvt2(o[et][4 * g] * rs * gn[0] * bf2f(sg.x & 0xffffu), o[et][4 * g + 1] * rs * gn[1] * bf2f(sg.x >> 16));
                w.y = cvt2(o[et][4 * g + 2] * rs * gn[2] * bf2f(sg.y & 0xffffu), o[et][4 * g + 3] * rs * gn[3] * bf2f(sg.y >> 16));
                *(u32x2*)(HS + row * D + c) = w; }
    }
}
#ifndef TIMING
#define TIMING 0
#endif
#ifndef TIMING_MASK
#define TIMING_MASK 0ull
#endif
#ifndef TIMING_MODE
#define TIMING_MODE 0
#endif
#ifndef TIMING_MUL
#define TIMING_MUL 4
#endif
constexpr int PH_PRO = 0, PH_H1 = 1, PH_L0 = 2, PH_PER_LAYER = 9, PH_END = PH_L0 + 2 * PH_PER_LAYER;
__device__ __forceinline__ void* launder_ptr(void* q) { unsigned long long v = (unsigned long long)q; asm volatile("" : "+s"(v)); return (void*)v; }
__global__ void __launch_bounds__(NTHREADS, 2) mk(Params p, int ph_lo, int ph_hi) {
    extern __shared__ __attribute__((aligned(16))) unsigned char lds_raw[];
    LAS unsigned char* lds = (LAS unsigned char*)lds_raw;
    constexpr int G = 256;
    unsigned char* const ws0 = p.ws; const int wave0 = __builtin_amdgcn_readfirstlane(threadIdx.x >> 6);
    cg::grid_group grid = cg::this_grid();
    if (threadIdx.x < 16) ((LAS unsigned*)(lds + LDS_BARST))[threadIdx.x] = 0u;
    __syncthreads();
    (void)xcd_barrier_post((unsigned*)(p.ws + WS_ZERO + Z_BAR), (volatile LAS unsigned*)(lds + LDS_BARST));
#if TIMING
    if (blockIdx.x == 0 && threadIdx.x == 0) ((LAS unsigned long long*)(lds + LDS_STAMP))[0] = __builtin_amdgcn_s_memrealtime();
#endif
    {
        const int tid0 = threadIdx.x;
        if (tid0 == 0) { const unsigned x = xb_xcc_id() & 7u; ((LAS int*)(lds + LDS_VBLK))[1] = (int)x; ((LAS int*)(lds + LDS_VBLK))[2] = (int)atomicAdd((unsigned*)(p.ws + WS_ZERO + Z_XC) + x, 1u); }
        ph_prologue(p, lds, tid0, tid0 & 63, wave0, G);
#if TIMING
        if (blockIdx.x == 0 && tid0 == 0) ((LAS unsigned long long*)(lds + LDS_STAMP))[32] = __builtin_amdgcn_s_memrealtime();
#endif
        grid.sync();
        if (tid0 == 0) {
            LAS int* vw = (LAS int*)(lds + LDS_VBLK); const unsigned* XC = (const unsigned*)(p.ws + WS_ZERO + Z_XC); const int myx = vw[1], myr = vw[2]; int vb = -1;
            if (myr < 32) vb = myr * 8 + myx;
            else { int o = myr - 32;
                for (int x = 0; x < myx; ++x) { const int c = (int)XC[x]; o += c > 32 ? c - 32 : 0; }
                for (int x = 0; x < 8 && vb < 0; ++x) { const int c = (int)XC[x] < 32 ? (int)XC[x] : 32, empty = 32 - c; if (o < empty) vb = (c + o) * 8 + x; else o -= empty; } }
            vw[0] = vb < 0 ? 0 : vb; }
        __syncthreads();
#if TIMING
        if (blockIdx.x == 0 && tid0 == 0) ((LAS unsigned long long*)(lds + LDS_STAMP))[1] = __builtin_amdgcn_s_memrealtime();
#endif
    }
    for (int ph = 1; ph < ph_hi; ++ph) {
        int zlane = 0; asm volatile("" : "+v"(zlane));
        const int tid = wave0 * 64 + (int)__builtin_amdgcn_mbcnt_hi(~0u, __builtin_amdgcn_mbcnt_lo(~0u, (unsigned)zlane));
        { size_t zoff = 0; asm volatile("" : "+s"(zoff)); p.ws = ws0 + zoff; }
        const int lane = tid & 63, wave = wave0;
        if (ph == PH_H1) ph_h1_first(p, lds, tid, lane, wave, G);
        else {
            const int l = (ph - PH_L0) / PH_PER_LAYER, s = (ph - PH_L0) % PH_PER_LAYER, last = l == 1;
            const float* modl = (const float*)(p.ws + WS_MOD) + (size_t)l * 9 * 6144;
            if (s == 0) {
                pg8::Gemm g{(const bf16*)(p.ws + WS_HB), (const bf16*)(p.ws + WS_WIN) + (size_t)l * INW * D, M, INW, D};
                pg8::DenseOrder S; S.init(M / 256, INW / 256, G, vblk(), 0);
                unsigned char* R = p.ws + WS_R;
                pg8::EpiInProj E{(bf16*)(R + R_QA), (bf16*)(R + R_KB), (bf16*)(R + R_KDT), (bf16*)(R + R_VT), (bf16*)(R + R_SG), (bf16*)(R + R_GU), (bf16*)(R + R_GVT), (float*)(R + R_EREF), (float*)(R + R_DEC),
                                 (float*)(p.ws + WS_ZERO + Z_SSV) + (size_t)l * M, (const float*)(p.ws + WS_LBV) + l * 1024, p.in[I_SGN] + l * 512, (size_t)M * 512, NCH};
                pg8::gemm_phase<pg8::EpiInProj, pg8::DenseOrder, true, true>(lds, g, S, E, tid);
            } else if (s == 1) { if (vblk() < 128) { scan_preload(p, lds, tid, vblk()); __syncthreads(); ph_scan(p, lds, lane, wave, vblk()); }
                else ph_sgu(p, l, lane, (vblk() - 128) * 8 + wave, 128 * 8); }
            else if (s == 2) ph_out(p, l, last, lane, wave, G);
            else if (s == 3) {
                pg8::Gemm g{(const bf16*)(p.ws + WS_HB), (const bf16*)(p.ws + WS_WOUT) + (size_t)l * D * D, M, D, D};
                pg8::DenseOrder S; S.init(last ? NB * 16 : M / 256, D / 256, G, vblk(), last);
                pg8::EpiResid E{l == 0 ? p.in[I_X] : p.out, l == 0 ? p.in[I_CTX] : (const float*)(p.ws + WS_XC), p.out, (float*)(p.ws + WS_XC), modl, (float*)(p.ws + WS_ZERO + Z_SS2) + (size_t)l * M};
                pg8::gemm_phase<pg8::EpiResid, pg8::DenseOrder, true, true>(lds, g, S, E, tid);
                if (last) ph_moe_wconv(p, l, lds, lane, wave, vblk(), G); else if (vblk() >= 32) ph_moe_wconv(p, l, lds, lane, wave, vblk() - 32, G - 32);
            } else if (s == 4) ph_router(p, l, last, lds, tid, lane, wave, G);
            else if (s == 5) ph_place(p, l, last, lds, tid, lane, wave, G);
            else if (s == 6) {
                const int* TILE = (const int*)(p.ws + WS_TILE); const int nt = __builtin_amdgcn_readfirstlane(TILE[MT_MAX]);
                pg8::Gemm g{(const bf16*)(p.ws + WS_R + R_BUF), (const bf16*)(p.ws + WS_R + R_WGU), NSLOT_PAD, 1024, D};
                pg8::MoeOrder S; S.init(TILE, nt, 4, G, vblk(), 4);
                pg8::EpiSwiglu E{(bf16*)(p.ws + WS_R + R_ACT)};
                pg8::gemm_phase<pg8::EpiSwiglu, pg8::MoeOrder, true, true>(lds, g, S, E, tid);
            } else if (s == 7) {
                const int* TILE = (const int*)(p.ws + WS_TILE); const int nt = __builtin_amdgcn_readfirstlane(TILE[MT_MAX]);
                pg8::Gemm g{(const bf16*)(p.ws + WS_R + R_ACT), (const bf16*)(p.ws + WS_R + R_WD), NSLOT_PAD, D, DE};
                pg8::MoeOrder S; S.init(TILE, nt, 4, G, vblk(), 4);
                pg8::EpiStoreBf16 E{(bf16*)(p.ws + WS_R + R_Y), D};
                pg8::gemm_phase<pg8::EpiStoreBf16, pg8::MoeOrder, true, true>(lds, g, S, E, tid);
            } else ph_combine(p, l, last, lds, tid, lane, wave, G);
        }
#if TIMING
        if (blockIdx.x == 0 && tid == 0) ((LAS unsigned long long*)(lds + LDS_STAMP))[32 + ph] = __builtin_amdgcn_s_memrealtime();
#endif
        if (ph + 1 < ph_hi) { { XcdBarrier bar; bar.bar = (unsigned*)(p.ws + WS_ZERO + Z_BAR); bar.x = xb_xcc_id(); bar.st = (volatile LAS unsigned*)(lds + LDS_BARST); xcd_barrier(bar, tid); } }
#if TIMING
        if (blockIdx.x == 0 && tid == 0) ((LAS unsigned long long*)(lds + LDS_STAMP))[ph + 1] = __builtin_amdgcn_s_memrealtime();
#endif
    }
#if TIMING
    if (blockIdx.x == 0 && threadIdx.x == 0) {
        LAS unsigned long long* st = (LAS unsigned long long*)(lds + LDS_STAMP); unsigned long long tot = 0;
        for (int k = 0; k < PH_END; ++k) if ((TIMING_MASK >> k) & 1ull) tot += (TIMING_MODE ? st[32 + k] : st[k + 1]) - st[k];
        const unsigned long long t0 = __builtin_amdgcn_s_memrealtime();
        while (__builtin_amdgcn_s_memrealtime() - t0 < tot * TIMING_MUL) __builtin_amdgcn_s_sleep(8);
    }
#endif
}

extern "C" void kernel_launch(void* const* d_in, const int* in_sizes, int n_in, void* d_out, int out_size, void* d_ws, size_t ws_size, hipStream_t stream) {
    static int grid = 0;
    if (grid == 0) {
        if (n_in != 23 || ws_size < WS_END) { fprintf(stderr, "kernel_launch: n_in %d ws %zu need %zu\n", n_in, ws_size, (size_t)WS_END); grid = -1; return; }
        int dev = 0, cus = 0, per_cu = 0;
        hipGetDevice(&dev); hipDeviceGetAttribute(&cus, hipDeviceAttributeMultiprocessorCount, dev);
        hipFuncSetAttribute((const void*)mk, hipFuncAttributeMaxDynamicSharedMemorySize, LDS_BYTES);
        hipOccupancyMaxActiveBlocksPerMultiprocessor(&per_cu, (const void*)mk, NTHREADS, LDS_BYTES);
        (void)hipGetLastError();
        grid = cus * (per_cu >= 1 ? 1 : 0);
        if (grid != 256) { fprintf(stderr, "kernel_launch: occupancy %d cus %d\n", per_cu, cus); grid = -1; return; }
    }
    if (grid < 0) return;
    hipMemsetAsync((char*)d_ws + WS_ZERO, 0, ZERO_BYTES, stream);
    Params p{};
    for (int i = 0; i < 23; ++i) p.in[i] = (const float*)d_in[i];
    p.out = (float*)d_out; p.ws = (unsigned char*)d_ws;
    int lo = 0, hi = PH_END;
    void* args[] = {&p, &lo, &hi};
    hipError_t e = hipLaunchCooperativeKernel((const void*)mk, dim3(grid), dim3(NTHREADS), args, LDS_BYTES, stream);
    if (e != hipSuccess) fprintf(stderr, "cooperative launch failed: %s (grid %d)\n", hipGetErrorString(e), grid);
}
```

```cpp
#include <hip/hip_runtime.h>
#include <hip/hip_cooperative_groups.h>
#include <cstdio>
#include <cstdint>
namespace cg = cooperative_groups;

constexpr int D = 1024, NB = 8, SEQ = 4096, CL = 256, RB = SEQ + CL  , M = NB * RB  ;
constexpr int INW = 3584, NEXP = 32, DE = 512, NSLOT = M * 2, NSLOT_PAD = NSLOT + NEXP * 256, MT_MAX = NSLOT_PAD / 256;
constexpr float EPS = 1e-6f;

namespace pg8 {
#define PG8_LAS __attribute__((address_space(3)))
typedef unsigned short bf16_t;
typedef short bf16x8 __attribute__((ext_vector_type(8)));
typedef float f32x4 __attribute__((ext_vector_type(4)));
typedef unsigned u32x4 __attribute__((ext_vector_type(4)));
constexpr int BM = 256, BK = 64, HALF = 128, HTB = HALF * BK * 2  , STAGE_BYTES = 8 * HTB, NXCD = 8, WGM = 8;

__host__ __device__ __forceinline__ int lds_byte(int r, int c) { const int st = (r >> 4) * 2 + (c >> 5), rr = r & 15, cc = c & 31, ob = rr * 64 + cc * 2; return st * 1024 + (ob ^ (((ob >> 9) & 1) << 5)); }
__host__ __device__ __forceinline__ void stage_rc(int b, int& R, int& C) { const int st = b / 1024, sb = b % 1024, swz = sb ^ (((sb >> 9) & 1) << 5); R = (st >> 1) * 16 + swz / 64; C = (st & 1) * 32 + (swz % 64) / 2; }
__host__ __device__ __forceinline__ int perm32(int rho) { const int n = rho >> 4, i = rho & 15; return 8 * (i >> 2) + 4 * n + (i & 3); }

struct Unit { int pm, pn, pb; };
struct Gemm { const bf16_t* A; const bf16_t* Bt; int M, N, K; };

struct StaticOrder {
    int nM, nN, nwg, G, c;
    __host__ __device__ void init(int M, int N, int G_, int c_) { nM = M / BM; nN = N / BM; nwg = nM * nN; G = G_; c = c_; }
    __host__ __device__ bool next(int i, Unit& u) const {
        const long L = (long)i * G + c; if (L >= nwg) return false;
        int wgid = (int)L; { const int q = nwg / NXCD, r = nwg % NXCD, xcd = wgid % NXCD, off = wgid / NXCD; wgid = (xcd < r ? xcd * (q + 1) : r * (q + 1) + (xcd - r) * q) + off; }
        const int nig = WGM * nN, gid = wgid / nig, fm = gid * WGM, gsz = (nM - fm) < WGM ? (nM - fm) : WGM;
        u.pm = fm + ((wgid % nig) % gsz); u.pn = (wgid % nig) / gsz; u.pb = u.pn; return true;
    }
    __device__ __forceinline__ void a_ready(const Unit&) const {}
    __device__ __forceinline__ void done(const Unit&) const {}
};

__device__ __forceinline__ unsigned cvt_pk_bf16(float lo, float hi) { unsigned r; asm volatile("v_cvt_pk_bf16_f32 %0, %1, %2" : "=v"(r) : "v"(lo), "v"(hi)); return r; }
typedef float f32x2 __attribute__((ext_vector_type(2)));
struct DenseOrder {
    int nM, nN, nwg, G, c, lat_only;
    __device__ void init(int nM_, int nN_, int G_, int c_, int lat_only_) { nM = nM_; nN = nN_; nwg = nM * nN; G = G_; c = c_; lat_only = lat_only_; }
    __device__ bool next(int i, Unit& u) const {
        const long L = (long)i * G + c; if (L >= nwg) return false;
        int wgid = (int)L; { const int q = nwg / NXCD, r = nwg % NXCD, xcd = wgid % NXCD, off = wgid / NXCD; wgid = (xcd < r ? xcd * (q + 1) : r * (q + 1) + (xcd - r) * q) + off; }
        const int nig = WGM * nN, gid = wgid / nig, fm = gid * WGM, gsz = (nM - fm) < WGM ? (nM - fm) : WGM;
        int pm = fm + ((wgid % nig) % gsz); u.pn = (wgid % nig) / gsz; u.pb = u.pn;
        if (lat_only) pm = (pm >> 4) * 17 + (pm & 15);
        u.pm = pm; return true;
    }
    __device__ __forceinline__ void a_ready(const Unit&) const {}
    __device__ __forceinline__ void done(const Unit&) const {}
};
struct MoeOrder {
    const int* tile_e; int nM, nN, nwg, G, c, nbt;
    __device__ void init(const int* te, int nM_, int nN_, int G_, int c_, int nbt_) { tile_e = te; nM = nM_; nN = nN_; nwg = nM * nN; G = G_; c = c_; nbt = nbt_; }
    __device__ bool next(int i, Unit& u) const {
        const long L = (long)i * G + c; if (L >= nwg) return false;
        int wgid = (int)L; { const int q = nwg / NXCD, r = nwg % NXCD, xcd = wgid % NXCD, off = wgid / NXCD; wgid = (xcd < r ? xcd * (q + 1) : r * (q + 1) + (xcd - r) * q) + off; }
        const int nig = WGM * nN, gid = wgid / nig, fm = gid * WGM, gsz = (nM - fm) < WGM ? (nM - fm) : WGM;
        u.pm = fm + ((wgid % nig) % gsz); u.pn = (wgid % nig) / gsz;
        u.pb = __builtin_amdgcn_readfirstlane(tile_e[u.pm]) * nbt + u.pn; return true;
    }
    __device__ __forceinline__ void a_ready(const Unit&) const {}
    __device__ __forceinline__ void done(const Unit&) const {}
};

__device__ __forceinline__ float fast_silu(float x) { return x * __builtin_amdgcn_rcpf(1.f + __expf(-x)); }
struct EpiStoreBf16 {
    static constexpr bool PERM = true, AFTER_DRAIN = false;
    bf16_t* O; int ldc;
    __device__ __forceinline__ void operator()(const f32x4 (&acc)[2][2][4][2], const Unit& u, int wr, int wc, int fr, int fq) const {
        const int row0 = u.pm * BM + wr * 64 + fr, col0 = u.pn * BM + wc * 32 + 8 * fq;
#pragma unroll
        for (int ai = 0; ai < 2; ++ai)
#pragma unroll
            for (int m = 0; m < 4; ++m) { bf16_t* rowp = O + (size_t)(row0 + ai * HALF + m * 16) * ldc + col0;
#pragma unroll
                for (int bj = 0; bj < 2; ++bj) { const f32x4 v0 = acc[ai][bj][m][0], v1 = acc[ai][bj][m][1];
                    u32x4 w; w.x = cvt_pk_bf16(v0[0], v0[1]); w.y = cvt_pk_bf16(v0[2], v0[3]); w.z = cvt_pk_bf16(v1[0], v1[1]); w.w = cvt_pk_bf16(v1[2], v1[3]);
                    *(u32x4*)(rowp + bj * HALF) = w; } }
    }
};
struct EpiSwiglu {
    static constexpr bool PERM = true, AFTER_DRAIN = false;
    bf16_t* ACT;
    __device__ __forceinline__ void operator()(const f32x4 (&acc)[2][2][4][2], const Unit& u, int wr, int wc, int fr, int fq) const {
        const int row0 = u.pm * BM + wr * 64 + fr, col0 = u.pn * HALF + wc * 32 + 8 * fq;
#pragma unroll
        for (int ai = 0; ai < 2; ++ai)
#pragma unroll
            for (int m = 0; m < 4; ++m) { bf16_t* rowp = ACT + (size_t)(row0 + ai * HALF + m * 16) * DE + col0;
                const f32x4 g0 = acc[ai][0][m][0], g1 = acc[ai][0][m][1], u0 = acc[ai][1][m][0], u1 = acc[ai][1][m][1];
                u32x4 w; w.x = cvt_pk_bf16(fast_silu(g0[0]) * u0[0], fast_silu(g0[1]) * u0[1]); w.y = cvt_pk_bf16(fast_silu(g0[2]) * u0[2], fast_silu(g0[3]) * u0[3]);
                w.z = cvt_pk_bf16(fast_silu(g1[0]) * u1[0], fast_silu(g1[1]) * u1[1]); w.w = cvt_pk_bf16(fast_silu(g1[2]) * u1[2], fast_silu(g1[3]) * u1[3]);
                *(u32x4*)rowp = w; }
    }
};
#define DPP_F(x, ctrl) __uint_as_float((unsigned)__builtin_amdgcn_update_dpp(0, (int)__float_as_uint(x), (ctrl), 0xf, 0xf, false))
__device__ __forceinline__ float row_allsum16(float x) { x += DPP_F(x, 0xB1); x += DPP_F(x, 0x4E); x += DPP_F(x, 0x141); x += DPP_F(x, 0x140); return x; }
__device__ __forceinline__ float row_incl_scan16(float x) { x += DPP_F(x, 0x111); x += DPP_F(x, 0x112); x += DPP_F(x, 0x114); x += DPP_F(x, 0x118); return x; }
__device__ __forceinline__ float fast_sigmoid(float x) { return __builtin_amdgcn_rcpf(1.f + __expf(-x)); }
__device__ __forceinline__ float fast_gelu(float x) { return x * fast_sigmoid(1.5957691216057308f * (x + 0.044715f * x * x * x)); }
__device__ __forceinline__ bf16_t bf16_1(float x) { return (bf16_t)(cvt_pk_bf16(x, 0.f) & 0xffffu); }
struct EpiInProj {
    static constexpr bool PERM = true, AFTER_DRAIN = false;
    bf16_t *QA, *KB, *KDT, *VT, *SG, *GU, *GVT; float *EREF, *DEC, *SSV; const float* LBV; const float* vgain; size_t dstride; int nch;
    __device__ __forceinline__ void operator()(const f32x4 (&acc)[2][2][4][2], const Unit& u, int wr, int wc, int fr, int fq) const {
        if (u.pn < 8) hgrn(acc, u, wr, wc, fr, fq); else if (u.pn < 12) actv(acc, u, wr, wc, fr, fq); else vtile(acc, u, wr, wc, fr, fq);
    }
    __device__ __forceinline__ void hgrn(const f32x4 (&acc)[2][2][4][2], const Unit& u, int wr, int wc, int fr, int fq) const {
        const int h = u.pn >> 1, dloc = (u.pn & 1) * 64 + 16 * wc + 4 * fq, dcol = h * 128 + dloc;
        const f32x4 lbf = *(const f32x4*)(LBV + dcol), lbb = *(const f32x4*)(LBV + 512 + dcol);
#pragma unroll
        for (int ai = 0; ai < 2; ++ai) {
            const int rowc = u.pm * BM + ai * HALF + wr * 64, gc = rowc >> 6;
            const size_t cb = ((size_t)(gc * 4 + h) * 4 + (dloc >> 5)) * 4;
            const int cl = ((dloc & 31) + 32 * (fr >> 3)) * 8 + (fr & 7);
            unsigned pqa[2][4][2], pkb[2][4][2]; float hqa[2][4], hkb[2][4];
#pragma unroll
            for (int e = 0; e < 4; ++e) {
#pragma unroll
                for (int dir = 0; dir < 2; ++dir) {
                    const float lb = dir ? lbb[e] : lbf[e];
                    float lf[4], kk[4], x[4], T[4];
#pragma unroll
                    for (int m = 0; m < 4; ++m) { const float z = dir ? acc[ai][1][m][0][e] : acc[ai][0][m][1][e]; const float sig = fast_sigmoid(z);
                        lf[m] = __logf(lb + (1.f - lb) * sig); kk[m] = (1.f - lb) * (1.f - sig); x[m] = lf[m]; }
#pragma unroll
                    for (int m = 0; m < 4; ++m) { T[m] = row_allsum16(x[m]); x[m] = row_incl_scan16(x[m]); }
                    const float t01 = T[0] + T[1], tot = t01 + T[2] + T[3];
                    float cum[4] = {x[0], x[1] + T[0], x[2] + t01, x[3] + t01 + T[2]}; float ref = t01;
                    if (dir) {
#pragma unroll
                        for (int m = 0; m < 4; ++m) cum[m] = tot - cum[m] + lf[m];
                        ref = tot - t01; }
                    const float etr = __expf(tot - ref);
#pragma unroll
                    for (int m = 0; m < 4; ++m) { const float q = acc[ai][0][m][0][e];
                        const float qa = q * __expf(cum[m] - ref), kb = kk[m] * __expf(ref - cum[m]), kd = kb * etr;
                        KDT[dir * dstride + ((cb + m) * 64) * 8 + cl + 8 * e] = bf16_1(kd);
                        if (e & 1) { pqa[dir][m][e >> 1] = cvt_pk_bf16(hqa[dir][m], qa); pkb[dir][m][e >> 1] = cvt_pk_bf16(hkb[dir][m], kb); } else { hqa[dir][m] = qa; hkb[dir][m] = kb; } }
                    if (fr == 0) { EREF[((size_t)dir * nch + gc) * 512 + dcol + e] = __expf(ref); DEC[((size_t)dir * nch + gc) * 512 + dcol + e] = __expf(tot); }
                }
#pragma unroll
                for (int m = 0; m < 4; ++m) VT[((cb + m) * 64) * 8 + cl + 8 * e] = bf16_1(acc[ai][1][m][1][e]);
            }
#pragma unroll
            for (int dir = 0; dir < 2; ++dir)
#pragma unroll
                for (int m = 0; m < 4; ++m) {
                    const size_t o = dir * dstride + (((((size_t)(gc * 4 + h) * 2 + (m >> 1)) * 8 + (dloc >> 4)) * 64) + 16 * (m & 1) + fr + 32 * (fq & 1)) * 8 + 4 * (fq >> 1);
                    typedef unsigned u32x2v __attribute__((ext_vector_type(2)));
                    *(u32x2v*)(QA + o) = (u32x2v){pqa[dir][m][0], pqa[dir][m][1]}; *(u32x2v*)(KB + o) = (u32x2v){pkb[dir][m][0], pkb[dir][m][1]}; }
        }
    }
    __device__ __forceinline__ void actv(const f32x4 (&acc)[2][2][4][2], const Unit& u, int wr, int wc, int fr, int fq) const {
        const bool isu = u.pn >= 10; bf16_t* O = isu ? GU : SG;
        const int row0 = u.pm * BM + wr * 64 + fr, col0 = (u.pn & 1) * 256 + wc * 32 + 8 * fq;
#pragma unroll
        for (int ai = 0; ai < 2; ++ai)
#pragma unroll
            for (int m = 0; m < 4; ++m) { bf16_t* rowp = O + (size_t)(row0 + ai * HALF + m * 16) * 512 + col0;
#pragma unroll
                for (int bj = 0; bj < 2; ++bj) { float v[8];
#pragma unroll
                    for (int i = 0; i < 8; ++i) { const float x = acc[ai][bj][m][i >> 2][i & 3]; v[i] = isu ? fast_gelu(x) : x * fast_sigmoid(x); }
                    u32x4 w; w.x = cvt_pk_bf16(v[0], v[1]); w.y = cvt_pk_bf16(v[2], v[3]); w.z = cvt_pk_bf16(v[4], v[5]); w.w = cvt_pk_bf16(v[6], v[7]);
                    *(u32x4*)(rowp + bj * HALF) = w; } }
    }
    __device__ __forceinline__ void vtile(const f32x4 (&acc)[2][2][4][2], const Unit& u, int wr, int wc, int fr, int fq) const {
        const int ch0 = (u.pn & 1) * 256 + wc * 32 + 8 * fq;
        f32x4 gn[2][2];
#pragma unroll
        for (int bj = 0; bj < 2; ++bj)
#pragma unroll
            for (int n = 0; n < 2; ++n) gn[bj][n] = *(const f32x4*)(vgain + ch0 + bj * HALF + 4 * n);
#pragma unroll
        for (int ai = 0; ai < 2; ++ai) { const int gc2 = u.pm * 2 + ai;
#pragma unroll
            for (int m = 0; m < 4; ++m) { const int tok = wr * 64 + 16 * m + fr; float s = 0.f;
#pragma unroll
                for (int bj = 0; bj < 2; ++bj)
#pragma unroll
                    for (int n = 0; n < 2; ++n)
#pragma unroll
                        for (int e = 0; e < 4; ++e) { const float g = fast_gelu(acc[ai][bj][m][n][e]); s += g * g;
                            GVT[(((((size_t)(gc2 * 4 + 2 * (u.pn & 1) + bj) * 4 + wc) * 8 + (tok >> 4)) * 64) + 8 * fq + 4 * n + e + 32 * (fr >> 3)) * 8 + (fr & 7)] = bf16_1(g * gn[bj][n][e]); }
                s += __shfl_xor(s, 16); s += __shfl_xor(s, 32);
                if (fq == 0) atomicAdd(SSV + gc2 * 128 + tok, s); } }
    }
};
struct EpiResid {
    static constexpr bool PERM = false, AFTER_DRAIN = false;
    const float* src_lat; const float* src_ctx; float* dst_lat; float* dst_ctx; const float* modl; float* ss;
    __device__ __forceinline__ void operator()(const f32x4 (&acc)[2][2][4][2], const Unit& u, int wr, int wc, int fr, int fq) const {
        const int b = u.pm / 17, j = u.pm % 17; const bool isctx = j == 16;
        const size_t trow = isctx ? (size_t)b * CL : (size_t)b * SEQ + (size_t)j * 256;
        const float* sb = (isctx ? src_ctx : src_lat) + trow * D; float* db = (isctx ? dst_ctx : dst_lat) + trow * D;
        const float* g1 = modl + (size_t)(isctx ? 8 : b) * 6144 + 2 * 1024;
        const int col0 = u.pn * BM + wc * 32 + 4 * fq;
        f32x4 gv[2][2];
#pragma unroll
        for (int bj = 0; bj < 2; ++bj)
#pragma unroll
            for (int n = 0; n < 2; ++n) gv[bj][n] = *(const f32x4*)(g1 + col0 + bj * HALF + n * 16);
#pragma unroll
        for (int ai = 0; ai < 2; ++ai) {
            f32x4 xs[4][2][2];
#pragma unroll
            for (int m = 0; m < 4; ++m) { const size_t off = (size_t)(ai * HALF + wr * 64 + m * 16 + fr) * D + col0;
#pragma unroll
                for (int bj = 0; bj < 2; ++bj)
#pragma unroll
                    for (int n = 0; n < 2; ++n) xs[m][bj][n] = *(const f32x4*)(sb + off + bj * HALF + n * 16); }
            __builtin_amdgcn_sched_barrier(0);
#pragma unroll
            for (int m = 0; m < 4; ++m) { const int rt = ai * HALF + wr * 64 + m * 16 + fr; const size_t off = (size_t)rt * D + col0; float s = 0.f;
#pragma unroll
                for (int bj = 0; bj < 2; ++bj)
#pragma unroll
                    for (int n = 0; n < 2; ++n) { const f32x4 o = xs[m][bj][n] + gv[bj][n] * acc[ai][bj][m][n];
                        *(f32x4*)(db + off + bj * HALF + n * 16) = o; s += (o[0] * o[0] + o[1] * o[1]) + (o[2] * o[2] + o[3] * o[3]); }
                s += __shfl_xor(s, 16); s += __shfl_xor(s, 32);
                if (fq == 0) atomicAdd(ss + u.pm * BM + rt, s); } }
    }
};
template <class Epi, class Sched, bool ALIGN_EPI = false, bool SP2 = false>
__device__ __forceinline__ void gemm_phase(PG8_LAS unsigned char* lds, const Gemm g, const Sched& S, const Epi& E, const int tid_in) {
    const int tid = tid_in, wid = __builtin_amdgcn_readfirstlane(tid >> 6), lane = tid & 63, wr = wid >> 2, wc = wid & 3, fr = lane & 15, fq = lane >> 4;
    const int K = g.K, nt = K / BK;
    unsigned voffA[2], voffB[2];
#pragma unroll
    for (int i = 0; i < 2; ++i) { int R, C; stage_rc(tid * 16 + i * 8192, R, C); const int Rb = Epi::PERM ? ((R & ~31) + perm32(R & 31)) : R;
        voffA[i] = (unsigned)(R * K + C) * 2u; voffB[i] = (unsigned)(Rb * K + C) * 2u; }
    const size_t kstep = (size_t)(BK * 2);
    const size_t hstep = (size_t)HALF * K * 2;
    const size_t tstep = 2 * hstep;
    const unsigned ldsw = (unsigned)wid * 1024u;
    const int aoff = lds_byte(wr * 64 + fr, fq * 8), boff = lds_byte(wc * 32 + fr, fq * 8);
#define PG8_SA(b, h) (((b) * 2 + (h)) * HTB)
#define PG8_SB(b, h) ((4 + (b) * 2 + (h)) * HTB)
#define PG8_STAGE(bufoff, gbase, voff) do { _Pragma("unroll") for (int _i = 0; _i < 2; ++_i) \
        __builtin_amdgcn_global_load_lds((const unsigned*)((const char*)(gbase) + (voff)[_i]), (PG8_LAS unsigned*)(lds + (bufoff) + ldsw + _i * 8192), 16, 0, 0); } while (0)
#define PG8_LDA(dst, b, h) do { _Pragma("unroll") for (int m = 0; m < 4; ++m) _Pragma("unroll") for (int k = 0; k < 2; ++k) dst[m][k] = *(const PG8_LAS bf16x8*)(lds + PG8_SA(b, h) + aoff + m * 2048 + k * 1024); } while (0)
#define PG8_LDB(dst, b, h) do { _Pragma("unroll") for (int n = 0; n < 2; ++n) _Pragma("unroll") for (int k = 0; k < 2; ++k) dst[n][k] = *(const PG8_LAS bf16x8*)(lds + PG8_SB(b, h) + boff + n * 2048 + k * 1024); } while (0)
#define PG8_MMA(ai, bj, At, Bt) do { __builtin_amdgcn_s_setprio(1); _Pragma("unroll") for (int m = 0; m < 4; ++m) _Pragma("unroll") for (int n = 0; n < 2; ++n) _Pragma("unroll") for (int k = 0; k < 2; ++k) \
        acc[ai][bj][m][n] = __builtin_amdgcn_mfma_f32_16x16x32_bf16(Bt[n][k], At[m][k], acc[ai][bj][m][n], 0, 0, 0); __builtin_amdgcn_s_setprio(0); } while (0)
#define PG8_WAIT_V(n) asm volatile("s_waitcnt vmcnt(" #n ")" ::: "memory")
#define PG8_WAIT_L(n) asm volatile("s_waitcnt lgkmcnt(" #n ")" ::: "memory")
#define PG8_BAR __builtin_amdgcn_s_barrier()
#define PG8_SCHED __builtin_amdgcn_sched_barrier(0)
    Unit cur, nxt; int ui = 0;
    if (!S.next(0, cur)) return;
    f32x4 acc[2][2][4][2];
#pragma unroll
    for (int a = 0; a < 2; ++a)
#pragma unroll
        for (int b = 0; b < 2; ++b)
#pragma unroll
            for (int m = 0; m < 4; ++m)
#pragma unroll
                for (int n = 0; n < 2; ++n) acc[a][b][m][n] = (f32x4){0.f, 0.f, 0.f, 0.f};
    bf16x8 At[4][2], B0[2][2], B1[2][2];
    const char* cA = (const char*)g.A + (size_t)cur.pm * tstep; const char* cB = (const char*)g.Bt + (size_t)cur.pb * tstep;
    S.a_ready(cur);
    if constexpr (SP2) {
        PG8_STAGE(PG8_SB(0, 0), cB, voffB); PG8_STAGE(PG8_SB(0, 1), cB + hstep, voffB); PG8_STAGE(PG8_SA(0, 0), cA, voffA); PG8_STAGE(PG8_SA(0, 1), cA + hstep, voffA);
        if (wr == 1) PG8_BAR;
        PG8_WAIT_V(2); PG8_BAR;
        PG8_STAGE(PG8_SB(1, 0), cB + kstep, voffB); PG8_STAGE(PG8_SA(1, 0), cA + kstep, voffA); PG8_STAGE(PG8_SB(1, 1), cB + hstep + kstep, voffB);
        PG8_WAIT_V(6); PG8_BAR;
    } else {
        PG8_STAGE(PG8_SB(0, 0), cB, voffB); PG8_STAGE(PG8_SA(0, 0), cA, voffA); PG8_STAGE(PG8_SB(0, 1), cB + hstep, voffB); PG8_STAGE(PG8_SA(0, 1), cA + hstep, voffA);
        if (wr == 1) PG8_BAR;
        PG8_WAIT_V(4); PG8_BAR;
        PG8_STAGE(PG8_SB(1, 0), cB + kstep, voffB); PG8_STAGE(PG8_SA(1, 0), cA + kstep, voffA); PG8_STAGE(PG8_SB(1, 1), cB + hstep + kstep, voffB);
        PG8_WAIT_V(6); PG8_BAR;
    }
    for (;;) {
        const bool has_next = S.next(ui + 1, nxt);
        const char* nA = has_next ? (const char*)g.A + (size_t)nxt.pm * tstep : cA; const char* nB = has_next ? (const char*)g.Bt + (size_t)nxt.pb * tstep : cB;
        for (int t = 0; t < nt; t += 2) {
            const bool last = (t == nt - 2);
            const char* a1 = cA + (size_t)(t + 1) * kstep;
            const char* a2 = last ? nA : cA + (size_t)(t + 2) * kstep; const char* b2 = last ? nB : cB + (size_t)(t + 2) * kstep;
            const char* a3 = a2 + kstep; const char* b3 = b2 + kstep;
            if (last && has_next) S.a_ready(nxt);
            if constexpr (SP2) {
            PG8_LDB(B0, 0, 0); PG8_LDB(B1, 0, 1); PG8_SCHED; PG8_LDA(At, 0, 0); PG8_STAGE(PG8_SA(1, 1), a1 + hstep, voffA);
            PG8_WAIT_V(8); PG8_WAIT_L(0); PG8_BAR; PG8_MMA(0, 0, At, B0); PG8_MMA(0, 1, At, B1); PG8_BAR; PG8_SCHED;
            PG8_LDA(At, 0, 1); PG8_STAGE(PG8_SB(0, 0), b2, voffB); PG8_STAGE(PG8_SB(0, 1), b2 + hstep, voffB); PG8_STAGE(PG8_SA(0, 0), a2, voffA);
            PG8_WAIT_V(8); PG8_WAIT_L(0); PG8_BAR; PG8_MMA(1, 0, At, B0); PG8_MMA(1, 1, At, B1); PG8_BAR; PG8_SCHED;
            PG8_LDB(B0, 1, 0); PG8_LDB(B1, 1, 1); PG8_SCHED; PG8_LDA(At, 1, 0); PG8_STAGE(PG8_SA(0, 1), a2 + hstep, voffA);
            PG8_WAIT_V(8); PG8_WAIT_L(0); PG8_BAR; PG8_MMA(0, 0, At, B0); PG8_MMA(0, 1, At, B1); PG8_BAR; PG8_SCHED;
            PG8_LDA(At, 1, 1); PG8_STAGE(PG8_SB(1, 0), b3, voffB); PG8_STAGE(PG8_SB(1, 1), b3 + hstep, voffB); PG8_STAGE(PG8_SA(1, 0), a3, voffA);
            PG8_WAIT_V(8); PG8_WAIT_L(0); PG8_BAR; PG8_MMA(1, 0, At, B0); PG8_MMA(1, 1, At, B1); PG8_BAR; PG8_SCHED;
            } else {
            PG8_LDB(B0, 0, 0); PG8_SCHED; PG8_LDA(At, 0, 0); PG8_STAGE(PG8_SA(1, 1), a1 + hstep, voffA);
            PG8_WAIT_L(8); PG8_BAR; PG8_WAIT_L(0); PG8_MMA(0, 0, At, B0); PG8_BAR; PG8_SCHED;
            PG8_LDB(B1, 0, 1); PG8_STAGE(PG8_SB(0, 0), b2, voffB);
            PG8_BAR; PG8_WAIT_L(0); PG8_MMA(0, 1, At, B1); PG8_BAR;
            PG8_LDA(At, 0, 1); PG8_STAGE(PG8_SA(0, 0), a2, voffA);
            PG8_BAR; PG8_WAIT_L(0); PG8_MMA(1, 0, At, B0); PG8_BAR; PG8_SCHED;
            PG8_STAGE(PG8_SB(0, 1), b2 + hstep, voffB);
            PG8_WAIT_V(6); PG8_BAR; PG8_MMA(1, 1, At, B1); PG8_BAR;
            PG8_LDB(B0, 1, 0); PG8_SCHED; PG8_LDA(At, 1, 0); PG8_STAGE(PG8_SA(0, 1), a2 + hstep, voffA);
            PG8_WAIT_L(8); PG8_BAR; PG8_WAIT_L(0); PG8_MMA(0, 0, At, B0); PG8_BAR; PG8_SCHED;
            PG8_LDB(B1, 1, 1); PG8_STAGE(PG8_SB(1, 0), b3, voffB);
            PG8_BAR; PG8_WAIT_L(0); PG8_MMA(0, 1, At, B1); PG8_BAR;
            PG8_LDA(At, 1, 1); PG8_STAGE(PG8_SA(1, 0), a3, voffA);
            PG8_BAR; PG8_WAIT_L(0); PG8_MMA(1, 0, At, B0); PG8_BAR; PG8_SCHED;
            PG8_STAGE(PG8_SB(1, 1), b3 + hstep, voffB);
            PG8_WAIT_V(6); PG8_BAR; PG8_MMA(1, 1, At, B1); PG8_BAR;
            }
        }
        if constexpr (ALIGN_EPI) { if (wr == 0) PG8_BAR; }
        if constexpr (!Epi::AFTER_DRAIN) { E(acc, cur, wr, wc, fr, fq); S.done(cur); }
        if (!has_next) break;
#pragma unroll
        for (int a = 0; a < 2; ++a)
#pragma unroll
            for (int b = 0; b < 2; ++b)
#pragma unroll
                for (int m = 0; m < 4; ++m)
#pragma unroll
                    for (int n = 0; n < 2; ++n) acc[a][b][m][n] = (f32x4){0.f, 0.f, 0.f, 0.f};
        cur = nxt; cA = nA; cB = nB; ++ui;
        if constexpr (ALIGN_EPI) { if (wr == 1) PG8_BAR; }
    }
    PG8_WAIT_V(0);
    if constexpr (!ALIGN_EPI) { if (wr == 0) PG8_BAR; }
    PG8_BAR;
    if constexpr (Epi::AFTER_DRAIN) { E.fused(acc, cur, wr, wc, fr, fq, lds, wid, lane); S.done(cur); }
#undef PG8_SA
#undef PG8_SB
#undef PG8_STAGE
#undef PG8_LDA
#undef PG8_LDB
#undef PG8_MMA
#undef PG8_WAIT_V
#undef PG8_WAIT_L
#undef PG8_BAR
#undef PG8_SCHED
}
}

#define LAS __attribute__((address_space(3)))
typedef unsigned short bf16;
typedef float f32x4 __attribute__((ext_vector_type(4)));
typedef unsigned u32x4 __attribute__((ext_vector_type(4)));
typedef unsigned u32x2 __attribute__((ext_vector_type(2)));
constexpr int NWAVES = 8, NTHREADS = 512, LDS_BYTES = 160 * 1024;
#define SCHED_FENCE() __builtin_amdgcn_sched_barrier(0)

__device__ __forceinline__ unsigned f2bf(float f) { unsigned u = __float_as_uint(f); return (u + 0x7fffu + ((u >> 16) & 1u)) >> 16; }
__device__ __forceinline__ unsigned pk2(float lo, float hi) { return f2bf(lo) | (f2bf(hi) << 16); }
__device__ __forceinline__ unsigned cvt2(float lo, float hi) { return pg8::cvt_pk_bf16(lo, hi); }
__device__ __forceinline__ float bf2f(unsigned h) { return __uint_as_float(h << 16); }
#define DPPF(x, ctrl) __uint_as_float((unsigned)__builtin_amdgcn_update_dpp(0, (int)__float_as_uint(x), (ctrl), 0xf, 0xf, false))
__device__ __forceinline__ float wave_sum(float v) {
    v += DPPF(v, 0xB1); v += DPPF(v, 0x4E); v += DPPF(v, 0x141); v += DPPF(v, 0x140);
    const float s0 = __uint_as_float(__builtin_amdgcn_readlane(__float_as_uint(v), 0)), s1 = __uint_as_float(__builtin_amdgcn_readlane(__float_as_uint(v), 16));
    const float s2 = __uint_as_float(__builtin_amdgcn_readlane(__float_as_uint(v), 32)), s3 = __uint_as_float(__builtin_amdgcn_readlane(__float_as_uint(v), 48));
    return (s0 + s1) + (s2 + s3);
}
__device__ __forceinline__ float siluf(float x) { return x / (1.f + expf(-x)); }
__device__ __forceinline__ float gelu_tanh(float x) { return 0.5f * x * (1.f + tanhf(0.7978845608028654f * (x + 0.044715f * x * x * x))); }
__device__ __forceinline__ int mod_row(int row) { return ((row % RB) < SEQ) ? row / RB : 8; }
__device__ __forceinline__ bool is_ctx_row(int row) { return (row % RB) >= SEQ; }

typedef __attribute__((address_space(1))) unsigned gu32;
#define RLX_AGENT __ATOMIC_RELAXED, __HIP_MEMORY_SCOPE_AGENT
#define XB_TMO      128
#define XB_XCNT(j)  (256  + 64 * (j))
#define XB_XSUB(j)  (1280 + 64 * (j))
#define XB_XGEN(j)  (2304 + 64 * (j))
#define XB_TOP      3328
#define XB_TOPGEN   3392
#define XCD_BAR_WORDS 3456
#define XB_SPIN_CAP (1u << 18)

__device__ __forceinline__ unsigned xb_ld(unsigned* p)              { return __hip_atomic_load(p, __ATOMIC_RELAXED, __HIP_MEMORY_SCOPE_AGENT); }
__device__ __forceinline__ unsigned xb_add(unsigned* p, unsigned v) { return __hip_atomic_fetch_add(p, v, __ATOMIC_RELAXED, __HIP_MEMORY_SCOPE_AGENT); }
__device__ __forceinline__ unsigned xb_xcc_id() { return (unsigned)__builtin_amdgcn_s_getreg((3 << 11) | 20) & 0xFu; }
#define XB_SPIN(cond, bar) do { unsigned _sp = 0; while (cond) { __builtin_amdgcn_s_sleep(1); \
    if ((++_sp & 255u) == 0u) { if (xb_ld(&(bar)[XB_TMO])) break; if (_sp > XB_SPIN_CAP) { atomicAdd(&(bar)[XB_TMO], 1u); break; } } } } while (0)

struct XcdBarrier {
    unsigned* bar; unsigned x;
    volatile LAS unsigned* st;
};

__device__ __forceinline__ XcdBarrier xcd_barrier_post(unsigned* bar, volatile LAS unsigned* st) {
    XcdBarrier b; b.bar = bar; b.x = xb_xcc_id(); b.st = st;
    if (threadIdx.x == 0) (void)xb_add(&bar[XB_XCNT(b.x)], 1u);
    return b;
}
__device__ __forceinline__ void xcd_barrier_complete(unsigned* bar, unsigned x, unsigned& nloc, unsigned& nx) {
    const unsigned G = gridDim.x * gridDim.y * gridDim.z;
    unsigned sum, cnt, mine, sp = 0u;
    for (;;) {
        sum = 0u; cnt = 0u; mine = 0u;
#pragma unroll
        for (unsigned j = 0; j < 16; ++j) { const unsigned c = xb_ld(&bar[XB_XCNT(j)]); sum += c; cnt += (c > 0u) ? 1u : 0u; mine = (j == x) ? c : mine; }
        if (sum == G) break;
        __builtin_amdgcn_s_sleep(1);
        if ((++sp & 255u) == 0u) { if (xb_ld(&bar[XB_TMO])) break; if (sp > XB_SPIN_CAP) { atomicAdd(&bar[XB_TMO], 1u); break; } }
    }
    nloc = mine > 0u ? mine : 1u; nx = cnt > 0u ? cnt : 1u;
}

__device__ __forceinline__ void xcd_barrier(const XcdBarrier& b, const int xb_tid) {
    asm volatile("s_waitcnt vmcnt(0)" ::: "memory");
    __syncthreads();
    if (xb_tid == 0) {
        unsigned* bar = b.bar;
        __builtin_amdgcn_s_waitcnt(0);
        unsigned nloc = b.st[0], nx = b.st[1];
        if (nloc == 0u) { xcd_barrier_complete(bar, b.x, nloc, nx); b.st[0] = nloc; b.st[1] = nx; }
        const unsigned old = xb_add(&bar[XB_XSUB(b.x)], 1u);
        const unsigned gen = old / nloc;
        if (old + 1u == (gen + 1u) * nloc) {
            __builtin_amdgcn_fence(__ATOMIC_RELEASE, "agent");
            asm volatile("s_waitcnt vmcnt(0)" ::: "memory");
            const unsigned og = xb_add(&bar[XB_TOP], 1u);
            const unsigned tg = og / nx;
            if (og + 1u == (tg + 1u) * nx) xb_add(&bar[XB_TOPGEN], 1u);
            else XB_SPIN(xb_ld(&bar[XB_TOPGEN]) == tg, bar);
            __builtin_amdgcn_fence(__ATOMIC_ACQUIRE, "agent");
            xb_add(&bar[XB_XGEN(b.x)], 1u);
            asm volatile("s_waitcnt vmcnt(0)" ::: "memory");
        } else {
            XB_SPIN(xb_ld(&bar[XB_XGEN(b.x)]) == gen, bar);
            __builtin_amdgcn_fence(__ATOMIC_ACQUIRE, "agent");
            asm volatile("s_waitcnt vmcnt(0)" ::: "memory");
        }
    }
    __syncthreads();
}

constexpr size_t al256(size_t x) { return (x + 255) & ~(size_t)255; }
constexpr size_t WS_ZERO = 0, ZERO_BYTES = 2u << 20;
constexpr size_t Z_GCNT = 0;
constexpr size_t Z_SS2 = 4096;
constexpr size_t WS_MOD = ZERO_BYTES;
constexpr size_t WS_WRT = WS_MOD + al256((size_t)2 * 9 * 6144 * 4);
constexpr size_t WS_TOKE = WS_WRT + al256((size_t)2 * 36 * 1024 * 4);
constexpr size_t WS_TOKP = WS_TOKE + al256((size_t)NSLOT * 4);
constexpr size_t WS_TOKC = WS_TOKP + al256((size_t)NSLOT * 4);
constexpr size_t WS_TOKS = WS_TOKC + al256((size_t)NSLOT * 4);
constexpr size_t WS_TILE = WS_TOKS + al256((size_t)NSLOT * 4);
constexpr size_t WS_XC = WS_TILE + al256((size_t)(MT_MAX + 64) * 4);
constexpr size_t WS_WIN = WS_XC + al256((size_t)NB * CL * D * 4);
constexpr size_t WS_WOUT = WS_WIN + al256((size_t)2 * INW * D * 2);
constexpr size_t WS_WSB = WS_WOUT + al256((size_t)2 * D * D * 2);
constexpr size_t WS_LBV = WS_WSB + al256((size_t)2 * 4 * 128 * 128 * 2);
constexpr size_t WS_HB = WS_LBV + al256((size_t)2 * 2 * 512 * 4);
constexpr size_t WS_R = WS_HB + al256((size_t)M * D * 2);
constexpr int NCH = M / 64  , NCH2 = M / 128;
constexpr size_t R_QA = 0;
constexpr size_t R_KB = R_QA + al256((size_t)2 * M * 512 * 2);
constexpr size_t R_KDT = R_KB + al256((size_t)2 * M * 512 * 2);
constexpr size_t R_VT = R_KDT + al256((size_t)2 * M * 512 * 2);
constexpr size_t R_SG = R_VT + al256((size_t)M * 512 * 2);
constexpr size_t R_GU = R_SG + al256((size_t)M * 512 * 2);
constexpr size_t R_GVT = R_GU + al256((size_t)M * 512 * 2);
constexpr size_t R_EREF = R_GVT + al256((size_t)M * 512 * 2);
constexpr size_t R_DEC = R_EREF + al256((size_t)2 * NCH * 512 * 4);
constexpr size_t R_ST = R_DEC + al256((size_t)2 * NCH * 512 * 4);
constexpr size_t R_MIX_END = R_ST + al256((size_t)(NCH + 1) * 2 * 4 * 128 * 128 * 2);
constexpr size_t R_HS_DUMMY = 0;
constexpr size_t R_WGU = 0;
constexpr size_t R_WD = R_WGU + al256((size_t)NEXP * 1024 * D * 2);
constexpr size_t R_BUF = R_WD + al256((size_t)NEXP * D * DE * 2);
constexpr size_t R_ACT = R_BUF + al256((size_t)NSLOT_PAD * D * 2);
constexpr size_t R_Y = R_ACT + al256((size_t)NSLOT_PAD * DE * 2);
constexpr size_t R_MOE_END = R_Y + al256((size_t)NSLOT_PAD * D * 2);
constexpr size_t WS_END = WS_R + (R_MIX_END > R_MOE_END ? R_MIX_END : R_MOE_END);
static_assert(WS_END <= (size_t)634 * 1000 * 1000, "workspace budget (sum of inputs = 634.3 MB)");
constexpr size_t Z_SSV = Z_SS2 + (size_t)2 * M * 4;
constexpr size_t Z_XC = Z_GCNT + 256;
constexpr size_t Z_BAR = Z_SSV + (size_t)2 * M * 4;
static_assert(Z_BAR % 256 == 0 && Z_BAR + (size_t)XCD_BAR_WORDS * 4 <= ZERO_BYTES, "zeroed region");
constexpr int LDS_BARST = LDS_BYTES - 64, LDS_VBLK = LDS_BYTES - 32, LDS_STAMP = LDS_BYTES - 1024;

struct Params { const float* in[23]; float* out; unsigned char* ws; };
enum { I_X = 0, I_C, I_CTX, I_CCTX, I_NORM1, I_NORM2, I_WMOD, I_BMOD, I_WIN, I_LB, I_HGN, I_SGN, I_SGW, I_SGB, I_WOUT, I_WG, I_BG, I_WR, I_BR, I_WGATE, I_WUP, I_WDOWN, I_FN };

__device__ __forceinline__ void transpose_item(const float* W, int K, int N, bf16* WT, int k0, int n0, int rowbase, LAS float* scr, int lane) {
    float t[32];
#pragma unroll
    for (int i = 0; i < 32; ++i) t[i] = W[(size_t)(k0 + 2 * i + (lane >> 5)) * N + n0 + (lane & 31)];
    SCHED_FENCE();
#pragma unroll
    for (int i = 0; i < 32; ++i) scr[(2 * i + (lane >> 5)) * 33 + (lane & 31)] = t[i];
    asm volatile("s_waitcnt lgkmcnt(0)" ::: "memory");
    const int c = lane & 7;
#pragma unroll
    for (int j = 0; j < 4; ++j) { const int n = (lane >> 3) + 8 * j; const LAS float* s = scr + (8 * c) * 33 + n;
        u32x4 o; o.x = cvt2(s[0 * 33], s[1 * 33]); o.y = cvt2(s[2 * 33], s[3 * 33]); o.z = cvt2(s[4 * 33], s[5 * 33]); o.w = cvt2(s[6 * 33], s[7 * 33]);
        *(u32x4*)(WT + (size_t)(rowbase + n) * K + k0 + 8 * c) = o; }
    asm volatile("s_waitcnt lgkmcnt(0)" ::: "memory");
}
__device__ __forceinline__ void transpose_item_g(const float* W, int K, int N, bf16* WT, int k0, int srccol_lane, int rowbase, LAS float* scr, int lane) {
    float t[32];
#pragma unroll
    for (int i = 0; i < 32; ++i) t[i] = W[(size_t)(k0 + 2 * i + (lane >> 5)) * N + srccol_lane];
    SCHED_FENCE();
#pragma unroll
    for (int i = 0; i < 32; ++i) scr[(2 * i + (lane >> 5)) * 33 + (lane & 31)] = t[i];
    asm volatile("s_waitcnt lgkmcnt(0)" ::: "memory");
    const int c = lane & 7;
#pragma unroll
    for (int j = 0; j < 4; ++j) { const int n = (lane >> 3) + 8 * j; const LAS float* s = scr + (8 * c) * 33 + n;
        u32x4 o; o.x = cvt2(s[0 * 33], s[1 * 33]); o.y = cvt2(s[2 * 33], s[3 * 33]); o.z = cvt2(s[4 * 33], s[5 * 33]); o.w = cvt2(s[6 * 33], s[7 * 33]);
        *(u32x4*)(WT + (size_t)(rowbase + n) * K + k0 + 8 * c) = o; }
    asm volatile("s_waitcnt lgkmcnt(0)" ::: "memory");
}
__device__ __forceinline__ int win_srccol(int r) {
    const int pn = r >> 8, c = r & 255;
    if (pn >= 8) return 2048 + (pn - 8) * 256 + c;
    const int bj = c >> 7, wc = (c >> 5) & 3, fq = (c >> 3) & 3, n = (c >> 2) & 1, e = c & 3;
    return (2 * bj + n) * 512 + (pn >> 1) * 128 + (pn & 1) * 64 + 16 * wc + 4 * fq + e;
}
__device__ __forceinline__ void norm_mod_row(const float* xr, const float* gain, const float* sh, const float* sc, bf16* orow, int lane) {
    f32x4 v[4]; float ss = 0.f;
#pragma unroll
    for (int j = 0; j < 4; ++j) { v[j] = *(const f32x4*)(xr + 4 * lane + 256 * j); ss += (v[j][0] * v[j][0] + v[j][1] * v[j][1]) + (v[j][2] * v[j][2] + v[j][3] * v[j][3]); }
    const float rs = rsqrtf(wave_sum(ss) * (1.f / D) + EPS);
#pragma unroll
    for (int j = 0; j < 4; ++j) { const int k = 4 * lane + 256 * j; const f32x4 g = *(const f32x4*)(gain + k), s1 = *(const f32x4*)(sc + k), s0 = *(const f32x4*)(sh + k);
        const f32x4 o = v[j] * rs * g * (s1 + 1.f) + s0; u32x2 w; w.x = cvt2(o[0], o[1]); w.y = cvt2(o[2], o[3]); *(u32x2*)(orow + k) = w; }
}
__device__ __forceinline__ const float* xrow_in(const Params& p, int row) { const int b = row / RB, t = row % RB; return t < SEQ ? p.in[I_X] + ((size_t)b * SEQ + t) * D : p.in[I_CTX] + ((size_t)b * CL + (t - SEQ)) * D; }
__device__ __forceinline__ float* xrow_cur(const Params& p, int row) { const int b = row / RB, t = row % RB; return t < SEQ ? p.out + ((size_t)b * SEQ + t) * D : (float*)(p.ws + WS_XC) + ((size_t)b * CL + (t - SEQ)) * D; }

__device__ __forceinline__ int vblk() { return __builtin_amdgcn_readfirstlane(*(const LAS int*)(unsigned)LDS_VBLK); }
__device__ __forceinline__ void ph_prologue(const Params& p, LAS unsigned char* lds, int tid, int lane, int wave, int G) {
    float* MOD = (float*)(p.ws + WS_MOD);
    if (blockIdx.x < 192) {
        const int l = blockIdx.x / 96, col0 = (blockIdx.x % 96) * 64;
        LAS float* sc = (LAS float*)lds; LAS float* red = (LAS float*)(lds + 36864);
        for (int i = tid; i < 9 * 1024; i += NTHREADS) { const int r = i >> 10, k = i & 1023; sc[i] = siluf(r < 8 ? p.in[I_C][r * 1024 + k] : p.in[I_CCTX][k]); }
        __syncthreads();
        const int c4 = tid & 15, kg = tid >> 4;
        f32x4 acc[9];
#pragma unroll
        for (int r = 0; r < 9; ++r) acc[r] = (f32x4){0.f, 0.f, 0.f, 0.f};
        const float* w = p.in[I_WMOD] + (size_t)l * 1024 * 6144 + col0 + 4 * c4;
#pragma unroll 8
        for (int k = kg; k < 1024; k += 32) { const f32x4 wv = *(const f32x4*)(w + (size_t)k * 6144);
#pragma unroll
            for (int r = 0; r < 9; ++r) acc[r] += wv * sc[r * 1024 + k]; }
#pragma unroll
        for (int r = 0; r < 9; ++r) *(LAS f32x4*)&red[(kg * 9 + r) * 64 + 4 * c4] = acc[r];
        __syncthreads();
        for (int i = tid; i < 576; i += NTHREADS) { const int r = i >> 6, cc = i & 63; float s = 0.f;
            for (int g = 0; g < 32; ++g) s += red[(g * 9 + r) * 64 + cc];
            MOD[(size_t)(l * 9 + r) * 6144 + col0 + cc] = s + p.in[I_BMOD][l * 6144 + col0 + cc]; }
        __syncthreads();
    }
    {
        float* WRT = (float*)(p.ws + WS_WRT);
        for (int i = blockIdx.x * NTHREADS + tid; i < 2 * 36 * 1024; i += G * NTHREADS) { const int l = i / (36 * 1024), o = (i / 1024) % 36, k = i & 1023;
            WRT[i] = o < 4 ? p.in[I_WG][((size_t)l * 1024 + k) * 4 + o] : p.in[I_WR][((size_t)l * 1024 + k) * 32 + (o - 4)]; }
    }
    {
        float* LBV = (float*)(p.ws + WS_LBV); bf16* WSB = (bf16*)(p.ws + WS_WSB);
        for (int i = blockIdx.x * NTHREADS + tid; i < 1024; i += G * NTHREADS) { LBV[i] = 0.f; LBV[1024 + i] = 1.f / (1.f + expf(p.in[I_LB][i] - p.in[I_LB][1024 + i])); }
        for (int i = blockIdx.x * NTHREADS + tid; i < 2 * 4 * 128 * 128; i += G * NTHREADS) {
            const int jj = i & 7, L = (i >> 3) & 63, sidx = (i >> 9) & 7, itile = (i >> 12) & 3, lh = i >> 14;
            WSB[i] = (bf16)f2bf(p.in[I_SGW][(size_t)lh * 128 * 128 + (32 * itile + (L & 31)) * 128 + 16 * sidx + 8 * (L >> 5) + jj]); }
    }
    LAS float* scr = (LAS float*)(lds + wave * 16384);
    const int gw = blockIdx.x * NWAVES + wave, NGW = G * NWAVES;
    constexpr int I_IN = (D / 64) * (INW / 32), I_OUT = (D / 64) * (D / 32);
    for (int it = gw; it < 2 * (I_IN + I_OUT); it += NGW) {
        const int l = it / (I_IN + I_OUT); int r = it % (I_IN + I_OUT);
        if (r < I_IN) { const int nblk = INW / 32, kb = r / nblk, nb = r % nblk; transpose_item_g(p.in[I_WIN] + (size_t)l * D * INW, D, INW, (bf16*)(p.ws + WS_WIN) + (size_t)l * INW * D, 64 * kb, win_srccol(32 * nb + (lane & 31)), 32 * nb, scr, lane); }
        else { r -= I_IN; const int nblk = D / 32, kb = r / nblk, nb = r % nblk; transpose_item(p.in[I_WOUT] + (size_t)l * D * D, D, D, (bf16*)(p.ws + WS_WOUT) + (size_t)l * D * D, 64 * kb, 32 * nb, 32 * nb, scr, lane); }
    }
}
__device__ __forceinline__ void ph_h1_first(const Params& p, LAS unsigned char* lds, int tid, int lane, int wave, int G) {
    const float* MOD = (const float*)(p.ws + WS_MOD); bf16* HB = (bf16*)(p.ws + WS_HB); const float* gain = p.in[I_NORM1];
    LAS f32x4* sm = (LAS f32x4*)lds;
    { f32x4 t[10];
#pragma unroll
      for (int i = 0; i < 10; ++i) { const int e = tid + i * NTHREADS; if (e < 19 * 256) { const int blk = e >> 8, c = e & 255; t[i] = blk < 18 ? *(const f32x4*)(MOD + (size_t)(blk >> 1) * 6144 + (blk & 1) * 1024 + 4 * c) : *(const f32x4*)(gain + 4 * c); } }
      SCHED_FENCE();
#pragma unroll
      for (int i = 0; i < 10; ++i) { const int e = tid + i * NTHREADS; if (e < 19 * 256) sm[e] = t[i]; } }
    __syncthreads();
    const int stride = G * NWAVES;
    for (int row0 = vblk() * NWAVES + wave; row0 < M; row0 += 4 * stride) {
        f32x4 v[4][4]; bool act[4]; int rows[4];
#pragma unroll
        for (int rr = 0; rr < 4; ++rr) { const int row = row0 + rr * stride; act[rr] = row < M; rows[rr] = act[rr] ? row : row0; const float* xr = xrow_in(p, rows[rr]);
#pragma unroll
            for (int j = 0; j < 4; ++j) v[rr][j] = *(const f32x4*)(xr + 4 * lane + 256 * j); }
        SCHED_FENCE();
#pragma unroll
        for (int rr = 0; rr < 4; ++rr) { float ss = 0.f;
#pragma unroll
            for (int j = 0; j < 4; ++j) ss += (v[rr][j][0] * v[rr][j][0] + v[rr][j][1] * v[rr][j][1]) + (v[rr][j][2] * v[rr][j][2] + v[rr][j][3] * v[rr][j][3]);
            const float rs = rsqrtf(wave_sum(ss) * (1.f / D) + EPS); const int mr = mod_row(rows[rr]);
            if (act[rr]) {
#pragma unroll
                for (int j = 0; j < 4; ++j) { const int c = lane + 64 * j; const f32x4 o = v[rr][j] * rs * sm[18 * 256 + c] * (sm[(mr * 2 + 1) * 256 + c] + 1.f) + sm[(mr * 2) * 256 + c];
                    u32x2 w; w.x = cvt2(o[0], o[1]); w.y = cvt2(o[2], o[3]); *(u32x2*)(HB + (size_t)rows[rr] * D + 4 * c) = w; } } }
    }
}
__device__ __forceinline__ void ph_moe_wconv(const Params& p, int l, LAS unsigned char* lds, int lane, int wave, int blk, int nblk) {
    LAS float* scr = (LAS float*)(lds + wave * 16384);
    bf16* WGU = (bf16*)(p.ws + WS_R + R_WGU); bf16* WD = (bf16*)(p.ws + WS_R + R_WD);
    constexpr int I_G = (D / 64) * (DE / 32)  , I_D = (DE / 64) * (D / 32)  , PER_E = 2 * I_G + I_D;
    for (int it = blk * NWAVES + wave; it < NEXP * PER_E; it += nblk * NWAVES) {
        const int e = it / PER_E; int r = it % PER_E;
        if (r < 2 * I_G) { const int isup = r >= I_G; r -= isup * I_G; const int nblk = DE / 32, kb = r / nblk, nb = r % nblk, n0 = 32 * nb;
            const float* W = p.in[isup ? I_WUP : I_WGATE] + ((size_t)l * NEXP + e) * D * DE;
            transpose_item(W, D, DE, WGU + (size_t)e * 1024 * D, 64 * kb, n0, 256 * (n0 >> 7) + 128 * isup + (n0 & 127), scr, lane); }
        else { r -= 2 * I_G; const int nblk = D / 32, kb = r / nblk, nb = r % nblk;
            transpose_item(p.in[I_WDOWN] + ((size_t)l * NEXP + e) * DE * D, DE, D, WD + (size_t)e * D * DE, 64 * kb, 32 * nb, 32 * nb, scr, lane); }
    }
}
__device__ __forceinline__ float opaque_v(float x) { asm volatile("" : "+v"(x)); return x; }
__device__ __forceinline__ void ph_router(const Params& p, int l, int last, LAS unsigned char* lds, int tid, int lane, int wave, int G) {
    LAS float* W = (LAS float*)lds; LAS int* hist = (LAS int*)(lds + 147456); LAS int* base = hist + 32; LAS int* sinfo = base + 32 + wave * 40;
    const float* WRT = (const float*)(p.ws + WS_WRT) + (size_t)l * 36 * 1024;
    { f32x4 wt[18];
#pragma unroll
      for (int i = 0; i < 18; ++i) wt[i] = ((const f32x4*)WRT)[tid + i * NTHREADS];
      SCHED_FENCE();
#pragma unroll
      for (int i = 0; i < 18; ++i) ((LAS f32x4*)W)[tid + i * NTHREADS] = wt[i]; }
    if (tid < 32) hist[tid] = 0;
    const float* MOD = (const float*)(p.ws + WS_MOD) + (size_t)l * 9 * 6144; const float* SS2 = (const float*)(p.ws + WS_ZERO + Z_SS2) + (size_t)l * M;
    bf16* HB = (bf16*)(p.ws + WS_HB); int* TOKE = (int*)(p.ws + WS_TOKE); float* TOKC = (float*)(p.ws + WS_TOKC); int* TOKP = (int*)(p.ws + WS_TOKP);
    int* gcnt = (int*)(p.ws + WS_ZERO + Z_GCNT) + l * 64;
    const float* gain = p.in[I_NORM2] + l * D;
    LAS float* Bv = (LAS float*)(lds + 147456 + 2048);
    if (tid < 36) Bv[tid] = tid < 4 ? p.in[I_BG][l * 4 + tid] : p.in[I_BR][l * 32 + tid - 4];
    __syncthreads();
    int nloc = 0;
    const int stride = G * NWAVES;
    for (int row0 = vblk() * NWAVES + wave; row0 < M; row0 += 2 * stride) {
        const bool two = row0 + stride < M; const int rows[2] = {row0, two ? row0 + stride : row0};
        bool act[2]; f32x4 h[2][4];
        {
            f32x4 xv[2][4], s1v[2][4], s0v[2][4], gv[4]; float ssq[2];
#pragma unroll
            for (int rr = 0; rr < 2; ++rr) { const int row = rows[rr]; act[rr] = (rr == 0 || two) && !(last && is_ctx_row(row));
                const float* xr = xrow_cur(p, row); const float* mr = MOD + (size_t)mod_row(row) * 6144; ssq[rr] = SS2[row];
#pragma unroll
                for (int j = 0; j < 4; ++j) { const int k = 4 * lane + 256 * j; xv[rr][j] = *(const f32x4*)(xr + k); s1v[rr][j] = *(const f32x4*)(mr + 4 * 1024 + k); s0v[rr][j] = *(const f32x4*)(mr + 3 * 1024 + k); } }
#pragma unroll
            for (int j = 0; j < 4; ++j) gv[j] = *(const f32x4*)(gain + 4 * lane + 256 * j);
            SCHED_FENCE();
#pragma unroll
            for (int rr = 0; rr < 2; ++rr) { const float rs = rsqrtf(ssq[rr] * (1.f / D) + EPS);
#pragma unroll
                for (int j = 0; j < 4; ++j) { const int k = 4 * lane + 256 * j; h[rr][j] = xv[rr][j] * rs * gv[j] * (s1v[rr][j] + 1.f) + s0v[rr][j];
                    if (act[rr]) { u32x2 w; w.x = cvt2(h[rr][j][0], h[rr][j][1]); w.y = cvt2(h[rr][j][2], h[rr][j][3]); *(u32x2*)(HB + (size_t)rows[rr] * D + k) = w; } } }
        }
        typedef float f32x2 __attribute__((ext_vector_type(2)));
        float gl[2][4];
        { f32x4 wg[16];
#pragma unroll
          for (int q = 0; q < 16; ++q) wg[q] = *(const LAS f32x4*)&W[(q >> 2) * 1024 + 4 * lane + 256 * (q & 3)];
          SCHED_FENCE();
#pragma unroll
          for (int o = 0; o < 4; ++o)
#pragma unroll
              for (int rr = 0; rr < 2; ++rr) { f32x2 a2 = {0.f, 0.f};
#pragma unroll
                  for (int j = 0; j < 4; ++j) { const f32x4 wv = wg[o * 4 + j], hv = h[rr][j];
                      a2 = __builtin_elementwise_fma((f32x2){hv[0], hv[1]}, (f32x2){wv[0], wv[1]}, a2); a2 = __builtin_elementwise_fma((f32x2){hv[2], hv[3]}, (f32x2){wv[2], wv[3]}, a2); }
                  gl[rr][o] = opaque_v(wave_sum(a2[0] + a2[1]) + Bv[o]); } }
#pragma unroll
        for (int rr = 0; rr < 2; ++rr) {
            const int row = rows[rr];
            int gs = 0; float gmax = gl[rr][0];
#pragma unroll
            for (int o = 1; o < 4; ++o) if (gl[rr][o] > gmax) { gmax = gl[rr][o]; gs = o; }
            float den = 0.f;
#pragma unroll
            for (int o = 0; o < 4; ++o) den += __expf(gl[rr][o] - gmax);
            const float psel = 1.f / den;
            const int gsu = __builtin_amdgcn_readfirstlane(gs);
            const LAS float* wb = W + (4 + 8 * gsu) * 1024 + 4 * lane; const LAS float* bb = Bv + 4 + 8 * gsu;
            float li[8];
#pragma unroll
            for (int half = 0; half < 2; ++half) { f32x4 we[16];
#pragma unroll
                for (int q = 0; q < 16; ++q) we[q] = *(const LAS f32x4*)&wb[(4 * half + (q >> 2)) * 1024 + 256 * (q & 3)];
                SCHED_FENCE();
#pragma unroll
                for (int o = 0; o < 4; ++o) { f32x2 a2 = {0.f, 0.f};
#pragma unroll
                    for (int j = 0; j < 4; ++j) { const f32x4 wv = we[o * 4 + j], hv = h[rr][j];
                        a2 = __builtin_elementwise_fma((f32x2){hv[0], hv[1]}, (f32x2){wv[0], wv[1]}, a2); a2 = __builtin_elementwise_fma((f32x2){hv[2], hv[3]}, (f32x2){wv[2], wv[3]}, a2); }
                    li[4 * half + o] = opaque_v(wave_sum(a2[0] + a2[1]) + bb[4 * half + o]); } }
            int i0 = 0; float m0 = li[0];
#pragma unroll
            for (int j = 1; j < 8; ++j) if (li[j] > m0) { m0 = li[j]; i0 = j; }
            int i1 = 0; float m1 = -3.0e38f;
#pragma unroll
            for (int j = 0; j < 8; ++j) if (j != i0 && li[j] > m1) { m1 = li[j]; i1 = j; }
            const float e1 = __expf(m1 - m0);
            if (act[rr]) {
                if (lane < 2) { const int e = gs * 8 + (lane ? i1 : i0); const float c = lane ? psel * e1 / (1.f + e1) : psel / (1.f + e1);
                    const int lp = __hip_atomic_fetch_add(&hist[e], 1, __ATOMIC_RELAXED, __HIP_MEMORY_SCOPE_WORKGROUP); TOKE[row * 2 + lane] = e; TOKC[row * 2 + lane] = c; sinfo[nloc * 2 + lane] = (e << 16) | lp; }
                ++nloc; }
        }
    }
    __syncthreads();
    if (tid < 32) base[tid] = atomicAdd(&gcnt[tid], hist[tid]);
    __syncthreads();
    nloc = 0;
    for (int row0 = vblk() * NWAVES + wave; row0 < M; row0 += 2 * stride) {
        const bool two = row0 + stride < M;
#pragma unroll
        for (int rr = 0; rr < 2; ++rr) { const int row = rr ? row0 + stride : row0; if ((rr == 0 || two) && !(last && is_ctx_row(row))) {
            if (lane < 2) { const int info = sinfo[nloc * 2 + lane]; TOKP[row * 2 + lane] = base[info >> 16] + (info & 0xffff); }
            ++nloc; } }
    }
}
__device__ __forceinline__ void ph_place(const Params& p, int l, int last, LAS unsigned char* lds, int tid, int lane, int wave, int G) {
    LAS int* ps = (LAS int*)lds;
    const int* gcnt = (const int*)(p.ws + WS_ZERO + Z_GCNT) + l * 64; int* TILE = (int*)(p.ws + WS_TILE);
    if (tid == 0) { int s = 0; for (int e = 0; e < NEXP; ++e) { ps[e] = s; s += (gcnt[e] + 255) / 256 * 256; } ps[32] = s; }
    __syncthreads();
    if (vblk() == 0 && tid < 32) { for (int t = ps[tid] / 256; t < ps[tid + 1] / 256; ++t) TILE[t] = tid; if (tid == 0) TILE[MT_MAX] = ps[32] / 256; }
    const bf16* HB = (const bf16*)(p.ws + WS_HB); bf16* BUF = (bf16*)(p.ws + WS_R + R_BUF);
    const int* TOKE = (const int*)(p.ws + WS_TOKE); const int* TOKP = (const int*)(p.ws + WS_TOKP); int* TOKS = (int*)(p.ws + WS_TOKS);
    const int stride = G * NWAVES;
    for (int row0 = vblk() * NWAVES + wave; row0 < M; row0 += 2 * stride) {
        const bool two = row0 + stride < M; const int rows[2] = {row0, two ? row0 + stride : row0};
        bool act[2]; int s0[2], s1[2]; u32x4 a[2], b[2];
#pragma unroll
        for (int rr = 0; rr < 2; ++rr) { const int row = rows[rr]; act[rr] = (rr == 0 || two) && !(last && is_ctx_row(row));
            const int e0 = act[rr] ? TOKE[row * 2] : 0, e1 = act[rr] ? TOKE[row * 2 + 1] : 0;
            s0[rr] = ps[e0] + TOKP[row * 2]; s1[rr] = ps[e1] + TOKP[row * 2 + 1];
            a[rr] = ((const u32x4*)(HB + (size_t)row * D))[lane]; b[rr] = ((const u32x4*)(HB + (size_t)row * D))[lane + 64]; }
#pragma unroll
        for (int rr = 0; rr < 2; ++rr) if (act[rr]) { const int row = rows[rr];
            ((u32x4*)(BUF + (size_t)s0[rr] * D))[lane] = a[rr]; ((u32x4*)(BUF + (size_t)s0[rr] * D))[lane + 64] = b[rr];
            ((u32x4*)(BUF + (size_t)s1[rr] * D))[lane] = a[rr]; ((u32x4*)(BUF + (size_t)s1[rr] * D))[lane + 64] = b[rr];
            if (lane == 0) { TOKS[row * 2] = s0[rr]; TOKS[row * 2 + 1] = s1[rr]; } }
    }
}
__device__ __forceinline__ void ph_combine(const Params& p, int l, int last, LAS unsigned char* lds, int tid, int lane, int wave, int G) {
    const float* MOD = (const float*)(p.ws + WS_MOD); const bf16* Y = (const bf16*)(p.ws + WS_R + R_Y); bf16* HB = (bf16*)(p.ws + WS_HB);
    const int* TOKS = (const int*)(p.ws + WS_TOKS); const float* TOKC = (const float*)(p.ws + WS_TOKC);
    const float* gain = last ? p.in[I_FN] : p.in[I_NORM1] + (l + 1) * D;
    LAS f32x4* sm = (LAS f32x4*)lds;
    { f32x4 t[14];
#pragma unroll
      for (int i = 0; i < 14; ++i) { const int e = tid + i * NTHREADS; if (e < 28 * 256) { const int blk = e >> 8, c = e & 255, mr = blk / 3, wh = blk % 3;
          t[i] = blk < 27 ? *(const f32x4*)(MOD + ((size_t)(wh == 0 ? l : (last ? l : l + 1)) * 9 + mr) * 6144 + (wh == 0 ? 5 : wh - 1) * 1024 + 4 * c) : *(const f32x4*)(gain + 4 * c); } }
      SCHED_FENCE();
#pragma unroll
      for (int i = 0; i < 14; ++i) { const int e = tid + i * NTHREADS; if (e < 28 * 256) sm[e] = t[i]; } }
    __syncthreads();
    const int stride = G * NWAVES;
    for (int row0 = vblk() * NWAVES + wave; row0 < M; row0 += 4 * stride) {
        bool act[4]; int rows[4]; float* xr[4]; f32x4 x[4][4]; u32x2 y0[4][4], y1[4][4]; float c0[4], c1[4];
#pragma unroll
        for (int rr = 0; rr < 4; ++rr) { const int rw = row0 + rr * stride; const bool in = rw < M; const int row = in ? rw : row0; rows[rr] = row; act[rr] = in && !(last && is_ctx_row(row)); xr[rr] = xrow_cur(p, row);
            const int s0 = act[rr] ? TOKS[row * 2] : 0, s1 = act[rr] ? TOKS[row * 2 + 1] : 0; c0[rr] = TOKC[row * 2]; c1[rr] = TOKC[row * 2 + 1];
#pragma unroll
            for (int j = 0; j < 4; ++j) { const int k = 4 * lane + 256 * j; x[rr][j] = *(const f32x4*)(xr[rr] + k); y0[rr][j] = *(const u32x2*)(Y + (size_t)s0 * D + k); y1[rr][j] = *(const u32x2*)(Y + (size_t)s1 * D + k); } }
        SCHED_FENCE();
#pragma unroll
        for (int rr = 0; rr < 4; ++rr) { f32x4 v[4]; float ss = 0.f; const int mr = mod_row(rows[rr]);
#pragma unroll
            for (int j = 0; j < 4; ++j) { const u32x2 a = y0[rr][j], b = y1[rr][j]; f32x4 f;
                f[0] = c0[rr] * bf2f(a.x & 0xffffu) + c1[rr] * bf2f(b.x & 0xffffu); f[1] = c0[rr] * bf2f(a.x >> 16) + c1[rr] * bf2f(b.x >> 16);
                f[2] = c0[rr] * bf2f(a.y & 0xffffu) + c1[rr] * bf2f(b.y & 0xffffu); f[3] = c0[rr] * bf2f(a.y >> 16) + c1[rr] * bf2f(b.y >> 16);
                v[j] = x[rr][j] + sm[(mr * 3) * 256 + lane + 64 * j] * f; ss += (v[j][0] * v[j][0] + v[j][1] * v[j][1]) + (v[j][2] * v[j][2] + v[j][3] * v[j][3]); }
            const float rs = rsqrtf(wave_sum(ss) * (1.f / D) + EPS);
            if (act[rr]) {
                if (!last) {
#pragma unroll
                    for (int j = 0; j < 4; ++j) { const int c = lane + 64 * j, k = 4 * c; *(f32x4*)(xr[rr] + k) = v[j];
                        const f32x4 o = v[j] * rs * sm[27 * 256 + c] * (sm[(mr * 3 + 2) * 256 + c] + 1.f) + sm[(mr * 3 + 1) * 256 + c];
                        u32x2 w; w.x = cvt2(o[0], o[1]); w.y = cvt2(o[2], o[3]); *(u32x2*)(HB + (size_t)rows[rr] * D + k) = w; } }
                else {
#pragma unroll
                    for (int j = 0; j < 4; ++j) { const int c = lane + 64 * j; *(f32x4*)(xr[rr] + 4 * c) = v[j] * rs * sm[27 * 256 + c]; } } } }
    }
}
__device__ __forceinline__ int scan_chunk(int step, int dir) { return dir == 0 ? (step < 4 ? 64 + step : step - 4) : 67 - step; }
typedef short bf16x8 __attribute__((ext_vector_type(8)));
typedef short s16x4 __attribute__((ext_vector_type(4)));
typedef float f32x16 __attribute__((ext_vector_type(16)));
#define MFMA32(a, b, c) __builtin_amdgcn_mfma_f32_32x32x16_bf16((a), (b), (c), 0, 0, 0)
__device__ __forceinline__ bf16x8 ld8(const bf16* q) { return *(const bf16x8*)q; }
__device__ __forceinline__ bf16x8 ld44(const bf16* q0, const bf16* q1) { const s16x4 lo = *(const s16x4*)q0, hi = *(const s16x4*)q1; return __builtin_shufflevector(lo, hi, 0, 1, 2, 3, 4, 5, 6, 7); }
__device__ __forceinline__ f32x16 zero16() { f32x16 z;
#pragma unroll
    for (int i = 0; i < 16; ++i) z[i] = 0.f; return z; }
__device__ __forceinline__ bf16x8 pack_acc(const f32x16& x, int s) { u32x4 w; w.x = pk2(x[8 * s], x[8 * s + 1]); w.y = pk2(x[8 * s + 2], x[8 * s + 3]); w.z = pk2(x[8 * s + 4], x[8 * s + 5]); w.w = pk2(x[8 * s + 6], x[8 * s + 7]); return __builtin_bit_cast(bf16x8, w); }
__device__ __forceinline__ bf16x8 scale8(bf16x8 f, f32x4 a, f32x4 b) { const u32x4 w = __builtin_bit_cast(u32x4, f); u32x4 o;
    o.x = cvt2(bf2f(w.x & 0xffffu) * a[0], bf2f(w.x >> 16) * a[1]); o.y = cvt2(bf2f(w.y & 0xffffu) * a[2], bf2f(w.y >> 16) * a[3]);
    o.z = cvt2(bf2f(w.z & 0xffffu) * b[0], bf2f(w.z >> 16) * b[1]); o.w = cvt2(bf2f(w.w & 0xffffu) * b[2], bf2f(w.w >> 16) * b[3]); return __builtin_bit_cast(bf16x8, o); }

constexpr int SCAN_DE_BYTES = 69 * 256 * 4, SCAN_RING_OFF = 71680, SCAN_BUF_BYTES = 24 * 1024;
__device__ __forceinline__ void scan_item(int item, int& b, int& h, int& dir, int& eh) {
    const int xcd = item & 7, j = item >> 3, pair = (j >> 2) * 8 + xcd; eh = j & 1; dir = (j >> 1) & 1; h = pair & 3; b = pair >> 2;
}
__device__ __forceinline__ void scan_preload(const Params& p, LAS unsigned char* lds, int tid, int item) {
    int b, h, dir, eh; scan_item(item, b, h, dir, eh);
    const float* DEC = (const float*)(p.ws + WS_R + R_DEC) + (size_t)dir * NCH * 512 + h * 128; const float* ER = (const float*)(p.ws + WS_R + R_EREF) + (size_t)dir * NCH * 512 + h * 128;
    LAS float* de = (LAS float*)lds;
    for (int i = tid; i < 69 * 256; i += NTHREADS) { const int step = i >> 8, w = i & 255; const size_t gc = (size_t)(b * 68 + scan_chunk(step < 68 ? step : 67, dir));
        de[i] = w < 128 ? DEC[gc * 512 + w] : ER[gc * 512 + (w - 128)]; }
}
struct ScanRegs { bf16x8 f[3]; };
__device__ __forceinline__ void ph_scan(const Params& p, LAS unsigned char* lds, int lane, int wave, int item) {
    int b, h, dir, eh; scan_item(item, b, h, dir, eh);
    const int dt = wave & 3, etl = wave >> 2, et = 2 * eh + etl, hh = lane >> 5;
    const bf16* KD = (const bf16*)(p.ws + WS_R + R_KDT) + (size_t)dir * M * 512; const bf16* V = (const bf16*)(p.ws + WS_R + R_VT);
    const bf16* src[3];
#pragma unroll
    for (int i = 0; i < 3; ++i) { const int f = 3 * wave + i; src[i] = f < 16 ? KD + ((((size_t)h * 4 + (f >> 2)) * 4 + (f & 3)) * 64 + lane) * 8 : V + ((((size_t)h * 4 + 2 * eh + ((f - 16) >> 2)) * 4 + (f & 3)) * 64 + lane) * 8; }
    const LAS float* de = (const LAS float*)lds + 32 * dt + 4 * hh;
    LAS unsigned char* ring = lds + SCAN_RING_OFF;
    const int wofs = 3 * wave * 1024 + lane * 16, aofs = dt * 4 * 1024 + lane * 16, bofs = (16 + etl * 4) * 1024 + lane * 16;
    bf16* ST = (bf16*)(p.ws + WS_R + R_ST) + (((size_t)dir * 4 + h) * 16 + dt * 4 + et) * 1024 + lane * 8;
    f32x16 S = zero16();
#define SCAN_GC(step) ((size_t)(b * 68 + scan_chunk((step) < 68 ? (step) : 67, dir)))
#define SCAN_LOAD(R, step) { const size_t g_ = SCAN_GC(step) * (4 * 4 * 4 * 512); _Pragma("unroll") for (int i = 0; i < 3; ++i) R.f[i] = ld8(src[i] + g_); }
#define SCAN_WRITE(R, buf) { _Pragma("unroll") for (int i = 0; i < 3; ++i) *(LAS bf16x8*)(ring + (buf) * SCAN_BUF_BYTES + wofs + i * 1024) = R.f[i]; }
#define SCAN_BAR() { asm volatile("s_waitcnt lgkmcnt(0)" ::: "memory"); __builtin_amdgcn_s_barrier(); asm volatile("" ::: "memory"); }
    ScanRegs P0, P1;
    SCAN_LOAD(P0, 0); SCAN_LOAD(P1, 1);
    SCAN_WRITE(P0, 0); SCAN_LOAD(P0, 2);
    for (int k0 = 0; k0 < 72; k0 += 6) {
#pragma unroll
        for (int j = 0; j < 6; ++j) { const int k = k0 + j;
            SCAN_BAR();
            if ((j + 1) & 1) { SCAN_WRITE(P1, (j + 1) % 3); SCAN_LOAD(P1, k + 3); } else { SCAN_WRITE(P0, (j + 1) % 3); SCAN_LOAD(P0, k + 3); }
            const LAS unsigned char* buf = ring + (j % 3) * SCAN_BUF_BYTES;
            bf16x8 fa[4], fb[4]; f32x4 dc[4], er[4]; const LAS float* dk = de + (k < 69 ? k : 68) * 256;
#pragma unroll
            for (int s = 0; s < 4; ++s) { fa[s] = *(const LAS bf16x8*)(buf + aofs + s * 1024); fb[s] = *(const LAS bf16x8*)(buf + bofs + s * 1024); dc[s] = *(const LAS f32x4*)(dk + 8 * s); er[s] = *(const LAS f32x4*)(dk + 128 + 8 * s); }
            { bf16* st = ST + (k < 68 ? SCAN_GC(k) : (size_t)NCH) * (2 * 4 * 16384); u32x4 w0, w1;
              w0.x = cvt2(S[0] * er[0][0], S[1] * er[0][1]); w0.y = cvt2(S[2] * er[0][2], S[3] * er[0][3]); w0.z = cvt2(S[4] * er[1][0], S[5] * er[1][1]); w0.w = cvt2(S[6] * er[1][2], S[7] * er[1][3]);
              w1.x = cvt2(S[8] * er[2][0], S[9] * er[2][1]); w1.y = cvt2(S[10] * er[2][2], S[11] * er[2][3]); w1.z = cvt2(S[12] * er[3][0], S[13] * er[3][1]); w1.w = cvt2(S[14] * er[3][2], S[15] * er[3][3]);
              *(u32x4*)st = w0; *(u32x4*)(st + 512) = w1; }
#pragma unroll
            for (int g = 0; g < 4; ++g)
#pragma unroll
                for (int q = 0; q < 4; ++q) S[4 * g + q] *= dc[g][q];
#pragma unroll
            for (int s = 0; s < 4; ++s) S = MFMA32(fa[s], fb[s], S);
        }
    }
#undef SCAN_GC
#undef SCAN_LOAD
#undef SCAN_WRITE
#undef SCAN_BAR
}
__device__ __forceinline__ void ph_sgu(const Params& p, int l, int lane, int widx, int nw) {
    const bf16* GVT = (const bf16*)(p.ws + WS_R + R_GVT); const bf16* GU = (const bf16*)(p.ws + WS_R + R_GU); bf16* HS = (bf16*)(p.ws + WS_HB);
    const float* SSV = (const float*)(p.ws + WS_ZERO + Z_SSV) + (size_t)l * M; const bf16* WSB = (const bf16*)(p.ws + WS_WSB) + (size_t)l * 4 * 128 * 128; const float* bs = p.in[I_SGB] + l * 512;
    const int r = lane & 31, hh = lane >> 5;
    for (int it = widx; it < NCH2 * 16; it += nw) { const int gc2 = it >> 4, h = (it >> 2) & 3, cht = it & 3;
        const bf16* ap = GVT + ((((size_t)(gc2 * 4 + h) * 4 + cht) * 8) * 64 + lane) * 8; const float* sp = SSV + gc2 * 128 + 8 * hh; const bf16* wp = WSB + ((((size_t)h * 4) * 8) * 64 + lane) * 8;
        f32x16 acc[4] = {zero16(), zero16(), zero16(), zero16()};
        bf16x8 av[8]; f32x4 sv[16];
#pragma unroll
        for (int s = 0; s < 8; ++s) { av[s] = ld8(ap + s * 512); sv[2 * s] = *(const f32x4*)(sp + 16 * s); sv[2 * s + 1] = *(const f32x4*)(sp + 16 * s + 4); }
        bf16x8 wa[4], wb[4];
#pragma unroll
        for (int t = 0; t < 4; ++t) wa[t] = ld8(wp + (size_t)t * 8 * 512);
#pragma unroll
        for (int s = 0; s < 8; ++s) {
            SCHED_FENCE();
            if (s < 7) {
#pragma unroll
                for (int t = 0; t < 4; ++t) { const bf16x8 w = ld8(wp + (size_t)t * 8 * 512 + (s + 1) * 512); if (s & 1) wa[t] = w; else wb[t] = w; } }
            SCHED_FENCE();
            f32x4 s0 = sv[2 * s], s1 = sv[2 * s + 1];
#pragma unroll
            for (int q = 0; q < 4; ++q) { s0[q] = rsqrtf(s0[q] * (1.f / 512.f) + EPS); s1[q] = rsqrtf(s1[q] * (1.f / 512.f) + EPS); }
            const bf16x8 a = scale8(av[s], s0, s1);
#pragma unroll
            for (int t = 0; t < 4; ++t) acc[t] = MFMA32(a, (s & 1) ? wb[t] : wa[t], acc[t]); }
        u32x2 gu[4][4]; float bias[4];
#pragma unroll
        for (int t = 0; t < 4; ++t) { const size_t row = (size_t)gc2 * 128 + 32 * t + r; bias[t] = bs[h * 128 + 32 * t + r];
#pragma unroll
            for (int g = 0; g < 4; ++g) gu[t][g] = *(const u32x2*)(GU + row * 512 + h * 128 + 32 * cht + 8 * g + 4 * hh); }
        SCHED_FENCE();
#pragma unroll
        for (int t = 0; t < 4; ++t) { const size_t row = (size_t)gc2 * 128 + 32 * t + r;
#pragma unroll
            for (int g = 0; g < 4; ++g) { const int ch = h * 128 + 32 * cht + 8 * g + 4 * hh; const u32x2 u = gu[t][g];
                u32x2 w; w.x = cvt2(bf2f(u.x & 0xffffu) * (acc[t][4 * g] + bias[t]), bf2f(u.x >> 16) * (acc[t][4 * g + 1] + bias[t])); w.y = cvt2(bf2f(u.y & 0xffffu) * (acc[t][4 * g + 2] + bias[t]), bf2f(u.y >> 16) * (acc[t][4 * g + 3] + bias[t]));
                *(u32x2*)(HS + row * D + 512 + ch) = w; } }
    }
}
__device__ __forceinline__ void ph_out(const Params& p, int l, int last, LAS unsigned char* lds, int lane, int wave, int G) {
    const bf16* QA = (const bf16*)(p.ws + WS_R + R_QA); const bf16* KB = (const bf16*)(p.ws + WS_R + R_KB); const bf16* VT = (const bf16*)(p.ws + WS_R + R_VT);
    const bf16* ST = (const bf16*)(p.ws + WS_R + R_ST); const bf16* SG = (const bf16*)(p.ws + WS_R + R_SG);
    bf16* HS = (bf16*)(p.ws + WS_HB); const float* gain = p.in[I_HGN] + l * 512;
    const int r = lane & 31, hh = lane >> 5;
    for (int it = vblk() * NWAVES + wave; it < NCH * 8; it += G * NWAVES) { const int gc = it >> 3, h = (it >> 1) & 3, ih = it & 1;
        if (last && (gc % 68) >= 64) continue;
        f32x16 o[4] = {zero16(), zero16(), zero16(), zero16()}; f32x16 Pd, Po;
#pragma unroll
        for (int dir = 0; dir < 2; ++dir) {
            const bf16* qp = QA + (size_t)dir * M * 512 + ((((size_t)(gc * 4 + h) * 2 + ih) * 8) * 64 + lane) * 8;
            const bf16* kd = KB + (size_t)dir * M * 512 + ((((size_t)(gc * 4 + h) * 2 + ih) * 8) * 64 + lane) * 8;
            const bf16* ko = KB + (size_t)dir * M * 512 + ((((size_t)(gc * 4 + h) * 2 + (1 - ih)) * 8) * 64 + lane) * 8;
            const bf16* sp = ST + (((size_t)gc * 2 + dir) * 4 + h) * 16384 + lane * 8;
            const bool off = (dir == 0) == (ih == 1);
            bf16x8 qa[8], ka[8], sa[8], sb[8];
#pragma unroll
            for (int s = 0; s < 8; ++s) { qa[s] = ld8(qp + s * 512); ka[s] = ld8(kd + s * 512); }
            if (off) {
#pragma unroll
                for (int s = 0; s < 8; ++s) sb[s] = ld8(ko + s * 512); }
            SCHED_FENCE();
            { f32x16 t = zero16();
#pragma unroll
              for (int s = 0; s < 8; ++s) t = MFMA32(ka[s], qa[s], t);
              SCHED_FENCE();
#pragma unroll
              for (int s = 0; s < 8; ++s) sa[s] = ld8(sp + (size_t)((s >> 1) * 4 + 0) * 1024 + 512 * (s & 1));
              SCHED_FENCE();
#pragma unroll
              for (int q = 0; q < 16; ++q) { const int j = (q & 3) + 8 * (q >> 2) + 4 * hh; const bool keep = dir == 0 ? (j <= r) : (j >= r); const float v = keep ? t[q] : 0.f; if (dir == 0) Pd[q] = v; else Pd[q] += v; } }
            if (off) { f32x16 t = zero16();
#pragma unroll
              for (int s = 0; s < 8; ++s) t = MFMA32(sb[s], qa[s], t);
              Po = t; }
#pragma unroll
            for (int et = 0; et < 4; ++et) {
                SCHED_FENCE();
                if (et < 3) {
#pragma unroll
                    for (int s = 0; s < 8; ++s) { const bf16x8 w = ld8(sp + (size_t)((s >> 1) * 4 + et + 1) * 1024 + 512 * (s & 1)); if (et & 1) sa[s] = w; else sb[s] = w; } }
                SCHED_FENCE();
#pragma unroll
                for (int s = 0; s < 8; ++s) o[et] = MFMA32((et & 1) ? sb[s] : sa[s], qa[s], o[et]);
            }
        }
        {
            const bf16* vp = VT + (((size_t)(gc * 4 + h) * 4 * 4) * 64 + r) * 8 + 4 * hh;
            bf16x8 va[4][4];
#pragma unroll
            for (int et = 0; et < 4; ++et)
#pragma unroll
                for (int k = 0; k < 4; ++k) { const bf16* v = vp + (size_t)(et * 4 + k) * 512; va[et][k] = ld44(v, v + 32 * 8); }
            SCHED_FENCE();
#pragma unroll
            for (int s = 0; s < 2; ++s) { const bf16x8 pd = pack_acc(Pd, s), po = pack_acc(Po, s);
#pragma unroll
                for (int et = 0; et < 4; ++et) { o[et] = MFMA32(ih ? va[et][2 + s] : va[et][s], pd, o[et]); o[et] = MFMA32(ih ? va[et][s] : va[et][2 + s], po, o[et]); } }
        }
        float ss = 0.f;
#pragma unroll
        for (int et = 0; et < 4; ++et)
#pragma unroll
            for (int q = 0; q < 16; ++q) ss += o[et][q] * o[et][q];
        ss += __shfl_xor(ss, 32);
        const float rs = rsqrtf(ss * (1.f / 128.f) + EPS);
        LAS unsigned char* img = lds + wave * 8704;
#pragma unroll
        for (int et = 0; et < 4; ++et)
#pragma unroll
            for (int g = 0; g < 4; ++g) { u32x2 w; w.x = cvt2(o[et][4 * g] * rs, o[et][4 * g + 1] * rs); w.y = cvt2(o[et][4 * g + 2] * rs, o[et][4 * g + 3] * rs);
                *(LAS u32x2*)(img + r * 272 + (32 * et + 8 * g + 4 * hh) * 2) = w; }
        asm volatile("s_waitcnt lgkmcnt(0)" ::: "memory");
        const int ck = lane & 15, rq = lane >> 4;
        const f32x4 g0 = *(const f32x4*)(gain + h * 128 + 8 * ck), g1 = *(const f32x4*)(gain + h * 128 + 8 * ck + 4);
        u32x4 sg[8], ov[8];
#pragma unroll
        for (int i = 0; i < 8; ++i) { const size_t row = (size_t)gc * 64 + 32 * ih + 4 * i + rq; sg[i] = *(const u32x4*)(SG + row * 512 + h * 128 + 8 * ck); ov[i] = *(const LAS u32x4*)(img + (4 * i + rq) * 272 + ck * 16); }
#pragma unroll
        for (int i = 0; i < 8; ++i) { const size_t row = (size_t)gc * 64 + 32 * ih + 4 * i + rq; const u32x4 a = ov[i], b = sg[i]; u32x4 w;
            w.x = cvt2(bf2f(a.x & 0xffffu) * g0[0] * bf2f(b.x & 0xffffu), bf2f(a.x >> 16) * g0[1] * bf2f(b.x >> 16)); w.y = cvt2(bf2f(a.y & 0xffffu) * g0[2] * bf2f(b.y & 0xffffu), bf2f(a.y >> 16) * g0[3] * bf2f(b.y >> 16));
            w.z = cvt2(bf2f(a.z & 0xffffu) * g1[0] * bf2f(b.z & 0xffffu), bf2f(a.z >> 16) * g1[1] * bf2f(b.z >> 16)); w.w = cvt2(bf2f(a.w & 0xffffu) * g1[2] * bf2f(b.w & 0xffffu), bf2f(a.w >> 16) * g1[3] * bf2f(b.w >> 16));
            *(u32x4*)(HS + row * D + h * 128 + 8 * ck) = w; }
        asm volatile("s_waitcnt lgkmcnt(0)" ::: "memory");
    }
}
#ifndef TIMING
#define TIMING 0
#endif
#ifndef TIMING_MASK
#define TIMING_MASK 0ull
#endif
#ifndef TIMING_MODE
#define TIMING_MODE 0
#endif
#ifndef TIMING_MUL
#define TIMING_MUL 4
#endif
constexpr int PH_PRO = 0, PH_H1 = 1, PH_L0 = 2, PH_PER_LAYER = 9, PH_END = PH_L0 + 2 * PH_PER_LAYER;
__device__ __forceinline__ void* launder_ptr(void* q) { unsigned long long v = (unsigned long long)q; asm volatile("" : "+s"(v)); return (void*)v; }
__global__ void __launch_bounds__(NTHREADS, 2) mk(Params p, int ph_lo, int ph_hi) {
    extern __shared__ __attribute__((aligned(16))) unsigned char lds_raw[];
    LAS unsigned char* lds = (LAS unsigned char*)lds_raw;
    constexpr int G = 256;
    unsigned char* const ws0 = p.ws; const int wave0 = __builtin_amdgcn_readfirstlane(threadIdx.x >> 6);
    cg::grid_group grid = cg::this_grid();
    if (threadIdx.x < 16) ((LAS unsigned*)(lds + LDS_BARST))[threadIdx.x] = 0u;
    __syncthreads();
    (void)xcd_barrier_post((unsigned*)(p.ws + WS_ZERO + Z_BAR), (volatile LAS unsigned*)(lds + LDS_BARST));
#if TIMING
    if (blockIdx.x == 0 && threadIdx.x == 0) ((LAS unsigned long long*)(lds + LDS_STAMP))[0] = __builtin_amdgcn_s_memrealtime();
#endif
    {
        const int tid0 = threadIdx.x;
        if (tid0 == 0) { const unsigned x = xb_xcc_id() & 7u; ((LAS int*)(lds + LDS_VBLK))[1] = (int)x; ((LAS int*)(lds + LDS_VBLK))[2] = (int)atomicAdd((unsigned*)(p.ws + WS_ZERO + Z_XC) + x, 1u); }
        ph_prologue(p, lds, tid0, tid0 & 63, wave0, G);
#if TIMING
        if (blockIdx.x == 0 && tid0 == 0) ((LAS unsigned long long*)(lds + LDS_STAMP))[32] = __builtin_amdgcn_s_memrealtime();
#endif
        grid.sync();
        if (tid0 == 0) {
            LAS int* vw = (LAS int*)(lds + LDS_VBLK); const unsigned* XC = (const unsigned*)(p.ws + WS_ZERO + Z_XC); const int myx = vw[1], myr = vw[2]; int vb = -1;
            if (myr < 32) vb = myr * 8 + myx;
            else { int o = myr - 32;
                for (int x = 0; x < myx; ++x) { const int c = (int)XC[x]; o += c > 32 ? c - 32 : 0; }
                for (int x = 0; x < 8 && vb < 0; ++x) { const int c = (int)XC[x] < 32 ? (int)XC[x] : 32, empty = 32 - c; if (o < empty) vb = (c + o) * 8 + x; else o -= empty; } }
            vw[0] = vb < 0 ? 0 : vb; }
        __syncthreads();
#if TIMING
        if (blockIdx.x == 0 && tid0 == 0) ((LAS unsigned long long*)(lds + LDS_STAMP))[1] = __builtin_amdgcn_s_memrealtime();
#endif
    }
    for (int ph = 1; ph < ph_hi; ++ph) {
        int zlane = 0; asm volatile("" : "+v"(zlane));
        const int tid = wave0 * 64 + (int)__builtin_amdgcn_mbcnt_hi(~0u, __builtin_amdgcn_mbcnt_lo(~0u, (unsigned)zlane));
        { size_t zoff = 0; asm volatile("" : "+s"(zoff)); p.ws = ws0 + zoff; }
        const int lane = tid & 63, wave = wave0;
        if (ph == PH_H1) ph_h1_first(p, lds, tid, lane, wave, G);
        else {
            const int l = (ph - PH_L0) / PH_PER_LAYER, s = (ph - PH_L0) % PH_PER_LAYER, last = l == 1;
            const float* modl = (const float*)(p.ws + WS_MOD) + (size_t)l * 9 * 6144;
            if (s == 0) {
                pg8::Gemm g{(const bf16*)(p.ws + WS_HB), (const bf16*)(p.ws + WS_WIN) + (size_t)l * INW * D, M, INW, D};
                pg8::DenseOrder S; S.init(M / 256, INW / 256, G, vblk(), 0);
                unsigned char* R = p.ws + WS_R;
                pg8::EpiInProj E{(bf16*)(R + R_QA), (bf16*)(R + R_KB), (bf16*)(R + R_KDT), (bf16*)(R + R_VT), (bf16*)(R + R_SG), (bf16*)(R + R_GU), (bf16*)(R + R_GVT), (float*)(R + R_EREF), (float*)(R + R_DEC),
                                 (float*)(p.ws + WS_ZERO + Z_SSV) + (size_t)l * M, (const float*)(p.ws + WS_LBV) + l * 1024, p.in[I_SGN] + l * 512, (size_t)M * 512, NCH};
                pg8::gemm_phase<pg8::EpiInProj, pg8::DenseOrder, true, true>(lds, g, S, E, tid);
            } else if (s == 1) { if (vblk() < 128) { scan_preload(p, lds, tid, vblk()); __syncthreads(); ph_scan(p, lds, lane, wave, vblk()); }
                else ph_sgu(p, l, lane, (vblk() - 128) * 8 + wave, 128 * 8); }
            else if (s == 2) ph_out(p, l, last, lds, lane, wave, G);
            else if (s == 3) {
                pg8::Gemm g{(const bf16*)(p.ws + WS_HB), (const bf16*)(p.ws + WS_WOUT) + (size_t)l * D * D, M, D, D};
                pg8::DenseOrder S; S.init(last ? NB * 16 : M / 256, D / 256, G, vblk(), last);
                pg8::EpiResid E{l == 0 ? p.in[I_X] : p.out, l == 0 ? p.in[I_CTX] : (const float*)(p.ws + WS_XC), p.out, (float*)(p.ws + WS_XC), modl, (float*)(p.ws + WS_ZERO + Z_SS2) + (size_t)l * M};
                pg8::gemm_phase<pg8::EpiResid, pg8::DenseOrder, true, true>(lds, g, S, E, tid);
                if (last) ph_moe_wconv(p, l, lds, lane, wave, vblk(), G); else if (vblk() >= 32) ph_moe_wconv(p, l, lds, lane, wave, vblk() - 32, G - 32);
            } else if (s == 4) ph_router(p, l, last, lds, tid, lane, wave, G);
            else if (s == 5) ph_place(p, l, last, lds, tid, lane, wave, G);
            else if (s == 6) {
                const int* TILE = (const int*)(p.ws + WS_TILE); const int nt = __builtin_amdgcn_readfirstlane(TILE[MT_MAX]);
                pg8::Gemm g{(const bf16*)(p.ws + WS_R + R_BUF), (const bf16*)(p.ws + WS_R + R_WGU), NSLOT_PAD, 1024, D};
                pg8::MoeOrder S; S.init(TILE, nt, 4, G, vblk(), 4);
                pg8::EpiSwiglu E{(bf16*)(p.ws + WS_R + R_ACT)};
                pg8::gemm_phase<pg8::EpiSwiglu, pg8::MoeOrder, true, true>(lds, g, S, E, tid);
            } else if (s == 7) {
                const int* TILE = (const int*)(p.ws + WS_TILE); const int nt = __builtin_amdgcn_readfirstlane(TILE[MT_MAX]);
                pg8::Gemm g{(const bf16*)(p.ws + WS_R + R_ACT), (const bf16*)(p.ws + WS_R + R_WD), NSLOT_PAD, D, DE};
                pg8::MoeOrder S; S.init(TILE, nt, 4, G, vblk(), 4);
                pg8::EpiStoreBf16 E{(bf16*)(p.ws + WS_R + R_Y), D};
                pg8::gemm_phase<pg8::EpiStoreBf16, pg8::MoeOrder, true, true>(lds, g, S, E, tid);
            } else ph_combine(p, l, last, lds, tid, lane, wave, G);
        }
#if TIMING
        if (blockIdx.x == 0 && tid == 0) ((LAS unsigned long long*)(lds + LDS_STAMP))[32 + ph] = __builtin_amdgcn_s_memrealtime();
#endif
        if (ph + 1 < ph_hi) { { XcdBarrier bar; bar.bar = (unsigned*)(p.ws + WS_ZERO + Z_BAR); bar.x = xb_xcc_id(); bar.st = (volatile LAS unsigned*)(lds + LDS_BARST); xcd_barrier(bar, tid); } }
#if TIMING
        if (blockIdx.x == 0 && tid == 0) ((LAS unsigned long long*)(lds + LDS_STAMP))[ph + 1] = __builtin_amdgcn_s_memrealtime();
#endif
    }
#if TIMING
    if (blockIdx.x == 0 && threadIdx.x == 0) {
        LAS unsigned long long* st = (LAS unsigned long long*)(lds + LDS_STAMP); unsigned long long tot = 0;
        for (int k = 0; k < PH_END; ++k) if ((TIMING_MASK >> k) & 1ull) tot += (TIMING_MODE ? st[32 + k] : st[k + 1]) - st[k];
        const unsigned long long t0 = __builtin_amdgcn_s_memrealtime();
        while (__builtin_amdgcn_s_memrealtime() - t0 < tot * TIMING_MUL) __builtin_amdgcn_s_sleep(8);
    }
#endif
}

extern "C" void kernel_launch(void* const* d_in, const int* in_sizes, int n_in, void* d_out, int out_size, void* d_ws, size_t ws_size, hipStream_t stream) {
    static int grid = 0;
    if (grid == 0) {
        if (n_in != 23 || ws_size < WS_END) { fprintf(stderr, "kernel_launch: n_in %d ws %zu need %zu\n", n_in, ws_size, (size_t)WS_END); grid = -1; return; }
        int dev = 0, cus = 0, per_cu = 0;
        hipGetDevice(&dev); hipDeviceGetAttribute(&cus, hipDeviceAttributeMultiprocessorCount, dev);
        hipFuncSetAttribute((const void*)mk, hipFuncAttributeMaxDynamicSharedMemorySize, LDS_BYTES);
        hipOccupancyMaxActiveBlocksPerMultiprocessor(&per_cu, (const void*)mk, NTHREADS, LDS_BYTES);
        (void)hipGetLastError();
        grid = cus * (per_cu >= 1 ? 1 : 0);
        if (grid != 256) { fprintf(stderr, "kernel_launch: occupancy %d cus %d\n", per_cu, cus); grid = -1; return; }
    }
    if (grid < 0) return;
    hipMemsetAsync((char*)d_ws + WS_ZERO, 0, ZERO_BYTES, stream);
    Params p{};
    for (int i = 0; i < 23; ++i) p.in[i] = (const float*)d_in[i];
    p.out = (float*)d_out; p.ws = (unsigned char*)d_ws;
    int lo = 0, hi = PH_END;
    void* args[] = {&p, &lo, &hi};
    hipError_t e = hipLaunchCooperativeKernel((const void*)mk, dim3(grid), dim3(NTHREADS), args, LDS_BYTES, stream);
    if (e != hipSuccess) fprintf(stderr, "cooperative launch failed: %s (grid %d)\n", hipGetErrorString(e), grid);
}
```

```cpp
#include <hip/hip_runtime.h>
#include <hip/hip_cooperative_groups.h>
#include <cstdio>
#include <cstdint>
namespace cg = cooperative_groups;

constexpr int D = 1024, NB = 8, SEQ = 4096, CL = 256, RB = SEQ + CL  , M = NB * RB  ;
constexpr int INW = 3584, NEXP = 32, DE = 512, NSLOT = M * 2, NSLOT_PAD = NSLOT + NEXP * 256, MT_MAX = NSLOT_PAD / 256;
constexpr float EPS = 1e-6f;

namespace pg8 {
#define PG8_LAS __attribute__((address_space(3)))
typedef unsigned short bf16_t;
typedef short bf16x8 __attribute__((ext_vector_type(8)));
typedef float f32x4 __attribute__((ext_vector_type(4)));
typedef unsigned u32x4 __attribute__((ext_vector_type(4)));
constexpr int BM = 256, BK = 64, HALF = 128, HTB = HALF * BK * 2  , STAGE_BYTES = 8 * HTB, NXCD = 8, WGM = 8;

__host__ __device__ __forceinline__ int lds_byte(int r, int c) { const int st = (r >> 4) * 2 + (c >> 5), rr = r & 15, cc = c & 31, ob = rr * 64 + cc * 2; return st * 1024 + (ob ^ (((ob >> 9) & 1) << 5)); }
__host__ __device__ __forceinline__ void stage_rc(int b, int& R, int& C) { const int st = b / 1024, sb = b % 1024, swz = sb ^ (((sb >> 9) & 1) << 5); R = (st >> 1) * 16 + swz / 64; C = (st & 1) * 32 + (swz % 64) / 2; }
__host__ __device__ __forceinline__ int perm32(int rho) { const int n = rho >> 4, i = rho & 15; return 8 * (i >> 2) + 4 * n + (i & 3); }

struct Unit { int pm, pn, pb; };
struct Gemm { const bf16_t* A; const bf16_t* Bt; int M, N, K; };

struct StaticOrder {
    int nM, nN, nwg, G, c;
    __host__ __device__ void init(int M, int N, int G_, int c_) { nM = M / BM; nN = N / BM; nwg = nM * nN; G = G_; c = c_; }
    __host__ __device__ bool next(int i, Unit& u) const {
        const long L = (long)i * G + c; if (L >= nwg) return false;
        int wgid = (int)L; { const int q = nwg / NXCD, r = nwg % NXCD, xcd = wgid % NXCD, off = wgid / NXCD; wgid = (xcd < r ? xcd * (q + 1) : r * (q + 1) + (xcd - r) * q) + off; }
        const int nig = WGM * nN, gid = wgid / nig, fm = gid * WGM, gsz = (nM - fm) < WGM ? (nM - fm) : WGM;
        u.pm = fm + ((wgid % nig) % gsz); u.pn = (wgid % nig) / gsz; u.pb = u.pn; return true;
    }
    __device__ __forceinline__ void a_ready(const Unit&) const {}
    __device__ __forceinline__ void done(const Unit&) const {}
};

__device__ __forceinline__ unsigned cvt_pk_bf16(float lo, float hi) { unsigned r; asm volatile("v_cvt_pk_bf16_f32 %0, %1, %2" : "=v"(r) : "v"(lo), "v"(hi)); return r; }
typedef float f32x2 __attribute__((ext_vector_type(2)));
struct DenseOrder {
    int nM, nN, nwg, G, c, lat_only;
    __device__ void init(int nM_, int nN_, int G_, int c_, int lat_only_) { nM = nM_; nN = nN_; nwg = nM * nN; G = G_; c = c_; lat_only = lat_only_; }
    __device__ bool next(int i, Unit& u) const {
        const long L = (long)i * G + c; if (L >= nwg) return false;
        int wgid = (int)L; { const int q = nwg / NXCD, r = nwg % NXCD, xcd = wgid % NXCD, off = wgid / NXCD; wgid = (xcd < r ? xcd * (q + 1) : r * (q + 1) + (xcd - r) * q) + off; }
        const int nig = WGM * nN, gid = wgid / nig, fm = gid * WGM, gsz = (nM - fm) < WGM ? (nM - fm) : WGM;
        int pm = fm + ((wgid % nig) % gsz); u.pn = (wgid % nig) / gsz; u.pb = u.pn;
        if (lat_only) pm = (pm >> 4) * 17 + (pm & 15);
        u.pm = pm; return true;
    }
    __device__ __forceinline__ void a_ready(const Unit&) const {}
    __device__ __forceinline__ void done(const Unit&) const {}
};
struct MoeOrder {
    const int* tile_e; int nM, nN, nwg, G, c, nbt;
    __device__ void init(const int* te, int nM_, int nN_, int G_, int c_, int nbt_) { tile_e = te; nM = nM_; nN = nN_; nwg = nM * nN; G = G_; c = c_; nbt = nbt_; }
    __device__ bool next(int i, Unit& u) const {
        const long L = (long)i * G + c; if (L >= nwg) return false;
        int wgid = (int)L; { const int q = nwg / NXCD, r = nwg % NXCD, xcd = wgid % NXCD, off = wgid / NXCD; wgid = (xcd < r ? xcd * (q + 1) : r * (q + 1) + (xcd - r) * q) + off; }
        const int nig = WGM * nN, gid = wgid / nig, fm = gid * WGM, gsz = (nM - fm) < WGM ? (nM - fm) : WGM;
        u.pm = fm + ((wgid % nig) % gsz); u.pn = (wgid % nig) / gsz;
        u.pb = __builtin_amdgcn_readfirstlane(tile_e[u.pm]) * nbt + u.pn; return true;
    }
    __device__ __forceinline__ void a_ready(const Unit&) const {}
    __device__ __forceinline__ void done(const Unit&) const {}
};

__device__ __forceinline__ float fast_silu(float x) { return x * __builtin_amdgcn_rcpf(1.f + __expf(-x)); }
struct EpiStoreBf16 {
    static constexpr bool PERM = true, AFTER_DRAIN = false;
    bf16_t* O; int ldc;
    __device__ __forceinline__ void operator()(const f32x4 (&acc)[2][2][4][2], const Unit& u, int wr, int wc, int fr, int fq) const {
        const int row0 = u.pm * BM + wr * 64 + fr, col0 = u.pn * BM + wc * 32 + 8 * fq;
#pragma unroll
        for (int ai = 0; ai < 2; ++ai)
#pragma unroll
            for (int m = 0; m < 4; ++m) { bf16_t* rowp = O + (size_t)(row0 + ai * HALF + m * 16) * ldc + col0;
#pragma unroll
                for (int bj = 0; bj < 2; ++bj) { const f32x4 v0 = acc[ai][bj][m][0], v1 = acc[ai][bj][m][1];
                    u32x4 w; w.x = cvt_pk_bf16(v0[0], v0[1]); w.y = cvt_pk_bf16(v0[2], v0[3]); w.z = cvt_pk_bf16(v1[0], v1[1]); w.w = cvt_pk_bf16(v1[2], v1[3]);
                    *(u32x4*)(rowp + bj * HALF) = w; } }
    }
};
struct EpiSwiglu {
    static constexpr bool PERM = true, AFTER_DRAIN = false;
    bf16_t* ACT;
    __device__ __forceinline__ void operator()(const f32x4 (&acc)[2][2][4][2], const Unit& u, int wr, int wc, int fr, int fq) const {
        const int row0 = u.pm * BM + wr * 64 + fr, col0 = u.pn * HALF + wc * 32 + 8 * fq;
#pragma unroll
        for (int ai = 0; ai < 2; ++ai)
#pragma unroll
            for (int m = 0; m < 4; ++m) { bf16_t* rowp = ACT + (size_t)(row0 + ai * HALF + m * 16) * DE + col0;
                const f32x4 g0 = acc[ai][0][m][0], g1 = acc[ai][0][m][1], u0 = acc[ai][1][m][0], u1 = acc[ai][1][m][1];
                u32x4 w; w.x = cvt_pk_bf16(fast_silu(g0[0]) * u0[0], fast_silu(g0[1]) * u0[1]); w.y = cvt_pk_bf16(fast_silu(g0[2]) * u0[2], fast_silu(g0[3]) * u0[3]);
                w.z = cvt_pk_bf16(fast_silu(g1[0]) * u1[0], fast_silu(g1[1]) * u1[1]); w.w = cvt_pk_bf16(fast_silu(g1[2]) * u1[2], fast_silu(g1[3]) * u1[3]);
                *(u32x4*)rowp = w; }
    }
};
#define DPP_F(x, ctrl) __uint_as_float((unsigned)__builtin_amdgcn_update_dpp(0, (int)__float_as_uint(x), (ctrl), 0xf, 0xf, false))
__device__ __forceinline__ float row_allsum16(float x) { x += DPP_F(x, 0xB1); x += DPP_F(x, 0x4E); x += DPP_F(x, 0x141); x += DPP_F(x, 0x140); return x; }
__device__ __forceinline__ float row_incl_scan16(float x) { x += DPP_F(x, 0x111); x += DPP_F(x, 0x112); x += DPP_F(x, 0x114); x += DPP_F(x, 0x118); return x; }
__device__ __forceinline__ float fast_sigmoid(float x) { return __builtin_amdgcn_rcpf(1.f + __expf(-x)); }
__device__ __forceinline__ float fast_gelu(float x) { return x * fast_sigmoid(1.5957691216057308f * (x + 0.044715f * x * x * x)); }
__device__ __forceinline__ bf16_t bf16_1(float x) { return (bf16_t)(cvt_pk_bf16(x, 0.f) & 0xffffu); }
struct EpiInProj {
    static constexpr bool PERM = true, AFTER_DRAIN = false;
    bf16_t *QA, *KB, *KDT, *VT, *SG, *GU, *GVT; float *EREF, *DEC, *SSV; const float* LBV; const float* vgain; size_t dstride; int nch;
    __device__ __forceinline__ void operator()(const f32x4 (&acc)[2][2][4][2], const Unit& u, int wr, int wc, int fr, int fq) const {
        if (u.pn < 8) hgrn(acc, u, wr, wc, fr, fq); else if (u.pn < 12) actv(acc, u, wr, wc, fr, fq); else vtile(acc, u, wr, wc, fr, fq);
    }
    __device__ __forceinline__ void hgrn(const f32x4 (&acc)[2][2][4][2], const Unit& u, int wr, int wc, int fr, int fq) const {
        const int h = u.pn >> 1, dloc = (u.pn & 1) * 64 + 16 * wc + 4 * fq, dcol = h * 128 + dloc;
        const f32x4 lbf = *(const f32x4*)(LBV + dcol), lbb = *(const f32x4*)(LBV + 512 + dcol);
#pragma unroll
        for (int ai = 0; ai < 2; ++ai) {
            const int rowc = u.pm * BM + ai * HALF + wr * 64, gc = rowc >> 6;
            const size_t cb = ((size_t)(gc * 4 + h) * 4 + (dloc >> 5)) * 4;
            const int cl = ((dloc & 31) + 32 * (fr >> 3)) * 8 + (fr & 7);
            unsigned pqa[2][4][2], pkb[2][4][2]; float hqa[2][4], hkb[2][4];
#pragma unroll
            for (int e = 0; e < 4; ++e) {
#pragma unroll
                for (int dir = 0; dir < 2; ++dir) {
                    const float lb = dir ? lbb[e] : lbf[e];
                    float lf[4], kk[4], x[4], T[4];
#pragma unroll
                    for (int m = 0; m < 4; ++m) { const float z = dir ? acc[ai][1][m][0][e] : acc[ai][0][m][1][e]; const float sig = fast_sigmoid(z);
                        lf[m] = __logf(lb + (1.f - lb) * sig); kk[m] = (1.f - lb) * (1.f - sig); x[m] = lf[m]; }
#pragma unroll
                    for (int m = 0; m < 4; ++m) { T[m] = row_allsum16(x[m]); x[m] = row_incl_scan16(x[m]); }
                    const float t01 = T[0] + T[1], tot = t01 + T[2] + T[3];
                    float cum[4] = {x[0], x[1] + T[0], x[2] + t01, x[3] + t01 + T[2]}; float ref = t01;
                    if (dir) {
#pragma unroll
                        for (int m = 0; m < 4; ++m) cum[m] = tot - cum[m] + lf[m];
                        ref = tot - t01; }
                    const float etr = __expf(tot - ref);
#pragma unroll
                    for (int m = 0; m < 4; ++m) { const float q = acc[ai][0][m][0][e];
                        const float qa = q * __expf(cum[m] - ref), kb = kk[m] * __expf(ref - cum[m]), kd = kb * etr;
                        KDT[dir * dstride + ((cb + m) * 64) * 8 + cl + 8 * e] = bf16_1(kd);
                        if (e & 1) { pqa[dir][m][e >> 1] = cvt_pk_bf16(hqa[dir][m], qa); pkb[dir][m][e >> 1] = cvt_pk_bf16(hkb[dir][m], kb); } else { hqa[dir][m] = qa; hkb[dir][m] = kb; } }
                    if (fr == 0) { EREF[((size_t)dir * nch + gc) * 512 + dcol + e] = __expf(ref); DEC[((size_t)dir * nch + gc) * 512 + dcol + e] = __expf(tot); }
                }
#pragma unroll
                for (int m = 0; m < 4; ++m) VT[((cb + m) * 64) * 8 + cl + 8 * e] = bf16_1(acc[ai][1][m][1][e]);
            }
#pragma unroll
            for (int dir = 0; dir < 2; ++dir)
#pragma unroll
                for (int m = 0; m < 4; ++m) {
                    const size_t o = dir * dstride + (((((size_t)(gc * 4 + h) * 2 + (m >> 1)) * 8 + (dloc >> 4)) * 64) + 16 * (m & 1) + fr + 32 * (fq & 1)) * 8 + 4 * (fq >> 1);
                    typedef unsigned u32x2v __attribute__((ext_vector_type(2)));
                    *(u32x2v*)(QA + o) = (u32x2v){pqa[dir][m][0], pqa[dir][m][1]}; *(u32x2v*)(KB + o) = (u32x2v){pkb[dir][m][0], pkb[dir][m][1]}; }
        }
    }
    __device__ __forceinline__ void actv(const f32x4 (&acc)[2][2][4][2], const Unit& u, int wr, int wc, int fr, int fq) const {
        const bool isu = u.pn >= 10; bf16_t* O = isu ? GU : SG;
        const int row0 = u.pm * BM + wr * 64 + fr, col0 = (u.pn & 1) * 256 + wc * 32 + 8 * fq;
#pragma unroll
        for (int ai = 0; ai < 2; ++ai)
#pragma unroll
            for (int m = 0; m < 4; ++m) { bf16_t* rowp = O + (size_t)(row0 + ai * HALF + m * 16) * 512 + col0;
#pragma unroll
                for (int bj = 0; bj < 2; ++bj) { float v[8];
#pragma unroll
                    for (int i = 0; i < 8; ++i) { const float x = acc[ai][bj][m][i >> 2][i & 3]; v[i] = isu ? fast_gelu(x) : x * fast_sigmoid(x); }
                    u32x4 w; w.x = cvt_pk_bf16(v[0], v[1]); w.y = cvt_pk_bf16(v[2], v[3]); w.z = cvt_pk_bf16(v[4], v[5]); w.w = cvt_pk_bf16(v[6], v[7]);
                    *(u32x4*)(rowp + bj * HALF) = w; } }
    }
    __device__ __forceinline__ void vtile(const f32x4 (&acc)[2][2][4][2], const Unit& u, int wr, int wc, int fr, int fq) const {
        const int ch0 = (u.pn & 1) * 256 + wc * 32 + 8 * fq;
        f32x4 gn[2][2];
#pragma unroll
        for (int bj = 0; bj < 2; ++bj)
#pragma unroll
            for (int n = 0; n < 2; ++n) gn[bj][n] = *(const f32x4*)(vgain + ch0 + bj * HALF + 4 * n);
#pragma unroll
        for (int ai = 0; ai < 2; ++ai) { const int gc2 = u.pm * 2 + ai;
#pragma unroll
            for (int m = 0; m < 4; ++m) { const int tok = wr * 64 + 16 * m + fr; float s = 0.f;
#pragma unroll
                for (int bj = 0; bj < 2; ++bj)
#pragma unroll
                    for (int n = 0; n < 2; ++n)
#pragma unroll
                        for (int e = 0; e < 4; ++e) { const float g = fast_gelu(acc[ai][bj][m][n][e]); s += g * g;
                            GVT[(((((size_t)(gc2 * 4 + 2 * (u.pn & 1) + bj) * 4 + wc) * 8 + (tok >> 4)) * 64) + 8 * fq + 4 * n + e + 32 * (fr >> 3)) * 8 + (fr & 7)] = bf16_1(g * gn[bj][n][e]); }
                s += __shfl_xor(s, 16); s += __shfl_xor(s, 32);
                if (fq == 0) atomicAdd(SSV + gc2 * 128 + tok, s); } }
    }
};
struct EpiResid {
    static constexpr bool PERM = false, AFTER_DRAIN = false;
    const float* src_lat; const float* src_ctx; float* dst_lat; float* dst_ctx; const float* modl; float* ss;
    __device__ __forceinline__ void operator()(const f32x4 (&acc)[2][2][4][2], const Unit& u, int wr, int wc, int fr, int fq) const {
        const int b = u.pm / 17, j = u.pm % 17; const bool isctx = j == 16;
        const size_t trow = isctx ? (size_t)b * CL : (size_t)b * SEQ + (size_t)j * 256;
        const float* sb = (isctx ? src_ctx : src_lat) + trow * D; float* db = (isctx ? dst_ctx : dst_lat) + trow * D;
        const float* g1 = modl + (size_t)(isctx ? 8 : b) * 6144 + 2 * 1024;
        const int col0 = u.pn * BM + wc * 32 + 4 * fq;
        f32x4 gv[2][2];
#pragma unroll
        for (int bj = 0; bj < 2; ++bj)
#pragma unroll
            for (int n = 0; n < 2; ++n) gv[bj][n] = *(const f32x4*)(g1 + col0 + bj * HALF + n * 16);
#pragma unroll
        for (int ai = 0; ai < 2; ++ai) {
            f32x4 xs[4][2][2];
#pragma unroll
            for (int m = 0; m < 4; ++m) { const size_t off = (size_t)(ai * HALF + wr * 64 + m * 16 + fr) * D + col0;
#pragma unroll
                for (int bj = 0; bj < 2; ++bj)
#pragma unroll
                    for (int n = 0; n < 2; ++n) xs[m][bj][n] = *(const f32x4*)(sb + off + bj * HALF + n * 16); }
            __builtin_amdgcn_sched_barrier(0);
#pragma unroll
            for (int m = 0; m < 4; ++m) { const int rt = ai * HALF + wr * 64 + m * 16 + fr; const size_t off = (size_t)rt * D + col0; float s = 0.f;
#pragma unroll
                for (int bj = 0; bj < 2; ++bj)
#pragma unroll
                    for (int n = 0; n < 2; ++n) { const f32x4 o = xs[m][bj][n] + gv[bj][n] * acc[ai][bj][m][n];
                        *(f32x4*)(db + off + bj * HALF + n * 16) = o; s += (o[0] * o[0] + o[1] * o[1]) + (o[2] * o[2] + o[3] * o[3]); }
                s += __shfl_xor(s, 16); s += __shfl_xor(s, 32);
                if (fq == 0) atomicAdd(ss + u.pm * BM + rt, s); } }
    }
};
template <class Epi, class Sched, bool ALIGN_EPI = false, bool SP2 = false, bool GATHER = false>
__device__ __forceinline__ void gemm_phase(PG8_LAS unsigned char* lds, const Gemm g, const Sched& S, const Epi& E, const int tid_in, const PG8_LAS int* rmap = nullptr) {
    const int tid = tid_in, wid = __builtin_amdgcn_readfirstlane(tid >> 6), lane = tid & 63, wr = wid >> 2, wc = wid & 3, fr = lane & 15, fq = lane >> 4;
    const int K = g.K, nt = K / BK;
    unsigned voffA[2], voffB[2]; int gR[2], gC[2];
#pragma unroll
    for (int i = 0; i < 2; ++i) { int R, C; stage_rc(tid * 16 + i * 8192, R, C); const int Rb = Epi::PERM ? ((R & ~31) + perm32(R & 31)) : R;
        voffA[i] = (unsigned)(R * K + C) * 2u; voffB[i] = (unsigned)(Rb * K + C) * 2u; gR[i] = R; gC[i] = C; }
    unsigned vA0[2] = {voffA[0], voffA[1]}, vA1[2] = {voffA[0], voffA[1]}, nV0[2] = {voffA[0], voffA[1]}, nV1[2] = {voffA[0], voffA[1]};
#define PG8_GOFF(slot, o0, o1) do { const PG8_LAS int* _rm = rmap + (slot) * 256; _Pragma("unroll") for (int _i = 0; _i < 2; ++_i) { \
        o0[_i] = ((unsigned)_rm[gR[_i]] * (unsigned)K + (unsigned)gC[_i]) * 2u; o1[_i] = ((unsigned)_rm[128 + gR[_i]] * (unsigned)K + (unsigned)gC[_i]) * 2u; } } while (0)
    const size_t kstep = (size_t)(BK * 2);
    const size_t hstep = (size_t)HALF * K * 2;
    const size_t tstep = 2 * hstep;
    const size_t hstepA = GATHER ? 0 : hstep, tstepA = GATHER ? 0 : tstep;
    const unsigned ldsw = (unsigned)wid * 1024u;
    const int aoff = lds_byte(wr * 64 + fr, fq * 8), boff = lds_byte(wc * 32 + fr, fq * 8);
#define PG8_SA(b, h) (((b) * 2 + (h)) * HTB)
#define PG8_SB(b, h) ((4 + (b) * 2 + (h)) * HTB)
#define PG8_STAGE(bufoff, gbase, voff) do { _Pragma("unroll") for (int _i = 0; _i < 2; ++_i) \
        __builtin_amdgcn_global_load_lds((const unsigned*)((const char*)(gbase) + (voff)[_i]), (PG8_LAS unsigned*)(lds + (bufoff) + ldsw + _i * 8192), 16, 0, 0); } while (0)
#define PG8_LDA(dst, b, h) do { _Pragma("unroll") for (int m = 0; m < 4; ++m) _Pragma("unroll") for (int k = 0; k < 2; ++k) dst[m][k] = *(const PG8_LAS bf16x8*)(lds + PG8_SA(b, h) + aoff + m * 2048 + k * 1024); } while (0)
#define PG8_LDB(dst, b, h) do { _Pragma("unroll") for (int n = 0; n < 2; ++n) _Pragma("unroll") for (int k = 0; k < 2; ++k) dst[n][k] = *(const PG8_LAS bf16x8*)(lds + PG8_SB(b, h) + boff + n * 2048 + k * 1024); } while (0)
#define PG8_MMA(ai, bj, At, Bt) do { __builtin_amdgcn_s_setprio(1); _Pragma("unroll") for (int m = 0; m < 4; ++m) _Pragma("unroll") for (int n = 0; n < 2; ++n) _Pragma("unroll") for (int k = 0; k < 2; ++k) \
        acc[ai][bj][m][n] = __builtin_amdgcn_mfma_f32_16x16x32_bf16(Bt[n][k], At[m][k], acc[ai][bj][m][n], 0, 0, 0); __builtin_amdgcn_s_setprio(0); } while (0)
#define PG8_WAIT_V(n) asm volatile("s_waitcnt vmcnt(" #n ")" ::: "memory")
#define PG8_WAIT_L(n) asm volatile("s_waitcnt lgkmcnt(" #n ")" ::: "memory")
#define PG8_BAR __builtin_amdgcn_s_barrier()
#define PG8_SCHED __builtin_amdgcn_sched_barrier(0)
    Unit cur, nxt; int ui = 0;
    if (!S.next(0, cur)) return;
    f32x4 acc[2][2][4][2];
#pragma unroll
    for (int a = 0; a < 2; ++a)
#pragma unroll
        for (int b = 0; b < 2; ++b)
#pragma unroll
            for (int m = 0; m < 4; ++m)
#pragma unroll
                for (int n = 0; n < 2; ++n) acc[a][b][m][n] = (f32x4){0.f, 0.f, 0.f, 0.f};
    bf16x8 At[4][2], B0[2][2], B1[2][2];
    const char* cA = (const char*)g.A + (size_t)cur.pm * tstepA; const char* cB = (const char*)g.Bt + (size_t)cur.pb * tstep;
    if constexpr (GATHER) PG8_GOFF(0, vA0, vA1);
    S.a_ready(cur);
    if constexpr (SP2) {
        PG8_STAGE(PG8_SB(0, 0), cB, voffB); PG8_STAGE(PG8_SB(0, 1), cB + hstep, voffB); PG8_STAGE(PG8_SA(0, 0), cA, vA0); PG8_STAGE(PG8_SA(0, 1), cA + hstepA, vA1);
        if (wr == 1) PG8_BAR;
        PG8_WAIT_V(2); PG8_BAR;
        PG8_STAGE(PG8_SB(1, 0), cB + kstep, voffB); PG8_STAGE(PG8_SA(1, 0), cA + kstep, vA0); PG8_STAGE(PG8_SB(1, 1), cB + hstep + kstep, voffB);
        PG8_WAIT_V(6); PG8_BAR;
    } else {
        PG8_STAGE(PG8_SB(0, 0), cB, voffB); PG8_STAGE(PG8_SA(0, 0), cA, voffA); PG8_STAGE(PG8_SB(0, 1), cB + hstep, voffB); PG8_STAGE(PG8_SA(0, 1), cA + hstep, voffA);
        if (wr == 1) PG8_BAR;
        PG8_WAIT_V(4); PG8_BAR;
        PG8_STAGE(PG8_SB(1, 0), cB + kstep, voffB); PG8_STAGE(PG8_SA(1, 0), cA + kstep, voffA); PG8_STAGE(PG8_SB(1, 1), cB + hstep + kstep, voffB);
        PG8_WAIT_V(6); PG8_BAR;
    }
    for (;;) {
        const bool has_next = S.next(ui + 1, nxt);
        const char* nA = has_next ? (const char*)g.A + (size_t)nxt.pm * tstepA : cA; const char* nB = has_next ? (const char*)g.Bt + (size_t)nxt.pb * tstep : cB;
        if constexpr (GATHER) { if (has_next) PG8_GOFF(ui + 1, nV0, nV1); else { nV0[0] = vA0[0]; nV0[1] = vA0[1]; nV1[0] = vA1[0]; nV1[1] = vA1[1]; } }
        for (int t = 0; t < nt; t += 2) {
            const bool last = (t == nt - 2);
            const char* a1 = cA + (size_t)(t + 1) * kstep;
            const char* a2 = last ? nA : cA + (size_t)(t + 2) * kstep; const char* b2 = last ? nB : cB + (size_t)(t + 2) * kstep;
            const char* a3 = a2 + kstep; const char* b3 = b2 + kstep;
            const unsigned sA0[2] = {last ? nV0[0] : vA0[0], last ? nV0[1] : vA0[1]}, sA1[2] = {last ? nV1[0] : vA1[0], last ? nV1[1] : vA1[1]};
            if (last && has_next) S.a_ready(nxt);
            if constexpr (SP2) {
            PG8_LDB(B0, 0, 0); PG8_LDB(B1, 0, 1); PG8_SCHED; PG8_LDA(At, 0, 0); PG8_STAGE(PG8_SA(1, 1), a1 + hstepA, vA1);
            PG8_WAIT_V(8); PG8_WAIT_L(0); PG8_BAR; PG8_MMA(0, 0, At, B0); PG8_MMA(0, 1, At, B1); PG8_BAR; PG8_SCHED;
            PG8_LDA(At, 0, 1); PG8_STAGE(PG8_SB(0, 0), b2, voffB); PG8_STAGE(PG8_SB(0, 1), b2 + hstep, voffB); PG8_STAGE(PG8_SA(0, 0), a2, sA0);
            PG8_WAIT_V(8); PG8_WAIT_L(0); PG8_BAR; PG8_MMA(1, 0, At, B0); PG8_MMA(1, 1, At, B1); PG8_BAR; PG8_SCHED;
            PG8_LDB(B0, 1, 0); PG8_LDB(B1, 1, 1); PG8_SCHED; PG8_LDA(At, 1, 0); PG8_STAGE(PG8_SA(0, 1), a2 + hstepA, sA1);
            PG8_WAIT_V(8); PG8_WAIT_L(0); PG8_BAR; PG8_MMA(0, 0, At, B0); PG8_MMA(0, 1, At, B1); PG8_BAR; PG8_SCHED;
            PG8_LDA(At, 1, 1); PG8_STAGE(PG8_SB(1, 0), b3, voffB); PG8_STAGE(PG8_SB(1, 1), b3 + hstep, voffB); PG8_STAGE(PG8_SA(1, 0), a3, sA0);
            PG8_WAIT_V(8); PG8_WAIT_L(0); PG8_BAR; PG8_MMA(1, 0, At, B0); PG8_MMA(1, 1, At, B1); PG8_BAR; PG8_SCHED;
            } else {
            PG8_LDB(B0, 0, 0); PG8_SCHED; PG8_LDA(At, 0, 0); PG8_STAGE(PG8_SA(1, 1), a1 + hstep, voffA);
            PG8_WAIT_L(8); PG8_BAR; PG8_WAIT_L(0); PG8_MMA(0, 0, At, B0); PG8_BAR; PG8_SCHED;
            PG8_LDB(B1, 0, 1); PG8_STAGE(PG8_SB(0, 0), b2, voffB);
            PG8_BAR; PG8_WAIT_L(0); PG8_MMA(0, 1, At, B1); PG8_BAR;
            PG8_LDA(At, 0, 1); PG8_STAGE(PG8_SA(0, 0), a2, voffA);
            PG8_BAR; PG8_WAIT_L(0); PG8_MMA(1, 0, At, B0); PG8_BAR; PG8_SCHED;
            PG8_STAGE(PG8_SB(0, 1), b2 + hstep, voffB);
            PG8_WAIT_V(6); PG8_BAR; PG8_MMA(1, 1, At, B1); PG8_BAR;
            PG8_LDB(B0, 1, 0); PG8_SCHED; PG8_LDA(At, 1, 0); PG8_STAGE(PG8_SA(0, 1), a2 + hstep, voffA);
            PG8_WAIT_L(8); PG8_BAR; PG8_WAIT_L(0); PG8_MMA(0, 0, At, B0); PG8_BAR; PG8_SCHED;
            PG8_LDB(B1, 1, 1); PG8_STAGE(PG8_SB(1, 0), b3, voffB);
            PG8_BAR; PG8_WAIT_L(0); PG8_MMA(0, 1, At, B1); PG8_BAR;
            PG8_LDA(At, 1, 1); PG8_STAGE(PG8_SA(1, 0), a3, voffA);
            PG8_BAR; PG8_WAIT_L(0); PG8_MMA(1, 0, At, B0); PG8_BAR; PG8_SCHED;
            PG8_STAGE(PG8_SB(1, 1), b3 + hstep, voffB);
            PG8_WAIT_V(6); PG8_BAR; PG8_MMA(1, 1, At, B1); PG8_BAR;
            }
        }
        if constexpr (ALIGN_EPI) { if (wr == 0) PG8_BAR; }
        if constexpr (!Epi::AFTER_DRAIN) { E(acc, cur, wr, wc, fr, fq); S.done(cur); }
        if (!has_next) break;
#pragma unroll
        for (int a = 0; a < 2; ++a)
#pragma unroll
            for (int b = 0; b < 2; ++b)
#pragma unroll
                for (int m = 0; m < 4; ++m)
#pragma unroll
                    for (int n = 0; n < 2; ++n) acc[a][b][m][n] = (f32x4){0.f, 0.f, 0.f, 0.f};
        cur = nxt; cA = nA; cB = nB; ++ui;
        if constexpr (GATHER) { vA0[0] = nV0[0]; vA0[1] = nV0[1]; vA1[0] = nV1[0]; vA1[1] = nV1[1]; }
        if constexpr (ALIGN_EPI) { if (wr == 1) PG8_BAR; }
    }
    PG8_WAIT_V(0);
    if constexpr (!ALIGN_EPI) { if (wr == 0) PG8_BAR; }
    PG8_BAR;
    if constexpr (Epi::AFTER_DRAIN) { E.fused(acc, cur, wr, wc, fr, fq, lds, wid, lane); S.done(cur); }
#undef PG8_GOFF
#undef PG8_SA
#undef PG8_SB
#undef PG8_STAGE
#undef PG8_LDA
#undef PG8_LDB
#undef PG8_MMA
#undef PG8_WAIT_V
#undef PG8_WAIT_L
#undef PG8_BAR
#undef PG8_SCHED
}
}

#define LAS __attribute__((address_space(3)))
typedef unsigned short bf16;
typedef float f32x4 __attribute__((ext_vector_type(4)));
typedef unsigned u32x4 __attribute__((ext_vector_type(4)));
typedef unsigned u32x2 __attribute__((ext_vector_type(2)));
constexpr int NWAVES = 8, NTHREADS = 512, LDS_BYTES = 160 * 1024;
#define SCHED_FENCE() __builtin_amdgcn_sched_barrier(0)

__device__ __forceinline__ unsigned f2bf(float f) { unsigned u = __float_as_uint(f); return (u + 0x7fffu + ((u >> 16) & 1u)) >> 16; }
__device__ __forceinline__ unsigned pk2(float lo, float hi) { return f2bf(lo) | (f2bf(hi) << 16); }
__device__ __forceinline__ unsigned cvt2(float lo, float hi) { return pg8::cvt_pk_bf16(lo, hi); }
__device__ __forceinline__ float bf2f(unsigned h) { return __uint_as_float(h << 16); }
#define DPPF(x, ctrl) __uint_as_float((unsigned)__builtin_amdgcn_update_dpp(0, (int)__float_as_uint(x), (ctrl), 0xf, 0xf, false))
__device__ __forceinline__ float wave_sum(float v) {
    v += DPPF(v, 0xB1); v += DPPF(v, 0x4E); v += DPPF(v, 0x141); v += DPPF(v, 0x140);
    const float s0 = __uint_as_float(__builtin_amdgcn_readlane(__float_as_uint(v), 0)), s1 = __uint_as_float(__builtin_amdgcn_readlane(__float_as_uint(v), 16));
    const float s2 = __uint_as_float(__builtin_amdgcn_readlane(__float_as_uint(v), 32)), s3 = __uint_as_float(__builtin_amdgcn_readlane(__float_as_uint(v), 48));
    return (s0 + s1) + (s2 + s3);
}
__device__ __forceinline__ float siluf(float x) { return x / (1.f + expf(-x)); }
__device__ __forceinline__ float gelu_tanh(float x) { return 0.5f * x * (1.f + tanhf(0.7978845608028654f * (x + 0.044715f * x * x * x))); }
__device__ __forceinline__ int mod_row(int row) { return ((row % RB) < SEQ) ? row / RB : 8; }
__device__ __forceinline__ bool is_ctx_row(int row) { return (row % RB) >= SEQ; }

typedef __attribute__((address_space(1))) unsigned gu32;
#define RLX_AGENT __ATOMIC_RELAXED, __HIP_MEMORY_SCOPE_AGENT
#define XB_TMO      128
#define XB_XCNT(j)  (256  + 64 * (j))
#define XB_XSUB(j)  (1280 + 64 * (j))
#define XB_XGEN(j)  (2304 + 64 * (j))
#define XB_TOP      3328
#define XB_TOPGEN   3392
#define XCD_BAR_WORDS 3456
#define XB_SPIN_CAP (1u << 18)

__device__ __forceinline__ unsigned xb_ld(unsigned* p)              { return __hip_atomic_load(p, __ATOMIC_RELAXED, __HIP_MEMORY_SCOPE_AGENT); }
__device__ __forceinline__ unsigned xb_add(unsigned* p, unsigned v) { return __hip_atomic_fetch_add(p, v, __ATOMIC_RELAXED, __HIP_MEMORY_SCOPE_AGENT); }
__device__ __forceinline__ unsigned xb_xcc_id() { return (unsigned)__builtin_amdgcn_s_getreg((3 << 11) | 20) & 0xFu; }
#define XB_SPIN(cond, bar) do { unsigned _sp = 0; while (cond) { __builtin_amdgcn_s_sleep(1); \
    if ((++_sp & 255u) == 0u) { if (xb_ld(&(bar)[XB_TMO])) break; if (_sp > XB_SPIN_CAP) { atomicAdd(&(bar)[XB_TMO], 1u); break; } } } } while (0)

struct XcdBarrier {
    unsigned* bar; unsigned x;
    volatile LAS unsigned* st;
};

__device__ __forceinline__ XcdBarrier xcd_barrier_post(unsigned* bar, volatile LAS unsigned* st) {
    XcdBarrier b; b.bar = bar; b.x = xb_xcc_id(); b.st = st;
    if (threadIdx.x == 0) (void)xb_add(&bar[XB_XCNT(b.x)], 1u);
    return b;
}
__device__ __forceinline__ void xcd_barrier_complete(unsigned* bar, unsigned x, unsigned& nloc, unsigned& nx) {
    const unsigned G = gridDim.x * gridDim.y * gridDim.z;
    unsigned sum, cnt, mine, sp = 0u;
    for (;;) {
        sum = 0u; cnt = 0u; mine = 0u;
#pragma unroll
        for (unsigned j = 0; j < 16; ++j) { const unsigned c = xb_ld(&bar[XB_XCNT(j)]); sum += c; cnt += (c > 0u) ? 1u : 0u; mine = (j == x) ? c : mine; }
        if (sum == G) break;
        __builtin_amdgcn_s_sleep(1);
        if ((++sp & 255u) == 0u) { if (xb_ld(&bar[XB_TMO])) break; if (sp > XB_SPIN_CAP) { atomicAdd(&bar[XB_TMO], 1u); break; } }
    }
    nloc = mine > 0u ? mine : 1u; nx = cnt > 0u ? cnt : 1u;
}

__device__ __forceinline__ void xcd_barrier(const XcdBarrier& b, const int xb_tid) {
    asm volatile("s_waitcnt vmcnt(0)" ::: "memory");
    __syncthreads();
    if (xb_tid == 0) {
        unsigned* bar = b.bar;
        __builtin_amdgcn_s_waitcnt(0);
        unsigned nloc = b.st[0], nx = b.st[1];
        if (nloc == 0u) { xcd_barrier_complete(bar, b.x, nloc, nx); b.st[0] = nloc; b.st[1] = nx; }
        const unsigned old = xb_add(&bar[XB_XSUB(b.x)], 1u);
        const unsigned gen = old / nloc;
        if (old + 1u == (gen + 1u) * nloc) {
            __builtin_amdgcn_fence(__ATOMIC_RELEASE, "agent");
            asm volatile("s_waitcnt vmcnt(0)" ::: "memory");
            const unsigned og = xb_add(&bar[XB_TOP], 1u);
            const unsigned tg = og / nx;
            if (og + 1u == (tg + 1u) * nx) xb_add(&bar[XB_TOPGEN], 1u);
            else XB_SPIN(xb_ld(&bar[XB_TOPGEN]) == tg, bar);
            __builtin_amdgcn_fence(__ATOMIC_ACQUIRE, "agent");
            xb_add(&bar[XB_XGEN(b.x)], 1u);
            asm volatile("s_waitcnt vmcnt(0)" ::: "memory");
        } else {
            XB_SPIN(xb_ld(&bar[XB_XGEN(b.x)]) == gen, bar);
            __builtin_amdgcn_fence(__ATOMIC_ACQUIRE, "agent");
            asm volatile("s_waitcnt vmcnt(0)" ::: "memory");
        }
    }
    __syncthreads();
}

constexpr size_t al256(size_t x) { return (x + 255) & ~(size_t)255; }
constexpr size_t WS_ZERO = 0, ZERO_BYTES = 2u << 20;
constexpr size_t Z_GCNT = 0;
constexpr size_t Z_SS2 = 4096;
constexpr size_t WS_MOD = ZERO_BYTES;
constexpr size_t WS_WRT = WS_MOD + al256((size_t)2 * 9 * 6144 * 4);
constexpr size_t WS_TOKE = WS_WRT + al256((size_t)2 * 36 * 1024 * 4);
constexpr size_t WS_TOKP = WS_TOKE + al256((size_t)NSLOT * 4);
constexpr size_t WS_TOKC = WS_TOKP + al256((size_t)NSLOT * 4);
constexpr size_t WS_TOKS = WS_TOKC + al256((size_t)NSLOT * 4);
constexpr size_t WS_TILE = WS_TOKS + al256((size_t)NSLOT * 4);
constexpr size_t WS_XC = WS_TILE + al256((size_t)(MT_MAX + 64) * 4);
constexpr size_t WS_WIN = WS_XC + al256((size_t)NB * CL * D * 4);
constexpr size_t WS_WOUT = WS_WIN + al256((size_t)2 * INW * D * 2);
constexpr size_t WS_WSB = WS_WOUT + al256((size_t)2 * D * D * 2);
constexpr size_t WS_LBV = WS_WSB + al256((size_t)2 * 4 * 128 * 128 * 2);
constexpr size_t WS_HB = WS_LBV + al256((size_t)2 * 2 * 512 * 4);
constexpr size_t WS_R = WS_HB + al256((size_t)M * D * 2);
constexpr int NCH = M / 64  , NCH2 = M / 128;
constexpr size_t R_QA = 0;
constexpr size_t R_KB = R_QA + al256((size_t)2 * M * 512 * 2);
constexpr size_t R_KDT = R_KB + al256((size_t)2 * M * 512 * 2);
constexpr size_t R_VT = R_KDT + al256((size_t)2 * M * 512 * 2);
constexpr size_t R_SG = R_VT + al256((size_t)M * 512 * 2);
constexpr size_t R_GU = R_SG + al256((size_t)M * 512 * 2);
constexpr size_t R_GVT = R_GU + al256((size_t)M * 512 * 2);
constexpr size_t R_EREF = R_GVT + al256((size_t)M * 512 * 2);
constexpr size_t R_DEC = R_EREF + al256((size_t)2 * NCH * 512 * 4);
constexpr size_t R_ST = R_DEC + al256((size_t)2 * NCH * 512 * 4);
constexpr size_t R_MIX_END = R_ST + al256((size_t)(NCH + 1) * 2 * 4 * 128 * 128 * 2);
constexpr size_t R_HS_DUMMY = 0;
constexpr size_t R_WGU = 0;
constexpr size_t R_WD = R_WGU + al256((size_t)NEXP * 1024 * D * 2);
constexpr size_t R_BUF = R_WD + al256((size_t)NEXP * D * DE * 2);
constexpr size_t R_ACT = R_BUF + al256((size_t)NSLOT_PAD * D * 2);
constexpr size_t R_Y = R_ACT + al256((size_t)NSLOT_PAD * DE * 2);
constexpr size_t R_MOE_END = R_Y + al256((size_t)NSLOT_PAD * D * 2);
constexpr size_t WS_END = WS_R + (R_MIX_END > R_MOE_END ? R_MIX_END : R_MOE_END);
static_assert(WS_END <= (size_t)634 * 1000 * 1000, "workspace budget (sum of inputs = 634.3 MB)");
constexpr size_t Z_SSV = Z_SS2 + (size_t)2 * M * 4;
constexpr size_t Z_XC = Z_GCNT + 256;
constexpr size_t Z_BAR = Z_SSV + (size_t)2 * M * 4;
static_assert(Z_BAR % 256 == 0 && Z_BAR + (size_t)XCD_BAR_WORDS * 4 <= ZERO_BYTES, "zeroed region");
constexpr int LDS_BARST = LDS_BYTES - 64, LDS_VBLK = LDS_BYTES - 32, LDS_STAMP = LDS_BYTES - 1024;

struct Params { const float* in[23]; float* out; unsigned char* ws; };
enum { I_X = 0, I_C, I_CTX, I_CCTX, I_NORM1, I_NORM2, I_WMOD, I_BMOD, I_WIN, I_LB, I_HGN, I_SGN, I_SGW, I_SGB, I_WOUT, I_WG, I_BG, I_WR, I_BR, I_WGATE, I_WUP, I_WDOWN, I_FN };

__device__ __forceinline__ void transpose_item(const float* W, int K, int N, bf16* WT, int k0, int n0, int rowbase, LAS float* scr, int lane) {
    float t[32];
#pragma unroll
    for (int i = 0; i < 32; ++i) t[i] = W[(size_t)(k0 + 2 * i + (lane >> 5)) * N + n0 + (lane & 31)];
    SCHED_FENCE();
#pragma unroll
    for (int i = 0; i < 32; ++i) scr[(2 * i + (lane >> 5)) * 33 + (lane & 31)] = t[i];
    asm volatile("s_waitcnt lgkmcnt(0)" ::: "memory");
    const int c = lane & 7;
#pragma unroll
    for (int j = 0; j < 4; ++j) { const int n = (lane >> 3) + 8 * j; const LAS float* s = scr + (8 * c) * 33 + n;
        u32x4 o; o.x = cvt2(s[0 * 33], s[1 * 33]); o.y = cvt2(s[2 * 33], s[3 * 33]); o.z = cvt2(s[4 * 33], s[5 * 33]); o.w = cvt2(s[6 * 33], s[7 * 33]);
        *(u32x4*)(WT + (size_t)(rowbase + n) * K + k0 + 8 * c) = o; }
    asm volatile("s_waitcnt lgkmcnt(0)" ::: "memory");
}
__device__ __forceinline__ void transpose_item_g(const float* W, int K, int N, bf16* WT, int k0, int srccol_lane, int rowbase, LAS float* scr, int lane) {
    float t[32];
#pragma unroll
    for (int i = 0; i < 32; ++i) t[i] = W[(size_t)(k0 + 2 * i + (lane >> 5)) * N + srccol_lane];
    SCHED_FENCE();
#pragma unroll
    for (int i = 0; i < 32; ++i) scr[(2 * i + (lane >> 5)) * 33 + (lane & 31)] = t[i];
    asm volatile("s_waitcnt lgkmcnt(0)" ::: "memory");
    const int c = lane & 7;
#pragma unroll
    for (int j = 0; j < 4; ++j) { const int n = (lane >> 3) + 8 * j; const LAS float* s = scr + (8 * c) * 33 + n;
        u32x4 o; o.x = cvt2(s[0 * 33], s[1 * 33]); o.y = cvt2(s[2 * 33], s[3 * 33]); o.z = cvt2(s[4 * 33], s[5 * 33]); o.w = cvt2(s[6 * 33], s[7 * 33]);
        *(u32x4*)(WT + (size_t)(rowbase + n) * K + k0 + 8 * c) = o; }
    asm volatile("s_waitcnt lgkmcnt(0)" ::: "memory");
}
__device__ __forceinline__ int win_srccol(int r) {
    const int pn = r >> 8, c = r & 255;
    if (pn >= 8) return 2048 + (pn - 8) * 256 + c;
    const int bj = c >> 7, wc = (c >> 5) & 3, fq = (c >> 3) & 3, n = (c >> 2) & 1, e = c & 3;
    return (2 * bj + n) * 512 + (pn >> 1) * 128 + (pn & 1) * 64 + 16 * wc + 4 * fq + e;
}
__device__ __forceinline__ void norm_mod_row(const float* xr, const float* gain, const float* sh, const float* sc, bf16* orow, int lane) {
    f32x4 v[4]; float ss = 0.f;
#pragma unroll
    for (int j = 0; j < 4; ++j) { v[j] = *(const f32x4*)(xr + 4 * lane + 256 * j); ss += (v[j][0] * v[j][0] + v[j][1] * v[j][1]) + (v[j][2] * v[j][2] + v[j][3] * v[j][3]); }
    const float rs = rsqrtf(wave_sum(ss) * (1.f / D) + EPS);
#pragma unroll
    for (int j = 0; j < 4; ++j) { const int k = 4 * lane + 256 * j; const f32x4 g = *(const f32x4*)(gain + k), s1 = *(const f32x4*)(sc + k), s0 = *(const f32x4*)(sh + k);
        const f32x4 o = v[j] * rs * g * (s1 + 1.f) + s0; u32x2 w; w.x = cvt2(o[0], o[1]); w.y = cvt2(o[2], o[3]); *(u32x2*)(orow + k) = w; }
}
__device__ __forceinline__ const float* xrow_in(const Params& p, int row) { const int b = row / RB, t = row % RB; return t < SEQ ? p.in[I_X] + ((size_t)b * SEQ + t) * D : p.in[I_CTX] + ((size_t)b * CL + (t - SEQ)) * D; }
__device__ __forceinline__ float* xrow_cur(const Params& p, int row) { const int b = row / RB, t = row % RB; return t < SEQ ? p.out + ((size_t)b * SEQ + t) * D : (float*)(p.ws + WS_XC) + ((size_t)b * CL + (t - SEQ)) * D; }

__device__ __forceinline__ int vblk() { return __builtin_amdgcn_readfirstlane(*(const LAS int*)(unsigned)LDS_VBLK); }
__device__ __forceinline__ void ph_prologue(const Params& p, LAS unsigned char* lds, int tid, int lane, int wave, int G) {
    float* MOD = (float*)(p.ws + WS_MOD);
    if (blockIdx.x < 192) {
        const int l = blockIdx.x / 96, col0 = (blockIdx.x % 96) * 64;
        LAS float* sc = (LAS float*)lds; LAS float* red = (LAS float*)(lds + 36864);
        for (int i = tid; i < 9 * 1024; i += NTHREADS) { const int r = i >> 10, k = i & 1023; sc[i] = siluf(r < 8 ? p.in[I_C][r * 1024 + k] : p.in[I_CCTX][k]); }
        __syncthreads();
        const int c4 = tid & 15, kg = tid >> 4;
        f32x4 acc[9];
#pragma unroll
        for (int r = 0; r < 9; ++r) acc[r] = (f32x4){0.f, 0.f, 0.f, 0.f};
        const float* w = p.in[I_WMOD] + (size_t)l * 1024 * 6144 + col0 + 4 * c4;
#pragma unroll 8
        for (int k = kg; k < 1024; k += 32) { const f32x4 wv = *(const f32x4*)(w + (size_t)k * 6144);
#pragma unroll
            for (int r = 0; r < 9; ++r) acc[r] += wv * sc[r * 1024 + k]; }
#pragma unroll
        for (int r = 0; r < 9; ++r) *(LAS f32x4*)&red[(kg * 9 + r) * 64 + 4 * c4] = acc[r];
        __syncthreads();
        for (int i = tid; i < 576; i += NTHREADS) { const int r = i >> 6, cc = i & 63; float s = 0.f;
            for (int g = 0; g < 32; ++g) s += red[(g * 9 + r) * 64 + cc];
            MOD[(size_t)(l * 9 + r) * 6144 + col0 + cc] = s + p.in[I_BMOD][l * 6144 + col0 + cc]; }
        __syncthreads();
    }
    {
        float* WRT = (float*)(p.ws + WS_WRT);
        for (int i = blockIdx.x * NTHREADS + tid; i < 2 * 36 * 1024; i += G * NTHREADS) { const int l = i / (36 * 1024), o = (i / 1024) % 36, k = i & 1023;
            WRT[i] = o < 4 ? p.in[I_WG][((size_t)l * 1024 + k) * 4 + o] : p.in[I_WR][((size_t)l * 1024 + k) * 32 + (o - 4)]; }
    }
    {
        float* LBV = (float*)(p.ws + WS_LBV); bf16* WSB = (bf16*)(p.ws + WS_WSB);
        for (int i = blockIdx.x * NTHREADS + tid; i < 1024; i += G * NTHREADS) { LBV[i] = 0.f; LBV[1024 + i] = 1.f / (1.f + expf(p.in[I_LB][i] - p.in[I_LB][1024 + i])); }
        for (int i = blockIdx.x * NTHREADS + tid; i < 2 * 4 * 128 * 128; i += G * NTHREADS) {
            const int jj = i & 7, L = (i >> 3) & 63, sidx = (i >> 9) & 7, itile = (i >> 12) & 3, lh = i >> 14;
            WSB[i] = (bf16)f2bf(p.in[I_SGW][(size_t)lh * 128 * 128 + (32 * itile + (L & 31)) * 128 + 16 * sidx + 8 * (L >> 5) + jj]); }
    }
    LAS float* scr = (LAS float*)(lds + wave * 16384);
    const int gw = blockIdx.x * NWAVES + wave, NGW = G * NWAVES;
    constexpr int I_IN = (D / 64) * (INW / 32), I_OUT = (D / 64) * (D / 32);
    for (int it = gw; it < 2 * (I_IN + I_OUT); it += NGW) {
        const int l = it / (I_IN + I_OUT); int r = it % (I_IN + I_OUT);
        if (r < I_IN) { const int nblk = INW / 32, kb = r / nblk, nb = r % nblk; transpose_item_g(p.in[I_WIN] + (size_t)l * D * INW, D, INW, (bf16*)(p.ws + WS_WIN) + (size_t)l * INW * D, 64 * kb, win_srccol(32 * nb + (lane & 31)), 32 * nb, scr, lane); }
        else { r -= I_IN; const int nblk = D / 32, kb = r / nblk, nb = r % nblk; transpose_item(p.in[I_WOUT] + (size_t)l * D * D, D, D, (bf16*)(p.ws + WS_WOUT) + (size_t)l * D * D, 64 * kb, 32 * nb, 32 * nb, scr, lane); }
    }
}
__device__ __forceinline__ void ph_h1_first(const Params& p, LAS unsigned char* lds, int tid, int lane, int wave, int G) {
    const float* MOD = (const float*)(p.ws + WS_MOD); bf16* HB = (bf16*)(p.ws + WS_HB); const float* gain = p.in[I_NORM1];
    LAS f32x4* sm = (LAS f32x4*)lds;
    { f32x4 t[10];
#pragma unroll
      for (int i = 0; i < 10; ++i) { const int e = tid + i * NTHREADS; if (e < 19 * 256) { const int blk = e >> 8, c = e & 255; t[i] = blk < 18 ? *(const f32x4*)(MOD + (size_t)(blk >> 1) * 6144 + (blk & 1) * 1024 + 4 * c) : *(const f32x4*)(gain + 4 * c); } }
      SCHED_FENCE();
#pragma unroll
      for (int i = 0; i < 10; ++i) { const int e = tid + i * NTHREADS; if (e < 19 * 256) sm[e] = t[i]; } }
    __syncthreads();
    const int stride = G * NWAVES;
    for (int row0 = vblk() * NWAVES + wave; row0 < M; row0 += 4 * stride) {
        f32x4 v[4][4]; bool act[4]; int rows[4];
#pragma unroll
        for (int rr = 0; rr < 4; ++rr) { const int row = row0 + rr * stride; act[rr] = row < M; rows[rr] = act[rr] ? row : row0; const float* xr = xrow_in(p, rows[rr]);
#pragma unroll
            for (int j = 0; j < 4; ++j) v[rr][j] = *(const f32x4*)(xr + 4 * lane + 256 * j); }
        SCHED_FENCE();
#pragma unroll
        for (int rr = 0; rr < 4; ++rr) { float ss = 0.f;
#pragma unroll
            for (int j = 0; j < 4; ++j) ss += (v[rr][j][0] * v[rr][j][0] + v[rr][j][1] * v[rr][j][1]) + (v[rr][j][2] * v[rr][j][2] + v[rr][j][3] * v[rr][j][3]);
            const float rs = rsqrtf(wave_sum(ss) * (1.f / D) + EPS); const int mr = mod_row(rows[rr]);
            if (act[rr]) {
#pragma unroll
                for (int j = 0; j < 4; ++j) { const int c = lane + 64 * j; const f32x4 o = v[rr][j] * rs * sm[18 * 256 + c] * (sm[(mr * 2 + 1) * 256 + c] + 1.f) + sm[(mr * 2) * 256 + c];
                    u32x2 w; w.x = cvt2(o[0], o[1]); w.y = cvt2(o[2], o[3]); *(u32x2*)(HB + (size_t)rows[rr] * D + 4 * c) = w; } } }
    }
}
__device__ __forceinline__ void ph_moe_wconv(const Params& p, int l, LAS unsigned char* lds, int lane, int wave, int blk, int nblk) {
    LAS float* scr = (LAS float*)(lds + wave * 16384);
    bf16* WGU = (bf16*)(p.ws + WS_R + R_WGU); bf16* WD = (bf16*)(p.ws + WS_R + R_WD);
    constexpr int I_G = (D / 64) * (DE / 32)  , I_D = (DE / 64) * (D / 32)  , PER_E = 2 * I_G + I_D;
    for (int it = blk * NWAVES + wave; it < NEXP * PER_E; it += nblk * NWAVES) {
        const int e = it / PER_E; int r = it % PER_E;
        if (r < 2 * I_G) { const int isup = r >= I_G; r -= isup * I_G; const int nblk = DE / 32, kb = r / nblk, nb = r % nblk, n0 = 32 * nb;
            const float* W = p.in[isup ? I_WUP : I_WGATE] + ((size_t)l * NEXP + e) * D * DE;
            transpose_item(W, D, DE, WGU + (size_t)e * 1024 * D, 64 * kb, n0, 256 * (n0 >> 7) + 128 * isup + (n0 & 127), scr, lane); }
        else { r -= 2 * I_G; const int nblk = D / 32, kb = r / nblk, nb = r % nblk;
            transpose_item(p.in[I_WDOWN] + ((size_t)l * NEXP + e) * DE * D, DE, D, WD + (size_t)e * D * DE, 64 * kb, 32 * nb, 32 * nb, scr, lane); }
    }
}
__device__ __forceinline__ float opaque_v(float x) { asm volatile("" : "+v"(x)); return x; }
__device__ __forceinline__ void ph_router(const Params& p, int l, int last, LAS unsigned char* lds, int tid, int lane, int wave, int G) {
    LAS float* W = (LAS float*)lds; LAS int* hist = (LAS int*)(lds + 147456); LAS int* base = hist + 32; LAS int* sinfo = base + 32 + wave * 40;
    const float* WRT = (const float*)(p.ws + WS_WRT) + (size_t)l * 36 * 1024;
    { f32x4 wt[18];
#pragma unroll
      for (int i = 0; i < 18; ++i) wt[i] = ((const f32x4*)WRT)[tid + i * NTHREADS];
      SCHED_FENCE();
#pragma unroll
      for (int i = 0; i < 18; ++i) ((LAS f32x4*)W)[tid + i * NTHREADS] = wt[i]; }
    if (tid < 32) hist[tid] = 0;
    const float* MOD = (const float*)(p.ws + WS_MOD) + (size_t)l * 9 * 6144; const float* SS2 = (const float*)(p.ws + WS_ZERO + Z_SS2) + (size_t)l * M;
    bf16* HB = (bf16*)(p.ws + WS_HB); int* TOKE = (int*)(p.ws + WS_TOKE); float* TOKC = (float*)(p.ws + WS_TOKC); int* TOKP = (int*)(p.ws + WS_TOKP);
    int* gcnt = (int*)(p.ws + WS_ZERO + Z_GCNT) + l * 64;
    const float* gain = p.in[I_NORM2] + l * D;
    LAS float* Bv = (LAS float*)(lds + 147456 + 2048);
    if (tid < 36) Bv[tid] = tid < 4 ? p.in[I_BG][l * 4 + tid] : p.in[I_BR][l * 32 + tid - 4];
    __syncthreads();
    int nloc = 0;
    const int stride = G * NWAVES;
    for (int row0 = vblk() * NWAVES + wave; row0 < M; row0 += 2 * stride) {
        const bool two = row0 + stride < M; const int rows[2] = {row0, two ? row0 + stride : row0};
        bool act[2]; f32x4 h[2][4];
        {
            f32x4 xv[2][4], s1v[2][4], s0v[2][4], gv[4]; float ssq[2];
#pragma unroll
            for (int rr = 0; rr < 2; ++rr) { const int row = rows[rr]; act[rr] = (rr == 0 || two) && !(last && is_ctx_row(row));
                const float* xr = xrow_cur(p, row); const float* mr = MOD + (size_t)mod_row(row) * 6144; ssq[rr] = SS2[row];
#pragma unroll
                for (int j = 0; j < 4; ++j) { const int k = 4 * lane + 256 * j; xv[rr][j] = *(const f32x4*)(xr + k); s1v[rr][j] = *(const f32x4*)(mr + 4 * 1024 + k); s0v[rr][j] = *(const f32x4*)(mr + 3 * 1024 + k); } }
#pragma unroll
            for (int j = 0; j < 4; ++j) gv[j] = *(const f32x4*)(gain + 4 * lane + 256 * j);
            SCHED_FENCE();
#pragma unroll
            for (int rr = 0; rr < 2; ++rr) { const float rs = rsqrtf(ssq[rr] * (1.f / D) + EPS);
#pragma unroll
                for (int j = 0; j < 4; ++j) { const int k = 4 * lane + 256 * j; h[rr][j] = xv[rr][j] * rs * gv[j] * (s1v[rr][j] + 1.f) + s0v[rr][j];
                    if (act[rr]) { u32x2 w; w.x = cvt2(h[rr][j][0], h[rr][j][1]); w.y = cvt2(h[rr][j][2], h[rr][j][3]); *(u32x2*)(HB + (size_t)rows[rr] * D + k) = w; } } }
        }
        typedef float f32x2 __attribute__((ext_vector_type(2)));
        float gl[2][4];
        { f32x4 wg[16];
#pragma unroll
          for (int q = 0; q < 16; ++q) wg[q] = *(const LAS f32x4*)&W[(q >> 2) * 1024 + 4 * lane + 256 * (q & 3)];
          SCHED_FENCE();
#pragma unroll
          for (int o = 0; o < 4; ++o)
#pragma unroll
              for (int rr = 0; rr < 2; ++rr) { f32x2 a2 = {0.f, 0.f};
#pragma unroll
                  for (int j = 0; j < 4; ++j) { const f32x4 wv = wg[o * 4 + j], hv = h[rr][j];
                      a2 = __builtin_elementwise_fma((f32x2){hv[0], hv[1]}, (f32x2){wv[0], wv[1]}, a2); a2 = __builtin_elementwise_fma((f32x2){hv[2], hv[3]}, (f32x2){wv[2], wv[3]}, a2); }
                  gl[rr][o] = opaque_v(wave_sum(a2[0] + a2[1]) + Bv[o]); } }
#pragma unroll
        for (int rr = 0; rr < 2; ++rr) {
            const int row = rows[rr];
            int gs = 0; float gmax = gl[rr][0];
#pragma unroll
            for (int o = 1; o < 4; ++o) if (gl[rr][o] > gmax) { gmax = gl[rr][o]; gs = o; }
            float den = 0.f;
#pragma unroll
            for (int o = 0; o < 4; ++o) den += __expf(gl[rr][o] - gmax);
            const float psel = 1.f / den;
            const int gsu = __builtin_amdgcn_readfirstlane(gs);
            const LAS float* wb = W + (4 + 8 * gsu) * 1024 + 4 * lane; const LAS float* bb = Bv + 4 + 8 * gsu;
            float li[8];
#pragma unroll
            for (int half = 0; half < 2; ++half) { f32x4 we[16];
#pragma unroll
                for (int q = 0; q < 16; ++q) we[q] = *(const LAS f32x4*)&wb[(4 * half + (q >> 2)) * 1024 + 256 * (q & 3)];
                SCHED_FENCE();
#pragma unroll
                for (int o = 0; o < 4; ++o) { f32x2 a2 = {0.f, 0.f};
#pragma unroll
                    for (int j = 0; j < 4; ++j) { const f32x4 wv = we[o * 4 + j], hv = h[rr][j];
                        a2 = __builtin_elementwise_fma((f32x2){hv[0], hv[1]}, (f32x2){wv[0], wv[1]}, a2); a2 = __builtin_elementwise_fma((f32x2){hv[2], hv[3]}, (f32x2){wv[2], wv[3]}, a2); }
                    li[4 * half + o] = opaque_v(wave_sum(a2[0] + a2[1]) + bb[4 * half + o]); } }
            int i0 = 0; float m0 = li[0];
#pragma unroll
            for (int j = 1; j < 8; ++j) if (li[j] > m0) { m0 = li[j]; i0 = j; }
            int i1 = 0; float m1 = -3.0e38f;
#pragma unroll
            for (int j = 0; j < 8; ++j) if (j != i0 && li[j] > m1) { m1 = li[j]; i1 = j; }
            const float e1 = __expf(m1 - m0);
            if (act[rr]) {
                if (lane < 2) { const int e = gs * 8 + (lane ? i1 : i0); const float c = lane ? psel * e1 / (1.f + e1) : psel / (1.f + e1);
                    const int lp = __hip_atomic_fetch_add(&hist[e], 1, __ATOMIC_RELAXED, __HIP_MEMORY_SCOPE_WORKGROUP); TOKE[row * 2 + lane] = e; TOKC[row * 2 + lane] = c; sinfo[nloc * 2 + lane] = (e << 16) | lp; }
                ++nloc; }
        }
    }
    __syncthreads();
    if (tid < 32) base[tid] = atomicAdd(&gcnt[tid], hist[tid]);
    __syncthreads();
    nloc = 0;
    for (int row0 = vblk() * NWAVES + wave; row0 < M; row0 += 2 * stride) {
        const bool two = row0 + stride < M;
#pragma unroll
        for (int rr = 0; rr < 2; ++rr) { const int row = rr ? row0 + stride : row0; if ((rr == 0 || two) && !(last && is_ctx_row(row))) {
            if (lane < 2) { const int info = sinfo[nloc * 2 + lane]; TOKP[row * 2 + lane] = base[info >> 16] + (info & 0xffff); }
            ++nloc; } }
    }
}
__device__ __forceinline__ void ph_place(const Params& p, int l, int last, LAS unsigned char* lds, int tid, int lane, int wave, int G) {
    LAS int* ps = (LAS int*)lds;
    const int* gcnt = (const int*)(p.ws + WS_ZERO + Z_GCNT) + l * 64; int* TILE = (int*)(p.ws + WS_TILE);
    if (tid == 0) { int s = 0; for (int e = 0; e < NEXP; ++e) { ps[e] = s; s += (gcnt[e] + 255) / 256 * 256; } ps[32] = s; }
    __syncthreads();
    if (vblk() == 0 && tid < 32) { for (int t = ps[tid] / 256; t < ps[tid + 1] / 256; ++t) TILE[t] = tid; if (tid == 0) TILE[MT_MAX] = ps[32] / 256; }
    int* ROWMAP = (int*)(p.ws + WS_R + R_BUF);
    const int* TOKE = (const int*)(p.ws + WS_TOKE); const int* TOKP = (const int*)(p.ws + WS_TOKP); int* TOKS = (int*)(p.ws + WS_TOKS);
    for (int i = vblk() * NTHREADS + tid; i < NSLOT; i += G * NTHREADS) { const int row = i >> 1;
        if (last && is_ctx_row(row)) continue;
        const int sl = ps[TOKE[i]] + TOKP[i]; TOKS[i] = sl; ROWMAP[sl] = row; }
    if (vblk() == 1) { for (int e = 0; e < NEXP; ++e) for (int sl = ps[e] + gcnt[e] + tid; sl < ps[e + 1]; sl += NTHREADS) ROWMAP[sl] = 0; }
}
__device__ __forceinline__ void ph_combine(const Params& p, int l, int last, LAS unsigned char* lds, int tid, int lane, int wave, int G) {
    const float* MOD = (const float*)(p.ws + WS_MOD); const bf16* Y = (const bf16*)(p.ws + WS_R + R_Y); bf16* HB = (bf16*)(p.ws + WS_HB);
    const int* TOKS = (const int*)(p.ws + WS_TOKS); const float* TOKC = (const float*)(p.ws + WS_TOKC);
    const float* gain = last ? p.in[I_FN] : p.in[I_NORM1] + (l + 1) * D;
    LAS f32x4* sm = (LAS f32x4*)lds;
    { f32x4 t[14];
#pragma unroll
      for (int i = 0; i < 14; ++i) { const int e = tid + i * NTHREADS; if (e < 28 * 256) { const int blk = e >> 8, c = e & 255, mr = blk / 3, wh = blk % 3;
          t[i] = blk < 27 ? *(const f32x4*)(MOD + ((size_t)(wh == 0 ? l : (last ? l : l + 1)) * 9 + mr) * 6144 + (wh == 0 ? 5 : wh - 1) * 1024 + 4 * c) : *(const f32x4*)(gain + 4 * c); } }
      SCHED_FENCE();
#pragma unroll
      for (int i = 0; i < 14; ++i) { const int e = tid + i * NTHREADS; if (e < 28 * 256) sm[e] = t[i]; } }
    __syncthreads();
    const int stride = G * NWAVES;
    for (int row0 = vblk() * NWAVES + wave; row0 < M; row0 += 4 * stride) {
        bool act[4]; int rows[4]; float* xr[4]; f32x4 x[4][4]; u32x2 y0[4][4], y1[4][4]; float c0[4], c1[4];
#pragma unroll
        for (int rr = 0; rr < 4; ++rr) { const int rw = row0 + rr * stride; const bool in = rw < M; const int row = in ? rw : row0; rows[rr] = row; act[rr] = in && !(last && is_ctx_row(row)); xr[rr] = xrow_cur(p, row);
            const int s0 = act[rr] ? TOKS[row * 2] : 0, s1 = act[rr] ? TOKS[row * 2 + 1] : 0; c0[rr] = TOKC[row * 2]; c1[rr] = TOKC[row * 2 + 1];
#pragma unroll
            for (int j = 0; j < 4; ++j) { const int k = 4 * lane + 256 * j; x[rr][j] = *(const f32x4*)(xr[rr] + k); y0[rr][j] = *(const u32x2*)(Y + (size_t)s0 * D + k); y1[rr][j] = *(const u32x2*)(Y + (size_t)s1 * D + k); } }
        SCHED_FENCE();
#pragma unroll
        for (int rr = 0; rr < 4; ++rr) { f32x4 v[4]; float ss = 0.f; const int mr = mod_row(rows[rr]);
#pragma unroll
            for (int j = 0; j < 4; ++j) { const u32x2 a = y0[rr][j], b = y1[rr][j]; f32x4 f;
                f[0] = c0[rr] * bf2f(a.x & 0xffffu) + c1[rr] * bf2f(b.x & 0xffffu); f[1] = c0[rr] * bf2f(a.x >> 16) + c1[rr] * bf2f(b.x >> 16);
                f[2] = c0[rr] * bf2f(a.y & 0xffffu) + c1[rr] * bf2f(b.y & 0xffffu); f[3] = c0[rr] * bf2f(a.y >> 16) + c1[rr] * bf2f(b.y >> 16);
                v[j] = x[rr][j] + sm[(mr * 3) * 256 + lane + 64 * j] * f; ss += (v[j][0] * v[j][0] + v[j][1] * v[j][1]) + (v[j][2] * v[j][2] + v[j][3] * v[j][3]); }
            const float rs = rsqrtf(wave_sum(ss) * (1.f / D) + EPS);
            if (act[rr]) {
                if (!last) {
#pragma unroll
                    for (int j = 0; j < 4; ++j) { const int c = lane + 64 * j, k = 4 * c; *(f32x4*)(xr[rr] + k) = v[j];
                        const f32x4 o = v[j] * rs * sm[27 * 256 + c] * (sm[(mr * 3 + 2) * 256 + c] + 1.f) + sm[(mr * 3 + 1) * 256 + c];
                        u32x2 w; w.x = cvt2(o[0], o[1]); w.y = cvt2(o[2], o[3]); *(u32x2*)(HB + (size_t)rows[rr] * D + k) = w; } }
                else {
#pragma unroll
                    for (int j = 0; j < 4; ++j) { const int c = lane + 64 * j; *(f32x4*)(xr[rr] + 4 * c) = v[j] * rs * sm[27 * 256 + c]; } } } }
    }
}
__device__ __forceinline__ int scan_chunk(int step, int dir) { return dir == 0 ? (step < 4 ? 64 + step : step - 4) : 67 - step; }
typedef short bf16x8 __attribute__((ext_vector_type(8)));
typedef short s16x4 __attribute__((ext_vector_type(4)));
typedef float f32x16 __attribute__((ext_vector_type(16)));
#define MFMA32(a, b, c) __builtin_amdgcn_mfma_f32_32x32x16_bf16((a), (b), (c), 0, 0, 0)
__device__ __forceinline__ bf16x8 ld8(const bf16* q) { return *(const bf16x8*)q; }
__device__ __forceinline__ bf16x8 ld44(const bf16* q0, const bf16* q1) { const s16x4 lo = *(const s16x4*)q0, hi = *(const s16x4*)q1; return __builtin_shufflevector(lo, hi, 0, 1, 2, 3, 4, 5, 6, 7); }
__device__ __forceinline__ f32x16 zero16() { f32x16 z;
#pragma unroll
    for (int i = 0; i < 16; ++i) z[i] = 0.f; return z; }
__device__ __forceinline__ bf16x8 pack_acc(const f32x16& x, int s) { u32x4 w; w.x = pk2(x[8 * s], x[8 * s + 1]); w.y = pk2(x[8 * s + 2], x[8 * s + 3]); w.z = pk2(x[8 * s + 4], x[8 * s + 5]); w.w = pk2(x[8 * s + 6], x[8 * s + 7]); return __builtin_bit_cast(bf16x8, w); }
__device__ __forceinline__ bf16x8 scale8(bf16x8 f, f32x4 a, f32x4 b) { const u32x4 w = __builtin_bit_cast(u32x4, f); u32x4 o;
    o.x = cvt2(bf2f(w.x & 0xffffu) * a[0], bf2f(w.x >> 16) * a[1]); o.y = cvt2(bf2f(w.y & 0xffffu) * a[2], bf2f(w.y >> 16) * a[3]);
    o.z = cvt2(bf2f(w.z & 0xffffu) * b[0], bf2f(w.z >> 16) * b[1]); o.w = cvt2(bf2f(w.w & 0xffffu) * b[2], bf2f(w.w >> 16) * b[3]); return __builtin_bit_cast(bf16x8, o); }

constexpr int SCAN_DE_BYTES = 69 * 256 * 4, SCAN_RING_OFF = 71680, SCAN_BUF_BYTES = 24 * 1024;
__device__ __forceinline__ void scan_item(int item, int& b, int& h, int& dir, int& eh) {
    const int xcd = item & 7, j = item >> 3, pair = (j >> 2) * 8 + xcd; eh = j & 1; dir = (j >> 1) & 1; h = pair & 3; b = pair >> 2;
}
__device__ __forceinline__ void scan_preload(const Params& p, LAS unsigned char* lds, int tid, int item) {
    int b, h, dir, eh; scan_item(item, b, h, dir, eh);
    const float* DEC = (const float*)(p.ws + WS_R + R_DEC) + (size_t)dir * NCH * 512 + h * 128; const float* ER = (const float*)(p.ws + WS_R + R_EREF) + (size_t)dir * NCH * 512 + h * 128;
    LAS float* de = (LAS float*)lds;
    for (int i = tid; i < 69 * 256; i += NTHREADS) { const int step = i >> 8, w = i & 255; const size_t gc = (size_t)(b * 68 + scan_chunk(step < 68 ? step : 67, dir));
        de[i] = w < 128 ? DEC[gc * 512 + w] : ER[gc * 512 + (w - 128)]; }
}
struct ScanRegs { bf16x8 f[3]; };
__device__ __forceinline__ void ph_scan(const Params& p, LAS unsigned char* lds, int lane, int wave, int item) {
    int b, h, dir, eh; scan_item(item, b, h, dir, eh);
    const int dt = wave & 3, etl = wave >> 2, et = 2 * eh + etl, hh = lane >> 5;
    const bf16* KD = (const bf16*)(p.ws + WS_R + R_KDT) + (size_t)dir * M * 512; const bf16* V = (const bf16*)(p.ws + WS_R + R_VT);
    const bf16* src[3];
#pragma unroll
    for (int i = 0; i < 3; ++i) { const int f = 3 * wave + i; src[i] = f < 16 ? KD + ((((size_t)h * 4 + (f >> 2)) * 4 + (f & 3)) * 64 + lane) * 8 : V + ((((size_t)h * 4 + 2 * eh + ((f - 16) >> 2)) * 4 + (f & 3)) * 64 + lane) * 8; }
    const LAS float* de = (const LAS float*)lds + 32 * dt + 4 * hh;
    LAS unsigned char* ring = lds + SCAN_RING_OFF;
    const int wofs = 3 * wave * 1024 + lane * 16, aofs = dt * 4 * 1024 + lane * 16, bofs = (16 + etl * 4) * 1024 + lane * 16;
    bf16* ST = (bf16*)(p.ws + WS_R + R_ST) + (((size_t)dir * 4 + h) * 16 + dt * 4 + et) * 1024 + lane * 8;
    f32x16 S = zero16();
#define SCAN_GC(step) ((size_t)(b * 68 + scan_chunk((step) < 68 ? (step) : 67, dir)))
#define SCAN_LOAD(R, step) { const size_t g_ = SCAN_GC(step) * (4 * 4 * 4 * 512); _Pragma("unroll") for (int i = 0; i < 3; ++i) R.f[i] = ld8(src[i] + g_); }
#define SCAN_WRITE(R, buf) { _Pragma("unroll") for (int i = 0; i < 3; ++i) *(LAS bf16x8*)(ring + (buf) * SCAN_BUF_BYTES + wofs + i * 1024) = R.f[i]; }
#define SCAN_BAR() { asm volatile("s_waitcnt lgkmcnt(0)" ::: "memory"); __builtin_amdgcn_s_barrier(); asm volatile("" ::: "memory"); }
    ScanRegs P0, P1;
    SCAN_LOAD(P0, 0); SCAN_LOAD(P1, 1);
    SCAN_WRITE(P0, 0); SCAN_LOAD(P0, 2);
    for (int k0 = 0; k0 < 72; k0 += 6) {
#pragma unroll
        for (int j = 0; j < 6; ++j) { const int k = k0 + j;
            SCAN_BAR();
            if ((j + 1) & 1) { SCAN_WRITE(P1, (j + 1) % 3); SCAN_LOAD(P1, k + 3); } else { SCAN_WRITE(P0, (j + 1) % 3); SCAN_LOAD(P0, k + 3); }
            const LAS unsigned char* buf = ring + (j % 3) * SCAN_BUF_BYTES;
            bf16x8 fa[4], fb[4]; f32x4 dc[4], er[4]; const LAS float* dk = de + (k < 69 ? k : 68) * 256;
#pragma unroll
            for (int s = 0; s < 4; ++s) { fa[s] = *(const LAS bf16x8*)(buf + aofs + s * 1024); fb[s] = *(const LAS bf16x8*)(buf + bofs + s * 1024); dc[s] = *(const LAS f32x4*)(dk + 8 * s); er[s] = *(const LAS f32x4*)(dk + 128 + 8 * s); }
            { bf16* st = ST + (k < 68 ? SCAN_GC(k) : (size_t)NCH) * (2 * 4 * 16384); u32x4 w0, w1;
              w0.x = cvt2(S[0] * er[0][0], S[1] * er[0][1]); w0.y = cvt2(S[2] * er[0][2], S[3] * er[0][3]); w0.z = cvt2(S[4] * er[1][0], S[5] * er[1][1]); w0.w = cvt2(S[6] * er[1][2], S[7] * er[1][3]);
              w1.x = cvt2(S[8] * er[2][0], S[9] * er[2][1]); w1.y = cvt2(S[10] * er[2][2], S[11] * er[2][3]); w1.z = cvt2(S[12] * er[3][0], S[13] * er[3][1]); w1.w = cvt2(S[14] * er[3][2], S[15] * er[3][3]);
              *(u32x4*)st = w0; *(u32x4*)(st + 512) = w1; }
#pragma unroll
            for (int g = 0; g < 4; ++g)
#pragma unroll
                for (int q = 0; q < 4; ++q) S[4 * g + q] *= dc[g][q];
#pragma unroll
            for (int s = 0; s < 4; ++s) S = MFMA32(fa[s], fb[s], S);
        }
    }
#undef SCAN_GC
#undef SCAN_LOAD
#undef SCAN_WRITE
#undef SCAN_BAR
}
__device__ __forceinline__ void ph_sgu(const Params& p, int l, int lane, int widx, int nw) {
    const bf16* GVT = (const bf16*)(p.ws + WS_R + R_GVT); const bf16* GU = (const bf16*)(p.ws + WS_R + R_GU); bf16* HS = (bf16*)(p.ws + WS_HB);
    const float* SSV = (const float*)(p.ws + WS_ZERO + Z_SSV) + (size_t)l * M; const bf16* WSB = (const bf16*)(p.ws + WS_WSB) + (size_t)l * 4 * 128 * 128; const float* bs = p.in[I_SGB] + l * 512;
    const int r = lane & 31, hh = lane >> 5;
    for (int it = widx; it < NCH2 * 16; it += nw) { const int gc2 = it >> 4, h = (it >> 2) & 3, cht = it & 3;
        const bf16* ap = GVT + ((((size_t)(gc2 * 4 + h) * 4 + cht) * 8) * 64 + lane) * 8; const float* sp = SSV + gc2 * 128 + 8 * hh; const bf16* wp = WSB + ((((size_t)h * 4) * 8) * 64 + lane) * 8;
        f32x16 acc[4] = {zero16(), zero16(), zero16(), zero16()};
        bf16x8 av[8]; f32x4 sv[16];
#pragma unroll
        for (int s = 0; s < 8; ++s) { av[s] = ld8(ap + s * 512); sv[2 * s] = *(const f32x4*)(sp + 16 * s); sv[2 * s + 1] = *(const f32x4*)(sp + 16 * s + 4); }
        bf16x8 wa[4], wb[4];
#pragma unroll
        for (int t = 0; t < 4; ++t) wa[t] = ld8(wp + (size_t)t * 8 * 512);
#pragma unroll
        for (int s = 0; s < 8; ++s) {
            SCHED_FENCE();
            if (s < 7) {
#pragma unroll
                for (int t = 0; t < 4; ++t) { const bf16x8 w = ld8(wp + (size_t)t * 8 * 512 + (s + 1) * 512); if (s & 1) wa[t] = w; else wb[t] = w; } }
            SCHED_FENCE();
            f32x4 s0 = sv[2 * s], s1 = sv[2 * s + 1];
#pragma unroll
            for (int q = 0; q < 4; ++q) { s0[q] = rsqrtf(s0[q] * (1.f / 512.f) + EPS); s1[q] = rsqrtf(s1[q] * (1.f / 512.f) + EPS); }
            const bf16x8 a = scale8(av[s], s0, s1);
#pragma unroll
            for (int t = 0; t < 4; ++t) acc[t] = MFMA32(a, (s & 1) ? wb[t] : wa[t], acc[t]); }
        u32x2 gu[4][4]; float bias[4];
#pragma unroll
        for (int t = 0; t < 4; ++t) { const size_t row = (size_t)gc2 * 128 + 32 * t + r; bias[t] = bs[h * 128 + 32 * t + r];
#pragma unroll
            for (int g = 0; g < 4; ++g) gu[t][g] = *(const u32x2*)(GU + row * 512 + h * 128 + 32 * cht + 8 * g + 4 * hh); }
        SCHED_FENCE();
#pragma unroll
        for (int t = 0; t < 4; ++t) { const size_t row = (size_t)gc2 * 128 + 32 * t + r;
#pragma unroll
            for (int g = 0; g < 4; ++g) { const int ch = h * 128 + 32 * cht + 8 * g + 4 * hh; const u32x2 u = gu[t][g];
                u32x2 w; w.x = cvt2(bf2f(u.x & 0xffffu) * (acc[t][4 * g] + bias[t]), bf2f(u.x >> 16) * (acc[t][4 * g + 1] + bias[t])); w.y = cvt2(bf2f(u.y & 0xffffu) * (acc[t][4 * g + 2] + bias[t]), bf2f(u.y >> 16) * (acc[t][4 * g + 3] + bias[t]));
                *(u32x2*)(HS + row * D + 512 + ch) = w; } }
    }
}
__device__ __forceinline__ void ph_out(const Params& p, int l, int last, LAS unsigned char* lds, int lane, int wave, int G) {
    const bf16* QA = (const bf16*)(p.ws + WS_R + R_QA); const bf16* KB = (const bf16*)(p.ws + WS_R + R_KB); const bf16* VT = (const bf16*)(p.ws + WS_R + R_VT);
    const bf16* ST = (const bf16*)(p.ws + WS_R + R_ST); const bf16* SG = (const bf16*)(p.ws + WS_R + R_SG);
    bf16* HS = (bf16*)(p.ws + WS_HB); const float* gain = p.in[I_HGN] + l * 512;
    const int r = lane & 31, hh = lane >> 5;
    for (int it = vblk() * NWAVES + wave; it < NCH * 8; it += G * NWAVES) { const int gc = it >> 3, h = (it >> 1) & 3, ih = it & 1;
        if (last && (gc % 68) >= 64) continue;
        f32x16 o[4] = {zero16(), zero16(), zero16(), zero16()}; f32x16 Pd, Po;
#pragma unroll
        for (int dir = 0; dir < 2; ++dir) {
            const bf16* qp = QA + (size_t)dir * M * 512 + ((((size_t)(gc * 4 + h) * 2 + ih) * 8) * 64 + lane) * 8;
            const bf16* kd = KB + (size_t)dir * M * 512 + ((((size_t)(gc * 4 + h) * 2 + ih) * 8) * 64 + lane) * 8;
            const bf16* ko = KB + (size_t)dir * M * 512 + ((((size_t)(gc * 4 + h) * 2 + (1 - ih)) * 8) * 64 + lane) * 8;
            const bf16* sp = ST + (((size_t)gc * 2 + dir) * 4 + h) * 16384 + lane * 8;
            const bool off = (dir == 0) == (ih == 1);
            bf16x8 qa[8], ka[8], sa[8], sb[8];
#pragma unroll
            for (int s = 0; s < 8; ++s) { qa[s] = ld8(qp + s * 512); ka[s] = ld8(kd + s * 512); }
            if (off) {
#pragma unroll
                for (int s = 0; s < 8; ++s) sb[s] = ld8(ko + s * 512); }
            SCHED_FENCE();
            { f32x16 t = zero16();
#pragma unroll
              for (int s = 0; s < 8; ++s) t = MFMA32(ka[s], qa[s], t);
              SCHED_FENCE();
#pragma unroll
              for (int s = 0; s < 8; ++s) sa[s] = ld8(sp + (size_t)((s >> 1) * 4 + 0) * 1024 + 512 * (s & 1));
              SCHED_FENCE();
#pragma unroll
              for (int q = 0; q < 16; ++q) { const int j = (q & 3) + 8 * (q >> 2) + 4 * hh; const bool keep = dir == 0 ? (j <= r) : (j >= r); const float v = keep ? t[q] : 0.f; if (dir == 0) Pd[q] = v; else Pd[q] += v; } }
            if (off) { f32x16 t = zero16();
#pragma unroll
              for (int s = 0; s < 8; ++s) t = MFMA32(sb[s], qa[s], t);
              Po = t; }
#pragma unroll
            for (int et = 0; et < 4; ++et) {
                SCHED_FENCE();
                if (et < 3) {
#pragma unroll
                    for (int s = 0; s < 8; ++s) { const bf16x8 w = ld8(sp + (size_t)((s >> 1) * 4 + et + 1) * 1024 + 512 * (s & 1)); if (et & 1) sa[s] = w; else sb[s] = w; } }
                SCHED_FENCE();
#pragma unroll
                for (int s = 0; s < 8; ++s) o[et] = MFMA32((et & 1) ? sb[s] : sa[s], qa[s], o[et]);
            }
        }
        {
            const bf16* vp = VT + (((size_t)(gc * 4 + h) * 4 * 4) * 64 + r) * 8 + 4 * hh;
            bf16x8 va[4][4];
#pragma unroll
            for (int et = 0; et < 4; ++et)
#pragma unroll
                for (int k = 0; k < 4; ++k) { const bf16* v = vp + (size_t)(et * 4 + k) * 512; va[et][k] = ld44(v, v + 32 * 8); }
            SCHED_FENCE();
#pragma unroll
            for (int s = 0; s < 2; ++s) { const bf16x8 pd = pack_acc(Pd, s), po = pack_acc(Po, s);
#pragma unroll
                for (int et = 0; et < 4; ++et) { o[et] = MFMA32(ih ? va[et][2 + s] : va[et][s], pd, o[et]); o[et] = MFMA32(ih ? va[et][s] : va[et][2 + s], po, o[et]); } }
        }
        float ss = 0.f;
#pragma unroll
        for (int et = 0; et < 4; ++et)
#pragma unroll
            for (int q = 0; q < 16; ++q) ss += o[et][q] * o[et][q];
        ss += __shfl_xor(ss, 32);
        const float rs = rsqrtf(ss * (1.f / 128.f) + EPS);
        LAS unsigned char* img = lds + wave * 8704;
#pragma unroll
        for (int et = 0; et < 4; ++et)
#pragma unroll
            for (int g = 0; g < 4; ++g) { u32x2 w; w.x = cvt2(o[et][4 * g] * rs, o[et][4 * g + 1] * rs); w.y = cvt2(o[et][4 * g + 2] * rs, o[et][4 * g + 3] * rs);
                *(LAS u32x2*)(img + r * 272 + (32 * et + 8 * g + 4 * hh) * 2) = w; }
        asm volatile("s_waitcnt lgkmcnt(0)" ::: "memory");
        const int ck = lane & 15, rq = lane >> 4;
        const f32x4 g0 = *(const f32x4*)(gain + h * 128 + 8 * ck), g1 = *(const f32x4*)(gain + h * 128 + 8 * ck + 4);
        u32x4 sg[8], ov[8];
#pragma unroll
        for (int i = 0; i < 8; ++i) { const size_t row = (size_t)gc * 64 + 32 * ih + 4 * i + rq; sg[i] = *(const u32x4*)(SG + row * 512 + h * 128 + 8 * ck); ov[i] = *(const LAS u32x4*)(img + (4 * i + rq) * 272 + ck * 16); }
#pragma unroll
        for (int i = 0; i < 8; ++i) { const size_t row = (size_t)gc * 64 + 32 * ih + 4 * i + rq; const u32x4 a = ov[i], b = sg[i]; u32x4 w;
            w.x = cvt2(bf2f(a.x & 0xffffu) * g0[0] * bf2f(b.x & 0xffffu), bf2f(a.x >> 16) * g0[1] * bf2f(b.x >> 16)); w.y = cvt2(bf2f(a.y & 0xffffu) * g0[2] * bf2f(b.y & 0xffffu), bf2f(a.y >> 16) * g0[3] * bf2f(b.y >> 16));
            w.z = cvt2(bf2f(a.z & 0xffffu) * g1[0] * bf2f(b.z & 0xffffu), bf2f(a.z >> 16) * g1[1] * bf2f(b.z >> 16)); w.w = cvt2(bf2f(a.w & 0xffffu) * g1[2] * bf2f(b.w & 0xffffu), bf2f(a.w >> 16) * g1[3] * bf2f(b.w >> 16));
            *(u32x4*)(HS + row * D + h * 128 + 8 * ck) = w; }
        asm volatile("s_waitcnt lgkmcnt(0)" ::: "memory");
    }
}
#ifndef TIMING
#define TIMING 0
#endif
#ifndef TIMING_MASK
#define TIMING_MASK 0ull
#endif
#ifndef TIMING_MODE
#define TIMING_MODE 0
#endif
#ifndef TIMING_MUL
#define TIMING_MUL 4
#endif
constexpr int PH_PRO = 0, PH_H1 = 1, PH_L0 = 2, PH_PER_LAYER = 9, PH_END = PH_L0 + 2 * PH_PER_LAYER;
__device__ __forceinline__ void* launder_ptr(void* q) { unsigned long long v = (unsigned long long)q; asm volatile("" : "+s"(v)); return (void*)v; }
__global__ void __launch_bounds__(NTHREADS, 2) mk(Params p, int ph_lo, int ph_hi) {
    extern __shared__ __attribute__((aligned(16))) unsigned char lds_raw[];
    LAS unsigned char* lds = (LAS unsigned char*)lds_raw;
    constexpr int G = 256;
    unsigned char* const ws0 = p.ws; const int wave0 = __builtin_amdgcn_readfirstlane(threadIdx.x >> 6);
    cg::grid_group grid = cg::this_grid();
    if (threadIdx.x < 16) ((LAS unsigned*)(lds + LDS_BARST))[threadIdx.x] = 0u;
    __syncthreads();
    (void)xcd_barrier_post((unsigned*)(p.ws + WS_ZERO + Z_BAR), (volatile LAS unsigned*)(lds + LDS_BARST));
#if TIMING
    if (blockIdx.x == 0 && threadIdx.x == 0) ((LAS unsigned long long*)(lds + LDS_STAMP))[0] = __builtin_amdgcn_s_memrealtime();
#endif
    {
        const int tid0 = threadIdx.x;
        if (tid0 == 0) { const unsigned x = xb_xcc_id() & 7u; ((LAS int*)(lds + LDS_VBLK))[1] = (int)x; ((LAS int*)(lds + LDS_VBLK))[2] = (int)atomicAdd((unsigned*)(p.ws + WS_ZERO + Z_XC) + x, 1u); }
        ph_prologue(p, lds, tid0, tid0 & 63, wave0, G);
#if TIMING
        if (blockIdx.x == 0 && tid0 == 0) ((LAS unsigned long long*)(lds + LDS_STAMP))[32] = __builtin_amdgcn_s_memrealtime();
#endif
        grid.sync();
        if (tid0 == 0) {
            LAS int* vw = (LAS int*)(lds + LDS_VBLK); const unsigned* XC = (const unsigned*)(p.ws + WS_ZERO + Z_XC); const int myx = vw[1], myr = vw[2]; int vb = -1;
            if (myr < 32) vb = myr * 8 + myx;
            else { int o = myr - 32;
                for (int x = 0; x < myx; ++x) { const int c = (int)XC[x]; o += c > 32 ? c - 32 : 0; }
                for (int x = 0; x < 8 && vb < 0; ++x) { const int c = (int)XC[x] < 32 ? (int)XC[x] : 32, empty = 32 - c; if (o < empty) vb = (c + o) * 8 + x; else o -= empty; } }
            vw[0] = vb < 0 ? 0 : vb; }
        __syncthreads();
#if TIMING
        if (blockIdx.x == 0 && tid0 == 0) ((LAS unsigned long long*)(lds + LDS_STAMP))[1] = __builtin_amdgcn_s_memrealtime();
#endif
    }
    for (int ph = 1; ph < ph_hi; ++ph) {
        int zlane = 0; asm volatile("" : "+v"(zlane));
        const int tid = wave0 * 64 + (int)__builtin_amdgcn_mbcnt_hi(~0u, __builtin_amdgcn_mbcnt_lo(~0u, (unsigned)zlane));
        { size_t zoff = 0; asm volatile("" : "+s"(zoff)); p.ws = ws0 + zoff; }
        const int lane = tid & 63, wave = wave0;
        if (ph == PH_H1) ph_h1_first(p, lds, tid, lane, wave, G);
        else {
            const int l = (ph - PH_L0) / PH_PER_LAYER, s = (ph - PH_L0) % PH_PER_LAYER, last = l == 1;
            const float* modl = (const float*)(p.ws + WS_MOD) + (size_t)l * 9 * 6144;
            if (s == 0) {
                pg8::Gemm g{(const bf16*)(p.ws + WS_HB), (const bf16*)(p.ws + WS_WIN) + (size_t)l * INW * D, M, INW, D};
                pg8::DenseOrder S; S.init(M / 256, INW / 256, G, vblk(), 0);
                unsigned char* R = p.ws + WS_R;
                pg8::EpiInProj E{(bf16*)(R + R_QA), (bf16*)(R + R_KB), (bf16*)(R + R_KDT), (bf16*)(R + R_VT), (bf16*)(R + R_SG), (bf16*)(R + R_GU), (bf16*)(R + R_GVT), (float*)(R + R_EREF), (float*)(R + R_DEC),
                                 (float*)(p.ws + WS_ZERO + Z_SSV) + (size_t)l * M, (const float*)(p.ws + WS_LBV) + l * 1024, p.in[I_SGN] + l * 512, (size_t)M * 512, NCH};
                pg8::gemm_phase<pg8::EpiInProj, pg8::DenseOrder, true, true>(lds, g, S, E, tid);
            } else if (s == 1) { if (vblk() < 128) { scan_preload(p, lds, tid, vblk()); __syncthreads(); ph_scan(p, lds, lane, wave, vblk()); }
                else ph_sgu(p, l, lane, (vblk() - 128) * 8 + wave, 128 * 8); }
            else if (s == 2) ph_out(p, l, last, lds, lane, wave, G);
            else if (s == 3) {
                pg8::Gemm g{(const bf16*)(p.ws + WS_HB), (const bf16*)(p.ws + WS_WOUT) + (size_t)l * D * D, M, D, D};
                pg8::DenseOrder S; S.init(last ? NB * 16 : M / 256, D / 256, G, vblk(), last);
                pg8::EpiResid E{l == 0 ? p.in[I_X] : p.out, l == 0 ? p.in[I_CTX] : (const float*)(p.ws + WS_XC), p.out, (float*)(p.ws + WS_XC), modl, (float*)(p.ws + WS_ZERO + Z_SS2) + (size_t)l * M};
                pg8::gemm_phase<pg8::EpiResid, pg8::DenseOrder, true, true>(lds, g, S, E, tid);
                if (last) ph_moe_wconv(p, l, lds, lane, wave, vblk(), G); else if (vblk() >= 32) ph_moe_wconv(p, l, lds, lane, wave, vblk() - 32, G - 32);
            } else if (s == 4) ph_router(p, l, last, lds, tid, lane, wave, G);
            else if (s == 5) ph_place(p, l, last, lds, tid, lane, wave, G);
            else if (s == 6) {
                const int* TILE = (const int*)(p.ws + WS_TILE); const int nt = __builtin_amdgcn_readfirstlane(TILE[MT_MAX]);
                pg8::Gemm g{(const bf16*)(p.ws + WS_HB), (const bf16*)(p.ws + WS_R + R_WGU), M, 1024, D};
                pg8::MoeOrder S; S.init(TILE, nt, 4, G, vblk(), 4);
                pg8::EpiSwiglu E{(bf16*)(p.ws + WS_R + R_ACT)};
                LAS int* rm = (LAS int*)(lds + 131072);
                { const int* ROWMAP = (const int*)(p.ws + WS_R + R_BUF);
                  for (int i = 0; i < 5; ++i) { pg8::Unit uu; if (S.next(i, uu) && tid < 256) { const int v_ = ROWMAP[uu.pm * 256 + tid]; rm[i * 256 + tid] = (unsigned)v_ < (unsigned)M ? v_ : 0; } }
                  __syncthreads(); }
                pg8::gemm_phase<pg8::EpiSwiglu, pg8::MoeOrder, true, true, true>(lds, g, S, E, tid, rm);
            } else if (s == 7) {
                const int* TILE = (const int*)(p.ws + WS_TILE); const int nt = __builtin_amdgcn_readfirstlane(TILE[MT_MAX]);
                pg8::Gemm g{(const bf16*)(p.ws + WS_R + R_ACT), (const bf16*)(p.ws + WS_R + R_WD), NSLOT_PAD, D, DE};
                pg8::MoeOrder S; S.init(TILE, nt, 4, G, vblk(), 4);
                pg8::EpiStoreBf16 E{(bf16*)(p.ws + WS_R + R_Y), D};
                pg8::gemm_phase<pg8::EpiStoreBf16, pg8::MoeOrder, true, true>(lds, g, S, E, tid);
            } else ph_combine(p, l, last, lds, tid, lane, wave, G);
        }
#if TIMING
        if (blockIdx.x == 0 && tid == 0) ((LAS unsigned long long*)(lds + LDS_STAMP))[32 + ph] = __builtin_amdgcn_s_memrealtime();
#endif
        if (ph + 1 < ph_hi) { { XcdBarrier bar; bar.bar = (unsigned*)(p.ws + WS_ZERO + Z_BAR); bar.x = xb_xcc_id(); bar.st = (volatile LAS unsigned*)(lds + LDS_BARST); xcd_barrier(bar, tid); } }
#if TIMING
        if (blockIdx.x == 0 && tid == 0) ((LAS unsigned long long*)(lds + LDS_STAMP))[ph + 1] = __builtin_amdgcn_s_memrealtime();
#endif
    }
#if TIMING
    if (blockIdx.x == 0 && threadIdx.x == 0) {
        LAS unsigned long long* st = (LAS unsigned long long*)(lds + LDS_STAMP); unsigned long long tot = 0;
        for (int k = 0; k < PH_END; ++k) if ((TIMING_MASK >> k) & 1ull) tot += (TIMING_MODE ? st[32 + k] : st[k + 1]) - st[k];
        const unsigned long long t0 = __builtin_amdgcn_s_memrealtime();
        while (__builtin_amdgcn_s_memrealtime() - t0 < tot * TIMING_MUL) __builtin_amdgcn_s_sleep(8);
    }
#endif
}

extern "C" void kernel_launch(void* const* d_in, const int* in_sizes, int n_in, void* d_out, int out_size, void* d_ws, size_t ws_size, hipStream_t stream) {
    static int grid = 0;
    if (grid == 0) {
        if (n_in != 23 || ws_size < WS_END) { fprintf(stderr, "kernel_launch: n_in %d ws %zu need %zu\n", n_in, ws_size, (size_t)WS_END); grid = -1; return; }
        int dev = 0, cus = 0, per_cu = 0;
        hipGetDevice(&dev); hipDeviceGetAttribute(&cus, hipDeviceAttributeMultiprocessorCount, dev);
        hipFuncSetAttribute((const void*)mk, hipFuncAttributeMaxDynamicSharedMemorySize, LDS_BYTES);
        hipOccupancyMaxActiveBlocksPerMultiprocessor(&per_cu, (const void*)mk, NTHREADS, LDS_BYTES);
        (void)hipGetLastError();
        grid = cus * (per_cu >= 1 ? 1 : 0);
        if (grid != 256) { fprintf(stderr, "kernel_launch: occupancy %d cus %d\n", per_cu, cus); grid = -1; return; }
    }
    if (grid < 0) return;
    hipMemsetAsync((char*)d_ws + WS_ZERO, 0, ZERO_BYTES, stream);
    Params p{};
    for (int i = 0; i < 23; ++i) p.in[i] = (const float*)d_in[i];
    p.out = (float*)d_out; p.ws = (unsigned char*)d_ws;
    int lo = 0, hi = PH_END;
    void* args[] = {&p, &lo, &hi};
    hipError_t e = hipLaunchCooperativeKernel((const void*)mk, dim3(grid), dim3(NTHREADS), args, LDS_BYTES, stream);
    if (e != hipSuccess) fprintf(stderr, "cooperative launch failed: %s (grid %d)\n", hipGetErrorString(e), grid);
}
```

```cpp
#include <hip/hip_runtime.h>
#include <hip/hip_cooperative_groups.h>
#include <cstdio>
#include <cstdint>
namespace cg = cooperative_groups;

constexpr int D = 1024, NB = 8, SEQ = 4096, CL = 256, RB = SEQ + CL  , M = NB * RB  ;
constexpr int INW = 3584, NEXP = 32, DE = 512, NSLOT = M * 2, NSLOT_PAD = NSLOT + NEXP * 256, MT_MAX = NSLOT_PAD / 256;
constexpr float EPS = 1e-6f;

namespace pg8 {
#define PG8_LAS __attribute__((address_space(3)))
typedef unsigned short bf16_t;
typedef short bf16x8 __attribute__((ext_vector_type(8)));
typedef float f32x4 __attribute__((ext_vector_type(4)));
typedef unsigned u32x4 __attribute__((ext_vector_type(4)));
constexpr int BM = 256, BK = 64, HALF = 128, HTB = HALF * BK * 2  , STAGE_BYTES = 8 * HTB, NXCD = 8, WGM = 8;

__host__ __device__ __forceinline__ int lds_byte(int r, int c) { const int st = (r >> 4) * 2 + (c >> 5), rr = r & 15, cc = c & 31, ob = rr * 64 + cc * 2; return st * 1024 + (ob ^ (((ob >> 9) & 1) << 5)); }
__host__ __device__ __forceinline__ void stage_rc(int b, int& R, int& C) { const int st = b / 1024, sb = b % 1024, swz = sb ^ (((sb >> 9) & 1) << 5); R = (st >> 1) * 16 + swz / 64; C = (st & 1) * 32 + (swz % 64) / 2; }
__host__ __device__ __forceinline__ int perm32(int rho) { const int n = rho >> 4, i = rho & 15; return 8 * (i >> 2) + 4 * n + (i & 3); }

struct Unit { int pm, pn, pb; };
struct Gemm { const bf16_t* A; const bf16_t* Bt; int M, N, K; };

struct StaticOrder {
    int nM, nN, nwg, G, c;
    __host__ __device__ void init(int M, int N, int G_, int c_) { nM = M / BM; nN = N / BM; nwg = nM * nN; G = G_; c = c_; }
    __host__ __device__ bool next(int i, Unit& u) const {
        const long L = (long)i * G + c; if (L >= nwg) return false;
        int wgid = (int)L; { const int q = nwg / NXCD, r = nwg % NXCD, xcd = wgid % NXCD, off = wgid / NXCD; wgid = (xcd < r ? xcd * (q + 1) : r * (q + 1) + (xcd - r) * q) + off; }
        const int nig = WGM * nN, gid = wgid / nig, fm = gid * WGM, gsz = (nM - fm) < WGM ? (nM - fm) : WGM;
        u.pm = fm + ((wgid % nig) % gsz); u.pn = (wgid % nig) / gsz; u.pb = u.pn; return true;
    }
    __device__ __forceinline__ void a_ready(const Unit&) const {}
    __device__ __forceinline__ void done(const Unit&) const {}
};

__device__ __forceinline__ unsigned cvt_pk_bf16(float lo, float hi) { unsigned r; asm volatile("v_cvt_pk_bf16_f32 %0, %1, %2" : "=v"(r) : "v"(lo), "v"(hi)); return r; }
typedef float f32x2 __attribute__((ext_vector_type(2)));
struct DenseOrder {
    int nM, nN, nwg, G, c, lat_only;
    __device__ void init(int nM_, int nN_, int G_, int c_, int lat_only_) { nM = nM_; nN = nN_; nwg = nM * nN; G = G_; c = c_; lat_only = lat_only_; }
    __device__ bool next(int i, Unit& u) const {
        const long L = (long)i * G + c; if (L >= nwg) return false;
        int wgid = (int)L; { const int q = nwg / NXCD, r = nwg % NXCD, xcd = wgid % NXCD, off = wgid / NXCD; wgid = (xcd < r ? xcd * (q + 1) : r * (q + 1) + (xcd - r) * q) + off; }
        const int nig = WGM * nN, gid = wgid / nig, fm = gid * WGM, gsz = (nM - fm) < WGM ? (nM - fm) : WGM;
        int pm = fm + ((wgid % nig) % gsz); u.pn = (wgid % nig) / gsz; u.pb = u.pn;
        if (lat_only) pm = (pm >> 4) * 17 + (pm & 15);
        u.pm = pm; return true;
    }
    __device__ __forceinline__ void a_ready(const Unit&) const {}
    __device__ __forceinline__ void done(const Unit&) const {}
};
struct MoeOrder {
    const int* tile_e; int nM, nN, nwg, G, c, nbt;
    __device__ void init(const int* te, int nM_, int nN_, int G_, int c_, int nbt_) { tile_e = te; nM = nM_; nN = nN_; nwg = nM * nN; G = G_; c = c_; nbt = nbt_; }
    __device__ bool next(int i, Unit& u) const {
        const long L = (long)i * G + c; if (L >= nwg) return false;
        int wgid = (int)L; { const int q = nwg / NXCD, r = nwg % NXCD, xcd = wgid % NXCD, off = wgid / NXCD; wgid = (xcd < r ? xcd * (q + 1) : r * (q + 1) + (xcd - r) * q) + off; }
        const int nig = WGM * nN, gid = wgid / nig, fm = gid * WGM, gsz = (nM - fm) < WGM ? (nM - fm) : WGM;
        u.pm = fm + ((wgid % nig) % gsz); u.pn = (wgid % nig) / gsz;
        u.pb = __builtin_amdgcn_readfirstlane(tile_e[u.pm]) * nbt + u.pn; return true;
    }
    __device__ __forceinline__ void a_ready(const Unit&) const {}
    __device__ __forceinline__ void done(const Unit&) const {}
};

__device__ __forceinline__ float fast_silu(float x) { return x * __builtin_amdgcn_rcpf(1.f + __expf(-x)); }
struct EpiStoreBf16 {
    static constexpr bool PERM = true, AFTER_DRAIN = false;
    bf16_t* O; int ldc;
    __device__ __forceinline__ void operator()(const f32x4 (&acc)[2][2][4][2], const Unit& u, int wr, int wc, int fr, int fq) const {
        const int row0 = u.pm * BM + wr * 64 + fr, col0 = u.pn * BM + wc * 32 + 8 * fq;
#pragma unroll
        for (int ai = 0; ai < 2; ++ai)
#pragma unroll
            for (int m = 0; m < 4; ++m) { bf16_t* rowp = O + (size_t)(row0 + ai * HALF + m * 16) * ldc + col0;
#pragma unroll
                for (int bj = 0; bj < 2; ++bj) { const f32x4 v0 = acc[ai][bj][m][0], v1 = acc[ai][bj][m][1];
                    u32x4 w; w.x = cvt_pk_bf16(v0[0], v0[1]); w.y = cvt_pk_bf16(v0[2], v0[3]); w.z = cvt_pk_bf16(v1[0], v1[1]); w.w = cvt_pk_bf16(v1[2], v1[3]);
                    *(u32x4*)(rowp + bj * HALF) = w; } }
    }
};
struct EpiSwiglu {
    static constexpr bool PERM = true, AFTER_DRAIN = false;
    bf16_t* ACT;
    __device__ __forceinline__ void operator()(const f32x4 (&acc)[2][2][4][2], const Unit& u, int wr, int wc, int fr, int fq) const {
        const int row0 = u.pm * BM + wr * 64 + fr, col0 = u.pn * HALF + wc * 32 + 8 * fq;
#pragma unroll
        for (int ai = 0; ai < 2; ++ai)
#pragma unroll
            for (int m = 0; m < 4; ++m) { bf16_t* rowp = ACT + (size_t)(row0 + ai * HALF + m * 16) * DE + col0;
                const f32x4 g0 = acc[ai][0][m][0], g1 = acc[ai][0][m][1], u0 = acc[ai][1][m][0], u1 = acc[ai][1][m][1];
                u32x4 w; w.x = cvt_pk_bf16(fast_silu(g0[0]) * u0[0], fast_silu(g0[1]) * u0[1]); w.y = cvt_pk_bf16(fast_silu(g0[2]) * u0[2], fast_silu(g0[3]) * u0[3]);
                w.z = cvt_pk_bf16(fast_silu(g1[0]) * u1[0], fast_silu(g1[1]) * u1[1]); w.w = cvt_pk_bf16(fast_silu(g1[2]) * u1[2], fast_silu(g1[3]) * u1[3]);
                *(u32x4*)rowp = w; }
    }
};
#define DPP_F(x, ctrl) __uint_as_float((unsigned)__builtin_amdgcn_update_dpp(0, (int)__float_as_uint(x), (ctrl), 0xf, 0xf, false))
__device__ __forceinline__ float row_allsum16(float x) { x += DPP_F(x, 0xB1); x += DPP_F(x, 0x4E); x += DPP_F(x, 0x141); x += DPP_F(x, 0x140); return x; }
__device__ __forceinline__ float row_incl_scan16(float x) { x += DPP_F(x, 0x111); x += DPP_F(x, 0x112); x += DPP_F(x, 0x114); x += DPP_F(x, 0x118); return x; }
__device__ __forceinline__ float fast_sigmoid(float x) { return __builtin_amdgcn_rcpf(1.f + __expf(-x)); }
__device__ __forceinline__ float fast_gelu(float x) { return x * fast_sigmoid(1.5957691216057308f * (x + 0.044715f * x * x * x)); }
__device__ __forceinline__ bf16_t bf16_1(float x) { return (bf16_t)(cvt_pk_bf16(x, 0.f) & 0xffffu); }
struct EpiInProj {
    static constexpr bool PERM = true, AFTER_DRAIN = false;
    bf16_t *QA, *KB, *KDT, *VT, *SG, *GU, *GVT; float *EREF, *DEC, *SSV; const float* LBV; const float* vgain; size_t dstride; int nch;
    __device__ __forceinline__ void operator()(const f32x4 (&acc)[2][2][4][2], const Unit& u, int wr, int wc, int fr, int fq) const {
        if (u.pn < 8) hgrn(acc, u, wr, wc, fr, fq); else if (u.pn < 12) actv(acc, u, wr, wc, fr, fq); else vtile(acc, u, wr, wc, fr, fq);
    }
    __device__ __forceinline__ void hgrn(const f32x4 (&acc)[2][2][4][2], const Unit& u, int wr, int wc, int fr, int fq) const {
        const int h = u.pn >> 1, dloc = (u.pn & 1) * 64 + 16 * wc + 4 * fq, dcol = h * 128 + dloc;
        const f32x4 lbf = *(const f32x4*)(LBV + dcol), lbb = *(const f32x4*)(LBV + 512 + dcol);
#pragma unroll
        for (int ai = 0; ai < 2; ++ai) {
            const int rowc = u.pm * BM + ai * HALF + wr * 64, gc = rowc >> 6;
            const size_t cb = ((size_t)(gc * 4 + h) * 4 + (dloc >> 5)) * 4;
            const int cl = ((dloc & 31) + 32 * (fr >> 3)) * 8 + (fr & 7);
            unsigned pqa[2][4][2], pkb[2][4][2]; float hqa[2][4], hkb[2][4];
#pragma unroll
            for (int e = 0; e < 4; ++e) {
#pragma unroll
                for (int dir = 0; dir < 2; ++dir) {
                    const float lb = dir ? lbb[e] : lbf[e];
                    float lf[4], kk[4], x[4], T[4];
#pragma unroll
                    for (int m = 0; m < 4; ++m) { const float z = dir ? acc[ai][1][m][0][e] : acc[ai][0][m][1][e]; const float sig = fast_sigmoid(z);
                        lf[m] = __logf(lb + (1.f - lb) * sig); kk[m] = (1.f - lb) * (1.f - sig); x[m] = lf[m]; }
#pragma unroll
                    for (int m = 0; m < 4; ++m) { T[m] = row_allsum16(x[m]); x[m] = row_incl_scan16(x[m]); }
                    const float t01 = T[0] + T[1], tot = t01 + T[2] + T[3];
                    float cum[4] = {x[0], x[1] + T[0], x[2] + t01, x[3] + t01 + T[2]}; float ref = t01;
                    if (dir) {
#pragma unroll
                        for (int m = 0; m < 4; ++m) cum[m] = tot - cum[m] + lf[m];
                        ref = tot - t01; }
                    const float etr = __expf(tot - ref);
#pragma unroll
                    for (int m = 0; m < 4; ++m) { const float q = acc[ai][0][m][0][e];
                        const float qa = q * __expf(cum[m] - ref), kb = kk[m] * __expf(ref - cum[m]), kd = kb * etr;
                        KDT[dir * dstride + ((cb + m) * 64) * 8 + cl + 8 * e] = bf16_1(kd);
                        if (e & 1) { pqa[dir][m][e >> 1] = cvt_pk_bf16(hqa[dir][m], qa); pkb[dir][m][e >> 1] = cvt_pk_bf16(hkb[dir][m], kb); } else { hqa[dir][m] = qa; hkb[dir][m] = kb; } }
                    if (fr == 0) { EREF[((size_t)dir * nch + gc) * 512 + dcol + e] = __expf(ref); DEC[((size_t)dir * nch + gc) * 512 + dcol + e] = __expf(tot); }
                }
#pragma unroll
                for (int m = 0; m < 4; ++m) VT[((cb + m) * 64) * 8 + cl + 8 * e] = bf16_1(acc[ai][1][m][1][e]);
            }
#pragma unroll
            for (int dir = 0; dir < 2; ++dir)
#pragma unroll
                for (int m = 0; m < 4; ++m) {
                    const size_t o = dir * dstride + (((((size_t)(gc * 4 + h) * 2 + (m >> 1)) * 8 + (dloc >> 4)) * 64) + 16 * (m & 1) + fr + 32 * (fq & 1)) * 8 + 4 * (fq >> 1);
                    typedef unsigned u32x2v __attribute__((ext_vector_type(2)));
                    *(u32x2v*)(QA + o) = (u32x2v){pqa[dir][m][0], pqa[dir][m][1]}; *(u32x2v*)(KB + o) = (u32x2v){pkb[dir][m][0], pkb[dir][m][1]}; }
        }
    }
    __device__ __forceinline__ void actv(const f32x4 (&acc)[2][2][4][2], const Unit& u, int wr, int wc, int fr, int fq) const {
        const bool isu = u.pn >= 10; bf16_t* O = isu ? GU : SG;
        const int row0 = u.pm * BM + wr * 64 + fr, col0 = (u.pn & 1) * 256 + wc * 32 + 8 * fq;
#pragma unroll
        for (int ai = 0; ai < 2; ++ai)
#pragma unroll
            for (int m = 0; m < 4; ++m) { bf16_t* rowp = O + (size_t)(row0 + ai * HALF + m * 16) * 512 + col0;
#pragma unroll
                for (int bj = 0; bj < 2; ++bj) { float v[8];
#pragma unroll
                    for (int i = 0; i < 8; ++i) { const float x = acc[ai][bj][m][i >> 2][i & 3]; v[i] = isu ? fast_gelu(x) : x * fast_sigmoid(x); }
                    u32x4 w; w.x = cvt_pk_bf16(v[0], v[1]); w.y = cvt_pk_bf16(v[2], v[3]); w.z = cvt_pk_bf16(v[4], v[5]); w.w = cvt_pk_bf16(v[6], v[7]);
                    *(u32x4*)(rowp + bj * HALF) = w; } }
    }
    __device__ __forceinline__ void vtile(const f32x4 (&acc)[2][2][4][2], const Unit& u, int wr, int wc, int fr, int fq) const {
        const int ch0 = (u.pn & 1) * 256 + wc * 32 + 8 * fq;
        f32x4 gn[2][2];
#pragma unroll
        for (int bj = 0; bj < 2; ++bj)
#pragma unroll
            for (int n = 0; n < 2; ++n) gn[bj][n] = *(const f32x4*)(vgain + ch0 + bj * HALF + 4 * n);
#pragma unroll
        for (int ai = 0; ai < 2; ++ai) { const int gc2 = u.pm * 2 + ai;
#pragma unroll
            for (int m = 0; m < 4; ++m) { const int tok = wr * 64 + 16 * m + fr; float s = 0.f;
#pragma unroll
                for (int bj = 0; bj < 2; ++bj)
#pragma unroll
                    for (int n = 0; n < 2; ++n)
#pragma unroll
                        for (int e = 0; e < 4; ++e) { const float g = fast_gelu(acc[ai][bj][m][n][e]); s += g * g;
                            GVT[(((((size_t)(gc2 * 4 + 2 * (u.pn & 1) + bj) * 4 + wc) * 8 + (tok >> 4)) * 64) + 8 * fq + 4 * n + e + 32 * (fr >> 3)) * 8 + (fr & 7)] = bf16_1(g * gn[bj][n][e]); }
                s += __shfl_xor(s, 16); s += __shfl_xor(s, 32);
                if (fq == 0) atomicAdd(SSV + gc2 * 128 + tok, s); } }
    }
};
struct EpiResid {
    static constexpr bool PERM = false, AFTER_DRAIN = false;
    const float* src_lat; const float* src_ctx; float* dst_lat; float* dst_ctx; const float* modl; float* ss;
    __device__ __forceinline__ void operator()(const f32x4 (&acc)[2][2][4][2], const Unit& u, int wr, int wc, int fr, int fq) const {
        const int b = u.pm / 17, j = u.pm % 17; const bool isctx = j == 16;
        const size_t trow = isctx ? (size_t)b * CL : (size_t)b * SEQ + (size_t)j * 256;
        const float* sb = (isctx ? src_ctx : src_lat) + trow * D; float* db = (isctx ? dst_ctx : dst_lat) + trow * D;
        const float* g1 = modl + (size_t)(isctx ? 8 : b) * 6144 + 2 * 1024;
        const int col0 = u.pn * BM + wc * 32 + 4 * fq;
        f32x4 gv[2][2];
#pragma unroll
        for (int bj = 0; bj < 2; ++bj)
#pragma unroll
            for (int n = 0; n < 2; ++n) gv[bj][n] = *(const f32x4*)(g1 + col0 + bj * HALF + n * 16);
#pragma unroll
        for (int ai = 0; ai < 2; ++ai) {
            f32x4 xs[4][2][2];
#pragma unroll
            for (int m = 0; m < 4; ++m) { const size_t off = (size_t)(ai * HALF + wr * 64 + m * 16 + fr) * D + col0;
#pragma unroll
                for (int bj = 0; bj < 2; ++bj)
#pragma unroll
                    for (int n = 0; n < 2; ++n) xs[m][bj][n] = *(const f32x4*)(sb + off + bj * HALF + n * 16); }
            __builtin_amdgcn_sched_barrier(0);
#pragma unroll
            for (int m = 0; m < 4; ++m) { const int rt = ai * HALF + wr * 64 + m * 16 + fr; const size_t off = (size_t)rt * D + col0; float s = 0.f;
#pragma unroll
                for (int bj = 0; bj < 2; ++bj)
#pragma unroll
                    for (int n = 0; n < 2; ++n) { const f32x4 o = xs[m][bj][n] + gv[bj][n] * acc[ai][bj][m][n];
                        *(f32x4*)(db + off + bj * HALF + n * 16) = o; s += (o[0] * o[0] + o[1] * o[1]) + (o[2] * o[2] + o[3] * o[3]); }
                s += __shfl_xor(s, 16); s += __shfl_xor(s, 32);
                if (fq == 0) atomicAdd(ss + u.pm * BM + rt, s); } }
    }
};
template <class Epi, class Sched, bool ALIGN_EPI = false, bool SP2 = false, bool GATHER = false>
__device__ __forceinline__ void gemm_phase(PG8_LAS unsigned char* lds, const Gemm g, const Sched& S, const Epi& E, const int tid_in, const PG8_LAS int* rmap = nullptr) {
    const int tid = tid_in, wid = __builtin_amdgcn_readfirstlane(tid >> 6), lane = tid & 63, wr = wid >> 2, wc = wid & 3, fr = lane & 15, fq = lane >> 4;
    const int K = g.K, nt = K / BK;
    unsigned voffA[2], voffB[2]; int gR[2], gC[2];
#pragma unroll
    for (int i = 0; i < 2; ++i) { int R, C; stage_rc(tid * 16 + i * 8192, R, C); const int Rb = Epi::PERM ? ((R & ~31) + perm32(R & 31)) : R;
        voffA[i] = (unsigned)(R * K + C) * 2u; voffB[i] = (unsigned)(Rb * K + C) * 2u; gR[i] = R; gC[i] = C; }
    unsigned vA0[2] = {voffA[0], voffA[1]}, vA1[2] = {voffA[0], voffA[1]}, nV0[2] = {voffA[0], voffA[1]}, nV1[2] = {voffA[0], voffA[1]};
#define PG8_GOFF(slot, o0, o1) do { const PG8_LAS int* _rm = rmap + (slot) * 256; _Pragma("unroll") for (int _i = 0; _i < 2; ++_i) { \
        o0[_i] = ((unsigned)_rm[gR[_i]] * (unsigned)K + (unsigned)gC[_i]) * 2u; o1[_i] = ((unsigned)_rm[128 + gR[_i]] * (unsigned)K + (unsigned)gC[_i]) * 2u; } } while (0)
    const size_t kstep = (size_t)(BK * 2);
    const size_t hstep = (size_t)HALF * K * 2;
    const size_t tstep = 2 * hstep;
    const size_t hstepA = GATHER ? 0 : hstep, tstepA = GATHER ? 0 : tstep;
    const unsigned ldsw = (unsigned)wid * 1024u;
    const int aoff = lds_byte(wr * 64 + fr, fq * 8), boff = lds_byte(wc * 32 + fr, fq * 8);
#define PG8_SA(b, h) (((b) * 2 + (h)) * HTB)
#define PG8_SB(b, h) ((4 + (b) * 2 + (h)) * HTB)
#define PG8_STAGE(bufoff, gbase, voff) do { _Pragma("unroll") for (int _i = 0; _i < 2; ++_i) \
        __builtin_amdgcn_global_load_lds((const unsigned*)((const char*)(gbase) + (voff)[_i]), (PG8_LAS unsigned*)(lds + (bufoff) + ldsw + _i * 8192), 16, 0, 0); } while (0)
#define PG8_LDA(dst, b, h) do { _Pragma("unroll") for (int m = 0; m < 4; ++m) _Pragma("unroll") for (int k = 0; k < 2; ++k) dst[m][k] = *(const PG8_LAS bf16x8*)(lds + PG8_SA(b, h) + aoff + m * 2048 + k * 1024); } while (0)
#define PG8_LDB(dst, b, h) do { _Pragma("unroll") for (int n = 0; n < 2; ++n) _Pragma("unroll") for (int k = 0; k < 2; ++k) dst[n][k] = *(const PG8_LAS bf16x8*)(lds + PG8_SB(b, h) + boff + n * 2048 + k * 1024); } while (0)
#define PG8_MMA(ai, bj, At, Bt) do { __builtin_amdgcn_s_setprio(1); _Pragma("unroll") for (int m = 0; m < 4; ++m) _Pragma("unroll") for (int n = 0; n < 2; ++n) _Pragma("unroll") for (int k = 0; k < 2; ++k) \
        acc[ai][bj][m][n] = __builtin_amdgcn_mfma_f32_16x16x32_bf16(Bt[n][k], At[m][k], acc[ai][bj][m][n], 0, 0, 0); __builtin_amdgcn_s_setprio(0); } while (0)
#define PG8_WAIT_V(n) asm volatile("s_waitcnt vmcnt(" #n ")" ::: "memory")
#define PG8_WAIT_L(n) asm volatile("s_waitcnt lgkmcnt(" #n ")" ::: "memory")
#define PG8_BAR __builtin_amdgcn_s_barrier()
#define PG8_SCHED __builtin_amdgcn_sched_barrier(0)
    Unit cur, nxt; int ui = 0;
    if (!S.next(0, cur)) return;
    f32x4 acc[2][2][4][2];
#pragma unroll
    for (int a = 0; a < 2; ++a)
#pragma unroll
        for (int b = 0; b < 2; ++b)
#pragma unroll
            for (int m = 0; m < 4; ++m)
#pragma unroll
                for (int n = 0; n < 2; ++n) acc[a][b][m][n] = (f32x4){0.f, 0.f, 0.f, 0.f};
    bf16x8 At[4][2], B0[2][2], B1[2][2];
    const char* cA = (const char*)g.A + (size_t)cur.pm * tstepA; const char* cB = (const char*)g.Bt + (size_t)cur.pb * tstep;
    if constexpr (GATHER) PG8_GOFF(0, vA0, vA1);
    S.a_ready(cur);
    if constexpr (SP2) {
        PG8_STAGE(PG8_SB(0, 0), cB, voffB); PG8_STAGE(PG8_SB(0, 1), cB + hstep, voffB); PG8_STAGE(PG8_SA(0, 0), cA, vA0); PG8_STAGE(PG8_SA(0, 1), cA + hstepA, vA1);
        if (wr == 1) PG8_BAR;
        PG8_WAIT_V(2); PG8_BAR;
        PG8_STAGE(PG8_SB(1, 0), cB + kstep, voffB); PG8_STAGE(PG8_SA(1, 0), cA + kstep, vA0); PG8_STAGE(PG8_SB(1, 1), cB + hstep + kstep, voffB);
        PG8_WAIT_V(6); PG8_BAR;
    } else {
        PG8_STAGE(PG8_SB(0, 0), cB, voffB); PG8_STAGE(PG8_SA(0, 0), cA, voffA); PG8_STAGE(PG8_SB(0, 1), cB + hstep, voffB); PG8_STAGE(PG8_SA(0, 1), cA + hstep, voffA);
        if (wr == 1) PG8_BAR;
        PG8_WAIT_V(4); PG8_BAR;
        PG8_STAGE(PG8_SB(1, 0), cB + kstep, voffB); PG8_STAGE(PG8_SA(1, 0), cA + kstep, voffA); PG8_STAGE(PG8_SB(1, 1), cB + hstep + kstep, voffB);
        PG8_WAIT_V(6); PG8_BAR;
    }
    for (;;) {
        const bool has_next = S.next(ui + 1, nxt);
        const char* nA = has_next ? (const char*)g.A + (size_t)nxt.pm * tstepA : cA; const char* nB = has_next ? (const char*)g.Bt + (size_t)nxt.pb * tstep : cB;
        if constexpr (GATHER) { if (has_next) PG8_GOFF(ui + 1, nV0, nV1); else { nV0[0] = vA0[0]; nV0[1] = vA0[1]; nV1[0] = vA1[0]; nV1[1] = vA1[1]; } }
        for (int t = 0; t < nt; t += 2) {
            const bool last = (t == nt - 2);
            const char* a1 = cA + (size_t)(t + 1) * kstep;
            const char* a2 = last ? nA : cA + (size_t)(t + 2) * kstep; const char* b2 = last ? nB : cB + (size_t)(t + 2) * kstep;
            const char* a3 = a2 + kstep; const char* b3 = b2 + kstep;
            const unsigned sA0[2] = {last ? nV0[0] : vA0[0], last ? nV0[1] : vA0[1]}, sA1[2] = {last ? nV1[0] : vA1[0], last ? nV1[1] : vA1[1]};
            if (last && has_next) S.a_ready(nxt);
            if constexpr (SP2) {
            PG8_LDB(B0, 0, 0); PG8_LDB(B1, 0, 1); PG8_SCHED; PG8_LDA(At, 0, 0); PG8_STAGE(PG8_SA(1, 1), a1 + hstepA, vA1);
            PG8_WAIT_V(8); PG8_WAIT_L(0); PG8_BAR; PG8_MMA(0, 0, At, B0); PG8_MMA(0, 1, At, B1); PG8_BAR; PG8_SCHED;
            PG8_LDA(At, 0, 1); PG8_STAGE(PG8_SB(0, 0), b2, voffB); PG8_STAGE(PG8_SB(0, 1), b2 + hstep, voffB); PG8_STAGE(PG8_SA(0, 0), a2, sA0);
            PG8_WAIT_V(8); PG8_WAIT_L(0); PG8_BAR; PG8_MMA(1, 0, At, B0); PG8_MMA(1, 1, At, B1); PG8_BAR; PG8_SCHED;
            PG8_LDB(B0, 1, 0); PG8_LDB(B1, 1, 1); PG8_SCHED; PG8_LDA(At, 1, 0); PG8_STAGE(PG8_SA(0, 1), a2 + hstepA, sA1);
            PG8_WAIT_V(8); PG8_WAIT_L(0); PG8_BAR; PG8_MMA(0, 0, At, B0); PG8_MMA(0, 1, At, B1); PG8_BAR; PG8_SCHED;
            PG8_LDA(At, 1, 1); PG8_STAGE(PG8_SB(1, 0), b3, voffB); PG8_STAGE(PG8_SB(1, 1), b3 + hstep, voffB); PG8_STAGE(PG8_SA(1, 0), a3, sA0);
            PG8_WAIT_V(8); PG8_WAIT_L(0); PG8_BAR; PG8_MMA(1, 0, At, B0); PG8_MMA(1, 1, At, B1); PG8_BAR; PG8_SCHED;
            } else {
            PG8_LDB(B0, 0, 0); PG8_SCHED; PG8_LDA(At, 0, 0); PG8_STAGE(PG8_SA(1, 1), a1 + hstep, voffA);
            PG8_WAIT_L(8); PG8_BAR; PG8_WAIT_L(0); PG8_MMA(0, 0, At, B0); PG8_BAR; PG8_SCHED;
            PG8_LDB(B1, 0, 1); PG8_STAGE(PG8_SB(0, 0), b2, voffB);
            PG8_BAR; PG8_WAIT_L(0); PG8_MMA(0, 1, At, B1); PG8_BAR;
            PG8_LDA(At, 0, 1); PG8_STAGE(PG8_SA(0, 0), a2, voffA);
            PG8_BAR; PG8_WAIT_L(0); PG8_MMA(1, 0, At, B0); PG8_BAR; PG8_SCHED;
            PG8_STAGE(PG8_SB(0, 1), b2 + hstep, voffB);
            PG8_WAIT_V(6); PG8_BAR; PG8_MMA(1, 1, At, B1); PG8_BAR;
            PG8_LDB(B0, 1, 0); PG8_SCHED; PG8_LDA(At, 1, 0); PG8_STAGE(PG8_SA(0, 1), a2 + hstep, voffA);
            PG8_WAIT_L(8); PG8_BAR; PG8_WAIT_L(0); PG8_MMA(0, 0, At, B0); PG8_BAR; PG8_SCHED;
            PG8_LDB(B1, 1, 1); PG8_STAGE(PG8_SB(1, 0), b3, voffB);
            PG8_BAR; PG8_WAIT_L(0); PG8_MMA(0, 1, At, B1); PG8_BAR;
            PG8_LDA(At, 1, 1); PG8_STAGE(PG8_SA(1, 0), a3, voffA);
            PG8_BAR; PG8_WAIT_L(0); PG8_MMA(1, 0, At, B0); PG8_BAR; PG8_SCHED;
            PG8_STAGE(PG8_SB(1, 1), b3 + hstep, voffB);
            PG8_WAIT_V(6); PG8_BAR; PG8_MMA(1, 1, At, B1); PG8_BAR;
            }
        }
        if constexpr (ALIGN_EPI) { if (wr == 0) PG8_BAR; }
        if constexpr (!Epi::AFTER_DRAIN) { E(acc, cur, wr, wc, fr, fq); S.done(cur); }
        if (!has_next) break;
#pragma unroll
        for (int a = 0; a < 2; ++a)
#pragma unroll
            for (int b = 0; b < 2; ++b)
#pragma unroll
                for (int m = 0; m < 4; ++m)
#pragma unroll
                    for (int n = 0; n < 2; ++n) acc[a][b][m][n] = (f32x4){0.f, 0.f, 0.f, 0.f};
        cur = nxt; cA = nA; cB = nB; ++ui;
        if constexpr (GATHER) { vA0[0] = nV0[0]; vA0[1] = nV0[1]; vA1[0] = nV1[0]; vA1[1] = nV1[1]; }
        if constexpr (ALIGN_EPI) { if (wr == 1) PG8_BAR; }
    }
    PG8_WAIT_V(0);
    if constexpr (!ALIGN_EPI) { if (wr == 0) PG8_BAR; }
    PG8_BAR;
    if constexpr (Epi::AFTER_DRAIN) { E.fused(acc, cur, wr, wc, fr, fq, lds, wid, lane); S.done(cur); }
#undef PG8_GOFF
#undef PG8_SA
#undef PG8_SB
#undef PG8_STAGE
#undef PG8_LDA
#undef PG8_LDB
#undef PG8_MMA
#undef PG8_WAIT_V
#undef PG8_WAIT_L
#undef PG8_BAR
#undef PG8_SCHED
}
}

#define LAS __attribute__((address_space(3)))
typedef unsigned short bf16;
typedef float f32x4 __attribute__((ext_vector_type(4)));
typedef unsigned u32x4 __attribute__((ext_vector_type(4)));
typedef unsigned u32x2 __attribute__((ext_vector_type(2)));
constexpr int NWAVES = 8, NTHREADS = 512, LDS_BYTES = 160 * 1024;
#define SCHED_FENCE() __builtin_amdgcn_sched_barrier(0)

__device__ __forceinline__ unsigned f2bf(float f) { unsigned u = __float_as_uint(f); return (u + 0x7fffu + ((u >> 16) & 1u)) >> 16; }
__device__ __forceinline__ unsigned pk2(float lo, float hi) { return f2bf(lo) | (f2bf(hi) << 16); }
__device__ __forceinline__ unsigned cvt2(float lo, float hi) { return pg8::cvt_pk_bf16(lo, hi); }
__device__ __forceinline__ float bf2f(unsigned h) { return __uint_as_float(h << 16); }
#define DPPF(x, ctrl) __uint_as_float((unsigned)__builtin_amdgcn_update_dpp(0, (int)__float_as_uint(x), (ctrl), 0xf, 0xf, false))
__device__ __forceinline__ float wave_sum(float v) {
    v += DPPF(v, 0xB1); v += DPPF(v, 0x4E); v += DPPF(v, 0x141); v += DPPF(v, 0x140);
    const float s0 = __uint_as_float(__builtin_amdgcn_readlane(__float_as_uint(v), 0)), s1 = __uint_as_float(__builtin_amdgcn_readlane(__float_as_uint(v), 16));
    const float s2 = __uint_as_float(__builtin_amdgcn_readlane(__float_as_uint(v), 32)), s3 = __uint_as_float(__builtin_amdgcn_readlane(__float_as_uint(v), 48));
    return (s0 + s1) + (s2 + s3);
}
__device__ __forceinline__ float siluf(float x) { return x / (1.f + expf(-x)); }
__device__ __forceinline__ float gelu_tanh(float x) { return 0.5f * x * (1.f + tanhf(0.7978845608028654f * (x + 0.044715f * x * x * x))); }
__device__ __forceinline__ int mod_row(int row) { return ((row % RB) < SEQ) ? row / RB : 8; }
__device__ __forceinline__ bool is_ctx_row(int row) { return (row % RB) >= SEQ; }

typedef __attribute__((address_space(1))) unsigned gu32;
#define RLX_AGENT __ATOMIC_RELAXED, __HIP_MEMORY_SCOPE_AGENT
#define XB_TMO      128
#define XB_XCNT(j)  (256  + 64 * (j))
#define XB_XSUB(j)  (1280 + 64 * (j))
#define XB_XGEN(j)  (2304 + 64 * (j))
#define XB_TOP      3328
#define XB_TOPGEN   3392
#define XCD_BAR_WORDS 3456
#define XB_SPIN_CAP (1u << 18)

__device__ __forceinline__ unsigned xb_ld(unsigned* p)              { return __hip_atomic_load(p, __ATOMIC_RELAXED, __HIP_MEMORY_SCOPE_AGENT); }
__device__ __forceinline__ unsigned xb_add(unsigned* p, unsigned v) { return __hip_atomic_fetch_add(p, v, __ATOMIC_RELAXED, __HIP_MEMORY_SCOPE_AGENT); }
__device__ __forceinline__ unsigned xb_xcc_id() { return (unsigned)__builtin_amdgcn_s_getreg((3 << 11) | 20) & 0xFu; }
#define XB_SPIN(cond, bar) do { unsigned _sp = 0; while (cond) { __builtin_amdgcn_s_sleep(1); \
    if ((++_sp & 255u) == 0u) { if (xb_ld(&(bar)[XB_TMO])) break; if (_sp > XB_SPIN_CAP) { atomicAdd(&(bar)[XB_TMO], 1u); break; } } } } while (0)

struct XcdBarrier {
    unsigned* bar; unsigned x;
    volatile LAS unsigned* st;
};

__device__ __forceinline__ XcdBarrier xcd_barrier_post(unsigned* bar, volatile LAS unsigned* st) {
    XcdBarrier b; b.bar = bar; b.x = xb_xcc_id(); b.st = st;
    if (threadIdx.x == 0) (void)xb_add(&bar[XB_XCNT(b.x)], 1u);
    return b;
}
__device__ __forceinline__ void xcd_barrier_complete(unsigned* bar, unsigned x, unsigned& nloc, unsigned& nx) {
    const unsigned G = gridDim.x * gridDim.y * gridDim.z;
    unsigned sum, cnt, mine, sp = 0u;
    for (;;) {
        sum = 0u; cnt = 0u; mine = 0u;
#pragma unroll
        for (unsigned j = 0; j < 16; ++j) { const unsigned c = xb_ld(&bar[XB_XCNT(j)]); sum += c; cnt += (c > 0u) ? 1u : 0u; mine = (j == x) ? c : mine; }
        if (sum == G) break;
        __builtin_amdgcn_s_sleep(1);
        if ((++sp & 255u) == 0u) { if (xb_ld(&bar[XB_TMO])) break; if (sp > XB_SPIN_CAP) { atomicAdd(&bar[XB_TMO], 1u); break; } }
    }
    nloc = mine > 0u ? mine : 1u; nx = cnt > 0u ? cnt : 1u;
}

__device__ __forceinline__ void xcd_barrier(const XcdBarrier& b, const int xb_tid) {
    asm volatile("s_waitcnt vmcnt(0)" ::: "memory");
    __syncthreads();
    if (xb_tid == 0) {
        unsigned* bar = b.bar;
        __builtin_amdgcn_s_waitcnt(0);
        unsigned nloc = b.st[0], nx = b.st[1];
        if (nloc == 0u) { xcd_barrier_complete(bar, b.x, nloc, nx); b.st[0] = nloc; b.st[1] = nx; }
        const unsigned old = xb_add(&bar[XB_XSUB(b.x)], 1u);
        const unsigned gen = old / nloc;
        if (old + 1u == (gen + 1u) * nloc) {
            __builtin_amdgcn_fence(__ATOMIC_RELEASE, "agent");
            asm volatile("s_waitcnt vmcnt(0)" ::: "memory");
            const unsigned og = xb_add(&bar[XB_TOP], 1u);
            const unsigned tg = og / nx;
            if (og + 1u == (tg + 1u) * nx) xb_add(&bar[XB_TOPGEN], 1u);
            else XB_SPIN(xb_ld(&bar[XB_TOPGEN]) == tg, bar);
            __builtin_amdgcn_fence(__ATOMIC_ACQUIRE, "agent");
            xb_add(&bar[XB_XGEN(b.x)], 1u);
            asm volatile("s_waitcnt vmcnt(0)" ::: "memory");
        } else {
            XB_SPIN(xb_ld(&bar[XB_XGEN(b.x)]) == gen, bar);
            __builtin_amdgcn_fence(__ATOMIC_ACQUIRE, "agent");
            asm volatile("s_waitcnt vmcnt(0)" ::: "memory");
        }
    }
    __syncthreads();
}

constexpr size_t al256(size_t x) { return (x + 255) & ~(size_t)255; }
constexpr size_t WS_ZERO = 0, ZERO_BYTES = 2u << 20;
constexpr size_t Z_GCNT = 0;
constexpr size_t Z_SS2 = 4096;
constexpr size_t WS_MOD = ZERO_BYTES;
constexpr size_t WS_WRT = WS_MOD + al256((size_t)2 * 9 * 6144 * 4);
constexpr size_t WS_TOKE = WS_WRT + al256((size_t)2 * 36 * 1024 * 4);
constexpr size_t WS_TOKP = WS_TOKE + al256((size_t)NSLOT * 4);
constexpr size_t WS_TOKC = WS_TOKP + al256((size_t)NSLOT * 4);
constexpr size_t WS_TOKS = WS_TOKC + al256((size_t)NSLOT * 4);
constexpr size_t WS_TILE = WS_TOKS + al256((size_t)NSLOT * 4);
constexpr size_t WS_XC = WS_TILE + al256((size_t)(MT_MAX + 64) * 4);
constexpr size_t WS_WIN = WS_XC + al256((size_t)NB * CL * D * 4);
constexpr size_t WS_WOUT = WS_WIN + al256((size_t)2 * INW * D * 2);
constexpr size_t WS_WSB = WS_WOUT + al256((size_t)2 * D * D * 2);
constexpr size_t WS_LBV = WS_WSB + al256((size_t)2 * 4 * 128 * 128 * 2);
constexpr size_t WS_HB = WS_LBV + al256((size_t)2 * 2 * 512 * 4);
constexpr size_t WS_R = WS_HB + al256((size_t)M * D * 2);
constexpr int NCH = M / 64  , NCH2 = M / 128;
constexpr size_t R_QA = 0;
constexpr size_t R_KB = R_QA + al256((size_t)2 * M * 512 * 2);
constexpr size_t R_KDT = R_KB + al256((size_t)2 * M * 512 * 2);
constexpr size_t R_VT = R_KDT + al256((size_t)2 * M * 512 * 2);
constexpr size_t R_SG = R_VT + al256((size_t)M * 512 * 2);
constexpr size_t R_GU = R_SG + al256((size_t)M * 512 * 2);
constexpr size_t R_GVT = R_GU + al256((size_t)M * 512 * 2);
constexpr size_t R_EREF = R_GVT + al256((size_t)M * 512 * 2);
constexpr size_t R_DEC = R_EREF + al256((size_t)2 * NCH * 512 * 4);
constexpr size_t R_ST = R_DEC + al256((size_t)2 * NCH * 512 * 4);
constexpr size_t R_MIX_END = R_ST + al256((size_t)(NCH + 1) * 2 * 4 * 128 * 128 * 2);
constexpr size_t R_HS_DUMMY = 0;
constexpr size_t R_WGU = 0;
constexpr size_t R_WD = R_WGU + al256((size_t)NEXP * 1024 * D * 2);
constexpr size_t R_BUF = R_WD + al256((size_t)NEXP * D * DE * 2);
constexpr size_t R_ACT = R_BUF + al256((size_t)NSLOT_PAD * D * 2);
constexpr size_t R_Y = R_ACT + al256((size_t)NSLOT_PAD * DE * 2);
constexpr size_t R_MOE_END = R_Y + al256((size_t)NSLOT_PAD * D * 2);
constexpr size_t WS_END = WS_R + (R_MIX_END > R_MOE_END ? R_MIX_END : R_MOE_END);
static_assert(WS_END <= (size_t)634 * 1000 * 1000, "workspace budget (sum of inputs = 634.3 MB)");
constexpr size_t Z_SSV = Z_SS2 + (size_t)2 * M * 4;
constexpr size_t Z_XC = Z_GCNT + 256;
constexpr size_t Z_BAR = Z_SSV + (size_t)2 * M * 4;
static_assert(Z_BAR % 256 == 0 && Z_BAR + (size_t)XCD_BAR_WORDS * 4 <= ZERO_BYTES, "zeroed region");
constexpr int LDS_BARST = LDS_BYTES - 64, LDS_VBLK = LDS_BYTES - 32, LDS_STAMP = LDS_BYTES - 1024;

struct Params { const float* in[23]; float* out; unsigned char* ws; };
enum { I_X = 0, I_C, I_CTX, I_CCTX, I_NORM1, I_NORM2, I_WMOD, I_BMOD, I_WIN, I_LB, I_HGN, I_SGN, I_SGW, I_SGB, I_WOUT, I_WG, I_BG, I_WR, I_BR, I_WGATE, I_WUP, I_WDOWN, I_FN };

__device__ __forceinline__ void transpose_item(const float* W, int K, int N, bf16* WT, int k0, int n0, int rowbase, LAS float* scr, int lane) {
    float t[32];
#pragma unroll
    for (int i = 0; i < 32; ++i) t[i] = W[(size_t)(k0 + 2 * i + (lane >> 5)) * N + n0 + (lane & 31)];
    SCHED_FENCE();
#pragma unroll
    for (int i = 0; i < 32; ++i) scr[(2 * i + (lane >> 5)) * 33 + (lane & 31)] = t[i];
    asm volatile("s_waitcnt lgkmcnt(0)" ::: "memory");
    const int c = lane & 7;
#pragma unroll
    for (int j = 0; j < 4; ++j) { const int n = (lane >> 3) + 8 * j; const LAS float* s = scr + (8 * c) * 33 + n;
        u32x4 o; o.x = cvt2(s[0 * 33], s[1 * 33]); o.y = cvt2(s[2 * 33], s[3 * 33]); o.z = cvt2(s[4 * 33], s[5 * 33]); o.w = cvt2(s[6 * 33], s[7 * 33]);
        *(u32x4*)(WT + (size_t)(rowbase + n) * K + k0 + 8 * c) = o; }
    asm volatile("s_waitcnt lgkmcnt(0)" ::: "memory");
}
__device__ __forceinline__ void transpose_item_g(const float* W, int K, int N, bf16* WT, int k0, int srccol_lane, int rowbase, LAS float* scr, int lane) {
    float t[32];
#pragma unroll
    for (int i = 0; i < 32; ++i) t[i] = W[(size_t)(k0 + 2 * i + (lane >> 5)) * N + srccol_lane];
    SCHED_FENCE();
#pragma unroll
    for (int i = 0; i < 32; ++i) scr[(2 * i + (lane >> 5)) * 33 + (lane & 31)] = t[i];
    asm volatile("s_waitcnt lgkmcnt(0)" ::: "memory");
    const int c = lane & 7;
#pragma unroll
    for (int j = 0; j < 4; ++j) { const int n = (lane >> 3) + 8 * j; const LAS float* s = scr + (8 * c) * 33 + n;
        u32x4 o; o.x = cvt2(s[0 * 33], s[1 * 33]); o.y = cvt2(s[2 * 33], s[3 * 33]); o.z = cvt2(s[4 * 33], s[5 * 33]); o.w = cvt2(s[6 * 33], s[7 * 33]);
        *(u32x4*)(WT + (size_t)(rowbase + n) * K + k0 + 8 * c) = o; }
    asm volatile("s_waitcnt lgkmcnt(0)" ::: "memory");
}
__device__ __forceinline__ int win_srccol(int r) {
    const int pn = r >> 8, c = r & 255;
    if (pn >= 8) return 2048 + (pn - 8) * 256 + c;
    const int bj = c >> 7, wc = (c >> 5) & 3, fq = (c >> 3) & 3, n = (c >> 2) & 1, e = c & 3;
    return (2 * bj + n) * 512 + (pn >> 1) * 128 + (pn & 1) * 64 + 16 * wc + 4 * fq + e;
}
__device__ __forceinline__ void norm_mod_row(const float* xr, const float* gain, const float* sh, const float* sc, bf16* orow, int lane) {
    f32x4 v[4]; float ss = 0.f;
#pragma unroll
    for (int j = 0; j < 4; ++j) { v[j] = *(const f32x4*)(xr + 4 * lane + 256 * j); ss += (v[j][0] * v[j][0] + v[j][1] * v[j][1]) + (v[j][2] * v[j][2] + v[j][3] * v[j][3]); }
    const float rs = rsqrtf(wave_sum(ss) * (1.f / D) + EPS);
#pragma unroll
    for (int j = 0; j < 4; ++j) { const int k = 4 * lane + 256 * j; const f32x4 g = *(const f32x4*)(gain + k), s1 = *(const f32x4*)(sc + k), s0 = *(const f32x4*)(sh + k);
        const f32x4 o = v[j] * rs * g * (s1 + 1.f) + s0; u32x2 w; w.x = cvt2(o[0], o[1]); w.y = cvt2(o[2], o[3]); *(u32x2*)(orow + k) = w; }
}
__device__ __forceinline__ const float* xrow_in(const Params& p, int row) { const int b = row / RB, t = row % RB; return t < SEQ ? p.in[I_X] + ((size_t)b * SEQ + t) * D : p.in[I_CTX] + ((size_t)b * CL + (t - SEQ)) * D; }
__device__ __forceinline__ float* xrow_cur(const Params& p, int row) { const int b = row / RB, t = row % RB; return t < SEQ ? p.out + ((size_t)b * SEQ + t) * D : (float*)(p.ws + WS_XC) + ((size_t)b * CL + (t - SEQ)) * D; }

__device__ __forceinline__ int vblk() { return __builtin_amdgcn_readfirstlane(*(const LAS int*)(unsigned)LDS_VBLK); }
__device__ __forceinline__ void ph_prologue(const Params& p, LAS unsigned char* lds, int tid, int lane, int wave, int G) {
    float* MOD = (float*)(p.ws + WS_MOD);
    if (blockIdx.x < 192) {
        const int l = blockIdx.x / 96, col0 = (blockIdx.x % 96) * 64;
        LAS float* sc = (LAS float*)lds; LAS float* red = (LAS float*)(lds + 36864);
        for (int i = tid; i < 9 * 1024; i += NTHREADS) { const int r = i >> 10, k = i & 1023; sc[i] = siluf(r < 8 ? p.in[I_C][r * 1024 + k] : p.in[I_CCTX][k]); }
        __syncthreads();
        const int c4 = tid & 15, kg = tid >> 4;
        f32x4 acc[9];
#pragma unroll
        for (int r = 0; r < 9; ++r) acc[r] = (f32x4){0.f, 0.f, 0.f, 0.f};
        const float* w = p.in[I_WMOD] + (size_t)l * 1024 * 6144 + col0 + 4 * c4;
#pragma unroll 8
        for (int k = kg; k < 1024; k += 32) { const f32x4 wv = *(const f32x4*)(w + (size_t)k * 6144);
#pragma unroll
            for (int r = 0; r < 9; ++r) acc[r] += wv * sc[r * 1024 + k]; }
#pragma unroll
        for (int r = 0; r < 9; ++r) *(LAS f32x4*)&red[(kg * 9 + r) * 64 + 4 * c4] = acc[r];
        __syncthreads();
        for (int i = tid; i < 576; i += NTHREADS) { const int r = i >> 6, cc = i & 63; float s = 0.f;
            for (int g = 0; g < 32; ++g) s += red[(g * 9 + r) * 64 + cc];
            MOD[(size_t)(l * 9 + r) * 6144 + col0 + cc] = s + p.in[I_BMOD][l * 6144 + col0 + cc]; }
        __syncthreads();
    }
    {
        float* WRT = (float*)(p.ws + WS_WRT);
        for (int i = blockIdx.x * NTHREADS + tid; i < 2 * 36 * 1024; i += G * NTHREADS) { const int l = i / (36 * 1024), o = (i / 1024) % 36, k = i & 1023;
            WRT[i] = o < 4 ? p.in[I_WG][((size_t)l * 1024 + k) * 4 + o] : p.in[I_WR][((size_t)l * 1024 + k) * 32 + (o - 4)]; }
    }
    {
        float* LBV = (float*)(p.ws + WS_LBV); bf16* WSB = (bf16*)(p.ws + WS_WSB);
        for (int i = blockIdx.x * NTHREADS + tid; i < 1024; i += G * NTHREADS) { LBV[i] = 0.f; LBV[1024 + i] = 1.f / (1.f + expf(p.in[I_LB][i] - p.in[I_LB][1024 + i])); }
        for (int i = blockIdx.x * NTHREADS + tid; i < 2 * 4 * 128 * 128; i += G * NTHREADS) {
            const int jj = i & 7, L = (i >> 3) & 63, sidx = (i >> 9) & 7, itile = (i >> 12) & 3, lh = i >> 14;
            WSB[i] = (bf16)f2bf(p.in[I_SGW][(size_t)lh * 128 * 128 + (32 * itile + (L & 31)) * 128 + 16 * sidx + 8 * (L >> 5) + jj]); }
    }
    LAS float* scr = (LAS float*)(lds + wave * 16384);
    const int gw = blockIdx.x * NWAVES + wave, NGW = G * NWAVES;
    constexpr int I_IN = (D / 64) * (INW / 32), I_OUT = (D / 64) * (D / 32);
    for (int it = gw; it < 2 * (I_IN + I_OUT); it += NGW) {
        const int l = it / (I_IN + I_OUT); int r = it % (I_IN + I_OUT);
        if (r < I_IN) { const int nblk = INW / 32, kb = r / nblk, nb = r % nblk; transpose_item_g(p.in[I_WIN] + (size_t)l * D * INW, D, INW, (bf16*)(p.ws + WS_WIN) + (size_t)l * INW * D, 64 * kb, win_srccol(32 * nb + (lane & 31)), 32 * nb, scr, lane); }
        else { r -= I_IN; const int nblk = D / 32, kb = r / nblk, nb = r % nblk; transpose_item(p.in[I_WOUT] + (size_t)l * D * D, D, D, (bf16*)(p.ws + WS_WOUT) + (size_t)l * D * D, 64 * kb, 32 * nb, 32 * nb, scr, lane); }
    }
}
__device__ __forceinline__ void ph_h1_first(const Params& p, LAS unsigned char* lds, int tid, int lane, int wave, int G) {
    const float* MOD = (const float*)(p.ws + WS_MOD); bf16* HB = (bf16*)(p.ws + WS_HB); const float* gain = p.in[I_NORM1];
    LAS f32x4* sm = (LAS f32x4*)lds;
    { f32x4 t[10];
#pragma unroll
      for (int i = 0; i < 10; ++i) { const int e = tid + i * NTHREADS; if (e < 19 * 256) { const int blk = e >> 8, c = e & 255; t[i] = blk < 18 ? *(const f32x4*)(MOD + (size_t)(blk >> 1) * 6144 + (blk & 1) * 1024 + 4 * c) : *(const f32x4*)(gain + 4 * c); } }
      SCHED_FENCE();
#pragma unroll
      for (int i = 0; i < 10; ++i) { const int e = tid + i * NTHREADS; if (e < 19 * 256) sm[e] = t[i]; } }
    __syncthreads();
    const int stride = G * NWAVES;
    for (int row0 = vblk() * NWAVES + wave; row0 < M; row0 += 4 * stride) {
        f32x4 v[4][4]; bool act[4]; int rows[4];
#pragma unroll
        for (int rr = 0; rr < 4; ++rr) { const int row = row0 + rr * stride; act[rr] = row < M; rows[rr] = act[rr] ? row : row0; const float* xr = xrow_in(p, rows[rr]);
#pragma unroll
            for (int j = 0; j < 4; ++j) v[rr][j] = *(const f32x4*)(xr + 4 * lane + 256 * j); }
        SCHED_FENCE();
#pragma unroll
        for (int rr = 0; rr < 4; ++rr) { float ss = 0.f;
#pragma unroll
            for (int j = 0; j < 4; ++j) ss += (v[rr][j][0] * v[rr][j][0] + v[rr][j][1] * v[rr][j][1]) + (v[rr][j][2] * v[rr][j][2] + v[rr][j][3] * v[rr][j][3]);
            const float rs = rsqrtf(wave_sum(ss) * (1.f / D) + EPS); const int mr = mod_row(rows[rr]);
            if (act[rr]) {
#pragma unroll
                for (int j = 0; j < 4; ++j) { const int c = lane + 64 * j; const f32x4 o = v[rr][j] * rs * sm[18 * 256 + c] * (sm[(mr * 2 + 1) * 256 + c] + 1.f) + sm[(mr * 2) * 256 + c];
                    u32x2 w; w.x = cvt2(o[0], o[1]); w.y = cvt2(o[2], o[3]); *(u32x2*)(HB + (size_t)rows[rr] * D + 4 * c) = w; } } }
    }
}
__device__ __forceinline__ void ph_moe_wconv(const Params& p, int l, LAS unsigned char* lds, int lane, int wave, int blk, int nblk) {
    LAS float* scr = (LAS float*)(lds + wave * 16384);
    bf16* WGU = (bf16*)(p.ws + WS_R + R_WGU); bf16* WD = (bf16*)(p.ws + WS_R + R_WD);
    constexpr int I_G = (D / 64) * (DE / 32)  , I_D = (DE / 64) * (D / 32)  , PER_E = 2 * I_G + I_D;
    for (int it = blk * NWAVES + wave; it < NEXP * PER_E; it += nblk * NWAVES) {
        const int e = it / PER_E; int r = it % PER_E;
        if (r < 2 * I_G) { const int isup = r >= I_G; r -= isup * I_G; const int nblk = DE / 32, kb = r / nblk, nb = r % nblk, n0 = 32 * nb;
            const float* W = p.in[isup ? I_WUP : I_WGATE] + ((size_t)l * NEXP + e) * D * DE;
            transpose_item(W, D, DE, WGU + (size_t)e * 1024 * D, 64 * kb, n0, 256 * (n0 >> 7) + 128 * isup + (n0 & 127), scr, lane); }
        else { r -= 2 * I_G; const int nblk = D / 32, kb = r / nblk, nb = r % nblk;
            transpose_item(p.in[I_WDOWN] + ((size_t)l * NEXP + e) * DE * D, DE, D, WD + (size_t)e * D * DE, 64 * kb, 32 * nb, 32 * nb, scr, lane); }
    }
}
__device__ __forceinline__ float opaque_v(float x) { asm volatile("" : "+v"(x)); return x; }
__device__ __forceinline__ void ph_router(const Params& p, int l, int last, LAS unsigned char* lds, int tid, int lane, int wave, int G) {
    LAS float* W = (LAS float*)lds; LAS int* hist = (LAS int*)(lds + 147456); LAS int* base = hist + 32; LAS int* sinfo = base + 32 + wave * 40;
    const float* WRT = (const float*)(p.ws + WS_WRT) + (size_t)l * 36 * 1024;
    { f32x4 wt[18];
#pragma unroll
      for (int i = 0; i < 18; ++i) wt[i] = ((const f32x4*)WRT)[tid + i * NTHREADS];
      SCHED_FENCE();
#pragma unroll
      for (int i = 0; i < 18; ++i) ((LAS f32x4*)W)[tid + i * NTHREADS] = wt[i]; }
    if (tid < 32) hist[tid] = 0;
    { int* ROWMAP = (int*)(p.ws + WS_R + R_BUF); for (int i = vblk() * NTHREADS + tid; i < NSLOT_PAD; i += G * NTHREADS) ROWMAP[i] = 0; }
    const float* MOD = (const float*)(p.ws + WS_MOD) + (size_t)l * 9 * 6144; const float* SS2 = (const float*)(p.ws + WS_ZERO + Z_SS2) + (size_t)l * M;
    bf16* HB = (bf16*)(p.ws + WS_HB); int* TOKE = (int*)(p.ws + WS_TOKE); float* TOKC = (float*)(p.ws + WS_TOKC); int* TOKP = (int*)(p.ws + WS_TOKP);
    int* gcnt = (int*)(p.ws + WS_ZERO + Z_GCNT) + l * 64;
    const float* gain = p.in[I_NORM2] + l * D;
    LAS float* Bv = (LAS float*)(lds + 147456 + 2048);
    if (tid < 36) Bv[tid] = tid < 4 ? p.in[I_BG][l * 4 + tid] : p.in[I_BR][l * 32 + tid - 4];
    __syncthreads();
    int nloc = 0;
    const int stride = G * NWAVES;
    for (int row0 = vblk() * NWAVES + wave; row0 < M; row0 += 2 * stride) {
        const bool two = row0 + stride < M; const int rows[2] = {row0, two ? row0 + stride : row0};
        bool act[2]; f32x4 h[2][4];
        {
            f32x4 xv[2][4], s1v[2][4], s0v[2][4], gv[4]; float ssq[2];
#pragma unroll
            for (int rr = 0; rr < 2; ++rr) { const int row = rows[rr]; act[rr] = (rr == 0 || two) && !(last && is_ctx_row(row));
                const float* xr = xrow_cur(p, row); const float* mr = MOD + (size_t)mod_row(row) * 6144; ssq[rr] = SS2[row];
#pragma unroll
                for (int j = 0; j < 4; ++j) { const int k = 4 * lane + 256 * j; xv[rr][j] = *(const f32x4*)(xr + k); s1v[rr][j] = *(const f32x4*)(mr + 4 * 1024 + k); s0v[rr][j] = *(const f32x4*)(mr + 3 * 1024 + k); } }
#pragma unroll
            for (int j = 0; j < 4; ++j) gv[j] = *(const f32x4*)(gain + 4 * lane + 256 * j);
            SCHED_FENCE();
#pragma unroll
            for (int rr = 0; rr < 2; ++rr) { const float rs = rsqrtf(ssq[rr] * (1.f / D) + EPS);
#pragma unroll
                for (int j = 0; j < 4; ++j) { const int k = 4 * lane + 256 * j; h[rr][j] = xv[rr][j] * rs * gv[j] * (s1v[rr][j] + 1.f) + s0v[rr][j];
                    if (act[rr]) { u32x2 w; w.x = cvt2(h[rr][j][0], h[rr][j][1]); w.y = cvt2(h[rr][j][2], h[rr][j][3]); *(u32x2*)(HB + (size_t)rows[rr] * D + k) = w; } } }
        }
        typedef float f32x2 __attribute__((ext_vector_type(2)));
        float gl[2][4];
        { f32x4 wg[16];
#pragma unroll
          for (int q = 0; q < 16; ++q) wg[q] = *(const LAS f32x4*)&W[(q >> 2) * 1024 + 4 * lane + 256 * (q & 3)];
          SCHED_FENCE();
#pragma unroll
          for (int o = 0; o < 4; ++o)
#pragma unroll
              for (int rr = 0; rr < 2; ++rr) { f32x2 a2 = {0.f, 0.f};
#pragma unroll
                  for (int j = 0; j < 4; ++j) { const f32x4 wv = wg[o * 4 + j], hv = h[rr][j];
                      a2 = __builtin_elementwise_fma((f32x2){hv[0], hv[1]}, (f32x2){wv[0], wv[1]}, a2); a2 = __builtin_elementwise_fma((f32x2){hv[2], hv[3]}, (f32x2){wv[2], wv[3]}, a2); }
                  gl[rr][o] = opaque_v(wave_sum(a2[0] + a2[1]) + Bv[o]); } }
#pragma unroll
        for (int rr = 0; rr < 2; ++rr) {
            const int row = rows[rr];
            int gs = 0; float gmax = gl[rr][0];
#pragma unroll
            for (int o = 1; o < 4; ++o) if (gl[rr][o] > gmax) { gmax = gl[rr][o]; gs = o; }
            float den = 0.f;
#pragma unroll
            for (int o = 0; o < 4; ++o) den += __expf(gl[rr][o] - gmax);
            const float psel = 1.f / den;
            const int gsu = __builtin_amdgcn_readfirstlane(gs);
            const LAS float* wb = W + (4 + 8 * gsu) * 1024 + 4 * lane; const LAS float* bb = Bv + 4 + 8 * gsu;
            float li[8];
#pragma unroll
            for (int half = 0; half < 2; ++half) { f32x4 we[16];
#pragma unroll
                for (int q = 0; q < 16; ++q) we[q] = *(const LAS f32x4*)&wb[(4 * half + (q >> 2)) * 1024 + 256 * (q & 3)];
                SCHED_FENCE();
#pragma unroll
                for (int o = 0; o < 4; ++o) { f32x2 a2 = {0.f, 0.f};
#pragma unroll
                    for (int j = 0; j < 4; ++j) { const f32x4 wv = we[o * 4 + j], hv = h[rr][j];
                        a2 = __builtin_elementwise_fma((f32x2){hv[0], hv[1]}, (f32x2){wv[0], wv[1]}, a2); a2 = __builtin_elementwise_fma((f32x2){hv[2], hv[3]}, (f32x2){wv[2], wv[3]}, a2); }
                    li[4 * half + o] = opaque_v(wave_sum(a2[0] + a2[1]) + bb[4 * half + o]); } }
            int i0 = 0; float m0 = li[0];
#pragma unroll
            for (int j = 1; j < 8; ++j) if (li[j] > m0) { m0 = li[j]; i0 = j; }
            int i1 = 0; float m1 = -3.0e38f;
#pragma unroll
            for (int j = 0; j < 8; ++j) if (j != i0 && li[j] > m1) { m1 = li[j]; i1 = j; }
            const float e1 = __expf(m1 - m0);
            if (act[rr]) {
                if (lane < 2) { const int e = gs * 8 + (lane ? i1 : i0); const float c = lane ? psel * e1 / (1.f + e1) : psel / (1.f + e1);
                    const int lp = __hip_atomic_fetch_add(&hist[e], 1, __ATOMIC_RELAXED, __HIP_MEMORY_SCOPE_WORKGROUP); TOKE[row * 2 + lane] = e; TOKC[row * 2 + lane] = c; sinfo[nloc * 2 + lane] = (e << 16) | lp; }
                ++nloc; }
        }
    }
    __syncthreads();
    if (tid < 32) base[tid] = atomicAdd(&gcnt[tid], hist[tid]);
    __syncthreads();
    nloc = 0;
    for (int row0 = vblk() * NWAVES + wave; row0 < M; row0 += 2 * stride) {
        const bool two = row0 + stride < M;
#pragma unroll
        for (int rr = 0; rr < 2; ++rr) { const int row = rr ? row0 + stride : row0; if ((rr == 0 || two) && !(last && is_ctx_row(row))) {
            if (lane < 2) { const int info = sinfo[nloc * 2 + lane]; TOKP[row * 2 + lane] = base[info >> 16] + (info & 0xffff); }
            ++nloc; } }
    }
}
__device__ __forceinline__ void ph_place(const Params& p, int l, int last, LAS unsigned char* lds, int tid, int lane, int wave, int G) {
    LAS int* ps = (LAS int*)lds;
    const int* gcnt = (const int*)(p.ws + WS_ZERO + Z_GCNT) + l * 64; int* TILE = (int*)(p.ws + WS_TILE);
    if (tid == 0) { int s = 0; for (int e = 0; e < NEXP; ++e) { ps[e] = s; s += (gcnt[e] + 255) / 256 * 256; } ps[32] = s; }
    __syncthreads();
    if (vblk() == 0 && tid < 32) { for (int t = ps[tid] / 256; t < ps[tid + 1] / 256; ++t) TILE[t] = tid; if (tid == 0) TILE[MT_MAX] = ps[32] / 256; }
    int* ROWMAP = (int*)(p.ws + WS_R + R_BUF);
    const int* TOKE = (const int*)(p.ws + WS_TOKE); const int* TOKP = (const int*)(p.ws + WS_TOKP); int* TOKS = (int*)(p.ws + WS_TOKS);
    for (int i = vblk() * NTHREADS + tid; i < NSLOT; i += G * NTHREADS) { const int row = i >> 1;
        if (last && is_ctx_row(row)) continue;
        const int sl = ps[TOKE[i]] + TOKP[i]; TOKS[i] = sl; ROWMAP[sl] = row; }
}
__device__ __forceinline__ void ph_combine(const Params& p, int l, int last, LAS unsigned char* lds, int tid, int lane, int wave, int G) {
    const float* MOD = (const float*)(p.ws + WS_MOD); const bf16* Y = (const bf16*)(p.ws + WS_R + R_Y); bf16* HB = (bf16*)(p.ws + WS_HB);
    const int* TOKS = (const int*)(p.ws + WS_TOKS); const float* TOKC = (const float*)(p.ws + WS_TOKC);
    const float* gain = last ? p.in[I_FN] : p.in[I_NORM1] + (l + 1) * D;
    LAS f32x4* sm = (LAS f32x4*)lds;
    { f32x4 t[14];
#pragma unroll
      for (int i = 0; i < 14; ++i) { const int e = tid + i * NTHREADS; if (e < 28 * 256) { const int blk = e >> 8, c = e & 255, mr = blk / 3, wh = blk % 3;
          t[i] = blk < 27 ? *(const f32x4*)(MOD + ((size_t)(wh == 0 ? l : (last ? l : l + 1)) * 9 + mr) * 6144 + (wh == 0 ? 5 : wh - 1) * 1024 + 4 * c) : *(const f32x4*)(gain + 4 * c); } }
      SCHED_FENCE();
#pragma unroll
      for (int i = 0; i < 14; ++i) { const int e = tid + i * NTHREADS; if (e < 28 * 256) sm[e] = t[i]; } }
    __syncthreads();
    const int stride = G * NWAVES;
    for (int row0 = vblk() * NWAVES + wave; row0 < M; row0 += 4 * stride) {
        bool act[4]; int rows[4]; float* xr[4]; f32x4 x[4][4]; u32x2 y0[4][4], y1[4][4]; float c0[4], c1[4];
#pragma unroll
        for (int rr = 0; rr < 4; ++rr) { const int rw = row0 + rr * stride; const bool in = rw < M; const int row = in ? rw : row0; rows[rr] = row; act[rr] = in && !(last && is_ctx_row(row)); xr[rr] = xrow_cur(p, row);
            const int s0 = act[rr] ? TOKS[row * 2] : 0, s1 = act[rr] ? TOKS[row * 2 + 1] : 0; c0[rr] = TOKC[row * 2]; c1[rr] = TOKC[row * 2 + 1];
#pragma unroll
            for (int j = 0; j < 4; ++j) { const int k = 4 * lane + 256 * j; x[rr][j] = *(const f32x4*)(xr[rr] + k); y0[rr][j] = *(const u32x2*)(Y + (size_t)s0 * D + k); y1[rr][j] = *(const u32x2*)(Y + (size_t)s1 * D + k); } }
        SCHED_FENCE();
#pragma unroll
        for (int rr = 0; rr < 4; ++rr) { f32x4 v[4]; float ss = 0.f; const int mr = mod_row(rows[rr]);
#pragma unroll
            for (int j = 0; j < 4; ++j) { const u32x2 a = y0[rr][j], b = y1[rr][j]; f32x4 f;
                f[0] = c0[rr] * bf2f(a.x & 0xffffu) + c1[rr] * bf2f(b.x & 0xffffu); f[1] = c0[rr] * bf2f(a.x >> 16) + c1[rr] * bf2f(b.x >> 16);
                f[2] = c0[rr] * bf2f(a.y & 0xffffu) + c1[rr] * bf2f(b.y & 0xffffu); f[3] = c0[rr] * bf2f(a.y >> 16) + c1[rr] * bf2f(b.y >> 16);
                v[j] = x[rr][j] + sm[(mr * 3) * 256 + lane + 64 * j] * f; ss += (v[j][0] * v[j][0] + v[j][1] * v[j][1]) + (v[j][2] * v[j][2] + v[j][3] * v[j][3]); }
            const float rs = rsqrtf(wave_sum(ss) * (1.f / D) + EPS);
            if (act[rr]) {
                if (!last) {
#pragma unroll
                    for (int j = 0; j < 4; ++j) { const int c = lane + 64 * j, k = 4 * c; *(f32x4*)(xr[rr] + k) = v[j];
                        const f32x4 o = v[j] * rs * sm[27 * 256 + c] * (sm[(mr * 3 + 2) * 256 + c] + 1.f) + sm[(mr * 3 + 1) * 256 + c];
                        u32x2 w; w.x = cvt2(o[0], o[1]); w.y = cvt2(o[2], o[3]); *(u32x2*)(HB + (size_t)rows[rr] * D + k) = w; } }
                else {
#pragma unroll
                    for (int j = 0; j < 4; ++j) { const int c = lane + 64 * j; *(f32x4*)(xr[rr] + 4 * c) = v[j] * rs * sm[27 * 256 + c]; } } } }
    }
}
__device__ __forceinline__ int scan_chunk(int step, int dir) { return dir == 0 ? (step < 4 ? 64 + step : step - 4) : 67 - step; }
typedef short bf16x8 __attribute__((ext_vector_type(8)));
typedef short s16x4 __attribute__((ext_vector_type(4)));
typedef float f32x16 __attribute__((ext_vector_type(16)));
#define MFMA32(a, b, c) __builtin_amdgcn_mfma_f32_32x32x16_bf16((a), (b), (c), 0, 0, 0)
__device__ __forceinline__ bf16x8 ld8(const bf16* q) { return *(const bf16x8*)q; }
__device__ __forceinline__ bf16x8 ld44(const bf16* q0, const bf16* q1) { const s16x4 lo = *(const s16x4*)q0, hi = *(const s16x4*)q1; return __builtin_shufflevector(lo, hi, 0, 1, 2, 3, 4, 5, 6, 7); }
__device__ __forceinline__ f32x16 zero16() { f32x16 z;
#pragma unroll
    for (int i = 0; i < 16; ++i) z[i] = 0.f; return z; }
__device__ __forceinline__ bf16x8 pack_acc(const f32x16& x, int s) { u32x4 w; w.x = pk2(x[8 * s], x[8 * s + 1]); w.y = pk2(x[8 * s + 2], x[8 * s + 3]); w.z = pk2(x[8 * s + 4], x[8 * s + 5]); w.w = pk2(x[8 * s + 6], x[8 * s + 7]); return __builtin_bit_cast(bf16x8, w); }
__device__ __forceinline__ bf16x8 scale8(bf16x8 f, f32x4 a, f32x4 b) { const u32x4 w = __builtin_bit_cast(u32x4, f); u32x4 o;
    o.x = cvt2(bf2f(w.x & 0xffffu) * a[0], bf2f(w.x >> 16) * a[1]); o.y = cvt2(bf2f(w.y & 0xffffu) * a[2], bf2f(w.y >> 16) * a[3]);
    o.z = cvt2(bf2f(w.z & 0xffffu) * b[0], bf2f(w.z >> 16) * b[1]); o.w = cvt2(bf2f(w.w & 0xffffu) * b[2], bf2f(w.w >> 16) * b[3]); return __builtin_bit_cast(bf16x8, o); }

constexpr int SCAN_DE_BYTES = 69 * 256 * 4, SCAN_RING_OFF = 71680, SCAN_BUF_BYTES = 24 * 1024;
__device__ __forceinline__ void scan_item(int item, int& b, int& h, int& dir, int& eh) {
    const int xcd = item & 7, j = item >> 3, pair = (j >> 2) * 8 + xcd; eh = j & 1; dir = (j >> 1) & 1; h = pair & 3; b = pair >> 2;
}
__device__ __forceinline__ void scan_preload(const Params& p, LAS unsigned char* lds, int tid, int item) {
    int b, h, dir, eh; scan_item(item, b, h, dir, eh);
    const float* DEC = (const float*)(p.ws + WS_R + R_DEC) + (size_t)dir * NCH * 512 + h * 128; const float* ER = (const float*)(p.ws + WS_R + R_EREF) + (size_t)dir * NCH * 512 + h * 128;
    LAS float* de = (LAS float*)lds;
    for (int i = tid; i < 69 * 256; i += NTHREADS) { const int step = i >> 8, w = i & 255; const size_t gc = (size_t)(b * 68 + scan_chunk(step < 68 ? step : 67, dir));
        de[i] = w < 128 ? DEC[gc * 512 + w] : ER[gc * 512 + (w - 128)]; }
}
struct ScanRegs { bf16x8 f[3]; };
__device__ __forceinline__ void ph_scan(const Params& p, LAS unsigned char* lds, int lane, int wave, int item) {
    int b, h, dir, eh; scan_item(item, b, h, dir, eh);
    const int dt = wave & 3, etl = wave >> 2, et = 2 * eh + etl, hh = lane >> 5;
    const bf16* KD = (const bf16*)(p.ws + WS_R + R_KDT) + (size_t)dir * M * 512; const bf16* V = (const bf16*)(p.ws + WS_R + R_VT);
    const bf16* src[3];
#pragma unroll
    for (int i = 0; i < 3; ++i) { const int f = 3 * wave + i; src[i] = f < 16 ? KD + ((((size_t)h * 4 + (f >> 2)) * 4 + (f & 3)) * 64 + lane) * 8 : V + ((((size_t)h * 4 + 2 * eh + ((f - 16) >> 2)) * 4 + (f & 3)) * 64 + lane) * 8; }
    const LAS float* de = (const LAS float*)lds + 32 * dt + 4 * hh;
    LAS unsigned char* ring = lds + SCAN_RING_OFF;
    const int wofs = 3 * wave * 1024 + lane * 16, aofs = dt * 4 * 1024 + lane * 16, bofs = (16 + etl * 4) * 1024 + lane * 16;
    bf16* ST = (bf16*)(p.ws + WS_R + R_ST) + (((size_t)dir * 4 + h) * 16 + dt * 4 + et) * 1024 + lane * 8;
    f32x16 S = zero16();
#define SCAN_GC(step) ((size_t)(b * 68 + scan_chunk((step) < 68 ? (step) : 67, dir)))
#define SCAN_LOAD(R, step) { const size_t g_ = SCAN_GC(step) * (4 * 4 * 4 * 512); _Pragma("unroll") for (int i = 0; i < 3; ++i) R.f[i] = ld8(src[i] + g_); }
#define SCAN_WRITE(R, buf) { _Pragma("unroll") for (int i = 0; i < 3; ++i) *(LAS bf16x8*)(ring + (buf) * SCAN_BUF_BYTES + wofs + i * 1024) = R.f[i]; }
#define SCAN_BAR() { asm volatile("s_waitcnt lgkmcnt(0)" ::: "memory"); __builtin_amdgcn_s_barrier(); asm volatile("" ::: "memory"); }
    ScanRegs P0, P1;
    SCAN_LOAD(P0, 0); SCAN_LOAD(P1, 1);
    SCAN_WRITE(P0, 0); SCAN_LOAD(P0, 2);
    for (int k0 = 0; k0 < 72; k0 += 6) {
#pragma unroll
        for (int j = 0; j < 6; ++j) { const int k = k0 + j;
            SCAN_BAR();
            if ((j + 1) & 1) { SCAN_WRITE(P1, (j + 1) % 3); SCAN_LOAD(P1, k + 3); } else { SCAN_WRITE(P0, (j + 1) % 3); SCAN_LOAD(P0, k + 3); }
            const LAS unsigned char* buf = ring + (j % 3) * SCAN_BUF_BYTES;
            bf16x8 fa[4], fb[4]; f32x4 dc[4], er[4]; const LAS float* dk = de + (k < 69 ? k : 68) * 256;
#pragma unroll
            for (int s = 0; s < 4; ++s) { fa[s] = *(const LAS bf16x8*)(buf + aofs + s * 1024); fb[s] = *(const LAS bf16x8*)(buf + bofs + s * 1024); dc[s] = *(const LAS f32x4*)(dk + 8 * s); er[s] = *(const LAS f32x4*)(dk + 128 + 8 * s); }
            { bf16* st = ST + (k < 68 ? SCAN_GC(k) : (size_t)NCH) * (2 * 4 * 16384); u32x4 w0, w1;
              w0.x = cvt2(S[0] * er[0][0], S[1] * er[0][1]); w0.y = cvt2(S[2] * er[0][2], S[3] * er[0][3]); w0.z = cvt2(S[4] * er[1][0], S[5] * er[1][1]); w0.w = cvt2(S[6] * er[1][2], S[7] * er[1][3]);
              w1.x = cvt2(S[8] * er[2][0], S[9] * er[2][1]); w1.y = cvt2(S[10] * er[2][2], S[11] * er[2][3]); w1.z = cvt2(S[12] * er[3][0], S[13] * er[3][1]); w1.w = cvt2(S[14] * er[3][2], S[15] * er[3][3]);
              *(u32x4*)st = w0; *(u32x4*)(st + 512) = w1; }
#pragma unroll
            for (int g = 0; g < 4; ++g)
#pragma unroll
                for (int q = 0; q < 4; ++q) S[4 * g + q] *= dc[g][q];
#pragma unroll
            for (int s = 0; s < 4; ++s) S = MFMA32(fa[s], fb[s], S);
        }
    }
#undef SCAN_GC
#undef SCAN_LOAD
#undef SCAN_WRITE
#undef SCAN_BAR
}
__device__ __forceinline__ void ph_sgu(const Params& p, int l, int lane, int widx, int nw) {
    const bf16* GVT = (const bf16*)(p.ws + WS_R + R_GVT); const bf16* GU = (const bf16*)(p.ws + WS_R + R_GU); bf16* HS = (bf16*)(p.ws + WS_HB);
    const float* SSV = (const float*)(p.ws + WS_ZERO + Z_SSV) + (size_t)l * M; const bf16* WSB = (const bf16*)(p.ws + WS_WSB) + (size_t)l * 4 * 128 * 128; const float* bs = p.in[I_SGB] + l * 512;
    const int r = lane & 31, hh = lane >> 5;
    for (int it = widx; it < NCH2 * 16; it += nw) { const int gc2 = it >> 4, h = (it >> 2) & 3, cht = it & 3;
        const bf16* ap = GVT + ((((size_t)(gc2 * 4 + h) * 4 + cht) * 8) * 64 + lane) * 8; const float* sp = SSV + gc2 * 128 + 8 * hh; const bf16* wp = WSB + ((((size_t)h * 4) * 8) * 64 + lane) * 8;
        f32x16 acc[4] = {zero16(), zero16(), zero16(), zero16()};
        bf16x8 av[8]; f32x4 sv[16];
#pragma unroll
        for (int s = 0; s < 8; ++s) { av[s] = ld8(ap + s * 512); sv[2 * s] = *(const f32x4*)(sp + 16 * s); sv[2 * s + 1] = *(const f32x4*)(sp + 16 * s + 4); }
        bf16x8 wa[4], wb[4];
#pragma unroll
        for (int t = 0; t < 4; ++t) wa[t] = ld8(wp + (size_t)t * 8 * 512);
#pragma unroll
        for (int s = 0; s < 8; ++s) {
            SCHED_FENCE();
            if (s < 7) {
#pragma unroll
                for (int t = 0; t < 4; ++t) { const bf16x8 w = ld8(wp + (size_t)t * 8 * 512 + (s + 1) * 512); if (s & 1) wa[t] = w; else wb[t] = w; } }
            SCHED_FENCE();
            f32x4 s0 = sv[2 * s], s1 = sv[2 * s + 1];
#pragma unroll
            for (int q = 0; q < 4; ++q) { s0[q] = rsqrtf(s0[q] * (1.f / 512.f) + EPS); s1[q] = rsqrtf(s1[q] * (1.f / 512.f) + EPS); }
            const bf16x8 a = scale8(av[s], s0, s1);
#pragma unroll
            for (int t = 0; t < 4; ++t) acc[t] = MFMA32(a, (s & 1) ? wb[t] : wa[t], acc[t]); }
        u32x2 gu[4][4]; float bias[4];
#pragma unroll
        for (int t = 0; t < 4; ++t) { const size_t row = (size_t)gc2 * 128 + 32 * t + r; bias[t] = bs[h * 128 + 32 * t + r];
#pragma unroll
            for (int g = 0; g < 4; ++g) gu[t][g] = *(const u32x2*)(GU + row * 512 + h * 128 + 32 * cht + 8 * g + 4 * hh); }
        SCHED_FENCE();
#pragma unroll
        for (int t = 0; t < 4; ++t) { const size_t row = (size_t)gc2 * 128 + 32 * t + r;
#pragma unroll
            for (int g = 0; g < 4; ++g) { const int ch = h * 128 + 32 * cht + 8 * g + 4 * hh; const u32x2 u = gu[t][g];
                u32x2 w; w.x = cvt2(bf2f(u.x & 0xffffu) * (acc[t][4 * g] + bias[t]), bf2f(u.x >> 16) * (acc[t][4 * g + 1] + bias[t])); w.y = cvt2(bf2f(u.y & 0xffffu) * (acc[t][4 * g + 2] + bias[t]), bf2f(u.y >> 16) * (acc[t][4 * g + 3] + bias[t]));
                *(u32x2*)(HS + row * D + 512 + ch) = w; } }
    }
}
__device__ __forceinline__ void ph_out(const Params& p, int l, int last, LAS unsigned char* lds, int lane, int wave, int G) {
    const bf16* QA = (const bf16*)(p.ws + WS_R + R_QA); const bf16* KB = (const bf16*)(p.ws + WS_R + R_KB); const bf16* VT = (const bf16*)(p.ws + WS_R + R_VT);
    const bf16* ST = (const bf16*)(p.ws + WS_R + R_ST); const bf16* SG = (const bf16*)(p.ws + WS_R + R_SG);
    bf16* HS = (bf16*)(p.ws + WS_HB); const float* gain = p.in[I_HGN] + l * 512;
    const int r = lane & 31, hh = lane >> 5;
    for (int it = vblk() * NWAVES + wave; it < NCH * 8; it += G * NWAVES) { const int gc = it >> 3, h = (it >> 1) & 3, ih = it & 1;
        if (last && (gc % 68) >= 64) continue;
        f32x16 o[4] = {zero16(), zero16(), zero16(), zero16()}; f32x16 Pd, Po;
#pragma unroll
        for (int dir = 0; dir < 2; ++dir) {
            const bf16* qp = QA + (size_t)dir * M * 512 + ((((size_t)(gc * 4 + h) * 2 + ih) * 8) * 64 + lane) * 8;
            const bf16* kd = KB + (size_t)dir * M * 512 + ((((size_t)(gc * 4 + h) * 2 + ih) * 8) * 64 + lane) * 8;
            const bf16* ko = KB + (size_t)dir * M * 512 + ((((size_t)(gc * 4 + h) * 2 + (1 - ih)) * 8) * 64 + lane) * 8;
            const bf16* sp = ST + (((size_t)gc * 2 + dir) * 4 + h) * 16384 + lane * 8;
            const bool off = (dir == 0) == (ih == 1);
            bf16x8 qa[8], ka[8], sa[8], sb[8];
#pragma unroll
            for (int s = 0; s < 8; ++s) { qa[s] = ld8(qp + s * 512); ka[s] = ld8(kd + s * 512); }
            if (off) {
#pragma unroll
                for (int s = 0; s < 8; ++s) sb[s] = ld8(ko + s * 512); }
            SCHED_FENCE();
            { f32x16 t = zero16();
#pragma unroll
              for (int s = 0; s < 8; ++s) t = MFMA32(ka[s], qa[s], t);
              SCHED_FENCE();
#pragma unroll
              for (int s = 0; s < 8; ++s) sa[s] = ld8(sp + (size_t)((s >> 1) * 4 + 0) * 1024 + 512 * (s & 1));
              SCHED_FENCE();
#pragma unroll
              for (int q = 0; q < 16; ++q) { const int j = (q & 3) + 8 * (q >> 2) + 4 * hh; const bool keep = dir == 0 ? (j <= r) : (j >= r); const float v = keep ? t[q] : 0.f; if (dir == 0) Pd[q] = v; else Pd[q] += v; } }
            if (off) { f32x16 t = zero16();
#pragma unroll
              for (int s = 0; s < 8; ++s) t = MFMA32(sb[s], qa[s], t);
              Po = t; }
#pragma unroll
            for (int et = 0; et < 4; ++et) {
                SCHED_FENCE();
                if (et < 3) {
#pragma unroll
                    for (int s = 0; s < 8; ++s) { const bf16x8 w = ld8(sp + (size_t)((s >> 1) * 4 + et + 1) * 1024 + 512 * (s & 1)); if (et & 1) sa[s] = w; else sb[s] = w; } }
                SCHED_FENCE();
#pragma unroll
                for (int s = 0; s < 8; ++s) o[et] = MFMA32((et & 1) ? sb[s] : sa[s], qa[s], o[et]);
            }
        }
        {
            const bf16* vp = VT + (((size_t)(gc * 4 + h) * 4 * 4) * 64 + r) * 8 + 4 * hh;
            bf16x8 va[4][4];
#pragma unroll
            for (int et = 0; et < 4; ++et)
#pragma unroll
                for (int k = 0; k < 4; ++k) { const bf16* v = vp + (size_t)(et * 4 + k) * 512; va[et][k] = ld44(v, v + 32 * 8); }
            SCHED_FENCE();
#pragma unroll
            for (int s = 0; s < 2; ++s) { const bf16x8 pd = pack_acc(Pd, s), po = pack_acc(Po, s);
#pragma unroll
                for (int et = 0; et < 4; ++et) { o[et] = MFMA32(ih ? va[et][2 + s] : va[et][s], pd, o[et]); o[et] = MFMA32(ih ? va[et][s] : va[et][2 + s], po, o[et]); } }
        }
        float ss = 0.f;
#pragma unroll
        for (int et = 0; et < 4; ++et)
#pragma unroll
            for (int q = 0; q < 16; ++q) ss += o[et][q] * o[et][q];
        ss += __shfl_xor(ss, 32);
        const float rs = rsqrtf(ss * (1.f / 128.f) + EPS);
        LAS unsigned char* img = lds + wave * 8704;
#pragma unroll
        for (int et = 0; et < 4; ++et)
#pragma unroll
            for (int g = 0; g < 4; ++g) { u32x2 w; w.x = cvt2(o[et][4 * g] * rs, o[et][4 * g + 1] * rs); w.y = cvt2(o[et][4 * g + 2] * rs, o[et][4 * g + 3] * rs);
                *(LAS u32x2*)(img + r * 272 + (32 * et + 8 * g + 4 * hh) * 2) = w; }
        asm volatile("s_waitcnt lgkmcnt(0)" ::: "memory");
        const int ck = lane & 15, rq = lane >> 4;
        const f32x4 g0 = *(const f32x4*)(gain + h * 128 + 8 * ck), g1 = *(const f32x4*)(gain + h * 128 + 8 * ck + 4);
        u32x4 sg[8], ov[8];
#pragma unroll
        for (int i = 0; i < 8; ++i) { const size_t row = (size_t)gc * 64 + 32 * ih + 4 * i + rq; sg[i] = *(const u32x4*)(SG + row * 512 + h * 128 + 8 * ck); ov[i] = *(const LAS u32x4*)(img + (4 * i + rq) * 272 + ck * 16); }
#pragma unroll
        for (int i = 0; i < 8; ++i) { const size_t row = (size_t)gc * 64 + 32 * ih + 4 * i + rq; const u32x4 a = ov[i], b = sg[i]; u32x4 w;
            w.x = cvt2(bf2f(a.x & 0xffffu) * g0[0] * bf2f(b.x & 0xffffu), bf2f(a.x >> 16) * g0[1] * bf2f(b.x >> 16)); w.y = cvt2(bf2f(a.y & 0xffffu) * g0[2] * bf2f(b.y & 0xffffu), bf2f(a.y >> 16) * g0[3] * bf2f(b.y >> 16));
            w.z = cvt2(bf2f(a.z & 0xffffu) * g1[0] * bf2f(b.z & 0xffffu), bf2f(a.z >> 16) * g1[1] * bf2f(b.z >> 16)); w.w = cvt2(bf2f(a.w & 0xffffu) * g1[2] * bf2f(b.w & 0xffffu), bf2f(a.w >> 16) * g1[3] * bf2f(b.w >> 16));
            *(u32x4*)(HS + row * D + h * 128 + 8 * ck) = w; }
        asm volatile("s_waitcnt lgkmcnt(0)" ::: "memory");
    }
}
#ifndef TIMING
#define TIMING 0
#endif
#ifndef TIMING_MASK
#define TIMING_MASK 0ull
#endif
#ifndef TIMING_MODE
#define TIMING_MODE 0
#endif
#ifndef TIMING_MUL
#define TIMING_MUL 4
#endif
constexpr int PH_PRO = 0, PH_H1 = 1, PH_L0 = 2, PH_PER_LAYER = 9, PH_END = PH_L0 + 2 * PH_PER_LAYER;
__device__ __forceinline__ void* launder_ptr(void* q) { unsigned long long v = (unsigned long long)q; asm volatile("" : "+s"(v)); return (void*)v; }
__global__ void __launch_bounds__(NTHREADS, 2) mk(Params p, int ph_lo, int ph_hi) {
    extern __shared__ __attribute__((aligned(16))) unsigned char lds_raw[];
    LAS unsigned char* lds = (LAS unsigned char*)lds_raw;
    constexpr int G = 256;
    unsigned char* const ws0 = p.ws; const int wave0 = __builtin_amdgcn_readfirstlane(threadIdx.x >> 6);
    cg::grid_group grid = cg::this_grid();
    if (threadIdx.x < 16) ((LAS unsigned*)(lds + LDS_BARST))[threadIdx.x] = 0u;
    __syncthreads();
    (void)xcd_barrier_post((unsigned*)(p.ws + WS_ZERO + Z_BAR), (volatile LAS unsigned*)(lds + LDS_BARST));
#if TIMING
    if (blockIdx.x == 0 && threadIdx.x == 0) ((LAS unsigned long long*)(lds + LDS_STAMP))[0] = __builtin_amdgcn_s_memrealtime();
#endif
    {
        const int tid0 = threadIdx.x;
        if (tid0 == 0) { const unsigned x = xb_xcc_id() & 7u; ((LAS int*)(lds + LDS_VBLK))[1] = (int)x; ((LAS int*)(lds + LDS_VBLK))[2] = (int)atomicAdd((unsigned*)(p.ws + WS_ZERO + Z_XC) + x, 1u); }
        ph_prologue(p, lds, tid0, tid0 & 63, wave0, G);
#if TIMING
        if (blockIdx.x == 0 && tid0 == 0) ((LAS unsigned long long*)(lds + LDS_STAMP))[32] = __builtin_amdgcn_s_memrealtime();
#endif
        grid.sync();
        if (tid0 == 0) {
            LAS int* vw = (LAS int*)(lds + LDS_VBLK); const unsigned* XC = (const unsigned*)(p.ws + WS_ZERO + Z_XC); const int myx = vw[1], myr = vw[2]; int vb = -1;
            if (myr < 32) vb = myr * 8 + myx;
            else { int o = myr - 32;
                for (int x = 0; x < myx; ++x) { const int c = (int)XC[x]; o += c > 32 ? c - 32 : 0; }
                for (int x = 0; x < 8 && vb < 0; ++x) { const int c = (int)XC[x] < 32 ? (int)XC[x] : 32, empty = 32 - c; if (o < empty) vb = (c + o) * 8 + x; else o -= empty; } }
            vw[0] = vb < 0 ? 0 : vb; }
        __syncthreads();
#if TIMING
        if (blockIdx.x == 0 && tid0 == 0) ((LAS unsigned long long*)(lds + LDS_STAMP))[1] = __builtin_amdgcn_s_memrealtime();
#endif
    }
    for (int ph = 1; ph < ph_hi; ++ph) {
        int zlane = 0; asm volatile("" : "+v"(zlane));
        const int tid = wave0 * 64 + (int)__builtin_amdgcn_mbcnt_hi(~0u, __builtin_amdgcn_mbcnt_lo(~0u, (unsigned)zlane));
        { size_t zoff = 0; asm volatile("" : "+s"(zoff)); p.ws = ws0 + zoff; }
        const int lane = tid & 63, wave = wave0;
        if (ph == PH_H1) ph_h1_first(p, lds, tid, lane, wave, G);
        else {
            const int l = (ph - PH_L0) / PH_PER_LAYER, s = (ph - PH_L0) % PH_PER_LAYER, last = l == 1;
            const float* modl = (const float*)(p.ws + WS_MOD) + (size_t)l * 9 * 6144;
            if (s == 0) {
                pg8::Gemm g{(const bf16*)(p.ws + WS_HB), (const bf16*)(p.ws + WS_WIN) + (size_t)l * INW * D, M, INW, D};
                pg8::DenseOrder S; S.init(M / 256, INW / 256, G, vblk(), 0);
                unsigned char* R = p.ws + WS_R;
                pg8::EpiInProj E{(bf16*)(R + R_QA), (bf16*)(R + R_KB), (bf16*)(R + R_KDT), (bf16*)(R + R_VT), (bf16*)(R + R_SG), (bf16*)(R + R_GU), (bf16*)(R + R_GVT), (float*)(R + R_EREF), (float*)(R + R_DEC),
                                 (float*)(p.ws + WS_ZERO + Z_SSV) + (size_t)l * M, (const float*)(p.ws + WS_LBV) + l * 1024, p.in[I_SGN] + l * 512, (size_t)M * 512, NCH};
                pg8::gemm_phase<pg8::EpiInProj, pg8::DenseOrder, true, true>(lds, g, S, E, tid);
            } else if (s == 1) { if (vblk() < 128) { scan_preload(p, lds, tid, vblk()); __syncthreads(); ph_scan(p, lds, lane, wave, vblk()); }
                else ph_sgu(p, l, lane, (vblk() - 128) * 8 + wave, 128 * 8); }
            else if (s == 2) ph_out(p, l, last, lds, lane, wave, G);
            else if (s == 3) {
                pg8::Gemm g{(const bf16*)(p.ws + WS_HB), (const bf16*)(p.ws + WS_WOUT) + (size_t)l * D * D, M, D, D};
                pg8::DenseOrder S; S.init(last ? NB * 16 : M / 256, D / 256, G, vblk(), last);
                pg8::EpiResid E{l == 0 ? p.in[I_X] : p.out, l == 0 ? p.in[I_CTX] : (const float*)(p.ws + WS_XC), p.out, (float*)(p.ws + WS_XC), modl, (float*)(p.ws + WS_ZERO + Z_SS2) + (size_t)l * M};
                pg8::gemm_phase<pg8::EpiResid, pg8::DenseOrder, true, true>(lds, g, S, E, tid);
                if (last) ph_moe_wconv(p, l, lds, lane, wave, vblk(), G); else if (vblk() >= 32) ph_moe_wconv(p, l, lds, lane, wave, vblk() - 32, G - 32);
            } else if (s == 4) ph_router(p, l, last, lds, tid, lane, wave, G);
            else if (s == 5) ph_place(p, l, last, lds, tid, lane, wave, G);
            else if (s == 6) {
                const int* TILE = (const int*)(p.ws + WS_TILE); const int nt = __builtin_amdgcn_readfirstlane(TILE[MT_MAX]);
                pg8::Gemm g{(const bf16*)(p.ws + WS_HB), (const bf16*)(p.ws + WS_R + R_WGU), M, 1024, D};
                pg8::MoeOrder S; S.init(TILE, nt, 4, G, vblk(), 4);
                pg8::EpiSwiglu E{(bf16*)(p.ws + WS_R + R_ACT)};
                LAS int* rm = (LAS int*)(lds + 131072);
                { const int* ROWMAP = (const int*)(p.ws + WS_R + R_BUF);
                  for (int i = 0; i < 5; ++i) { pg8::Unit uu; if (S.next(i, uu) && tid < 256) { const int v_ = ROWMAP[uu.pm * 256 + tid]; rm[i * 256 + tid] = v_; } }
                  __syncthreads(); }
                pg8::gemm_phase<pg8::EpiSwiglu, pg8::MoeOrder, true, true, true>(lds, g, S, E, tid, rm);
            } else if (s == 7) {
                const int* TILE = (const int*)(p.ws + WS_TILE); const int nt = __builtin_amdgcn_readfirstlane(TILE[MT_MAX]);
                pg8::Gemm g{(const bf16*)(p.ws + WS_R + R_ACT), (const bf16*)(p.ws + WS_R + R_WD), NSLOT_PAD, D, DE};
                pg8::MoeOrder S; S.init(TILE, nt, 4, G, vblk(), 4);
                pg8::EpiStoreBf16 E{(bf16*)(p.ws + WS_R + R_Y), D};
                pg8::gemm_phase<pg8::EpiStoreBf16, pg8::MoeOrder, true, true>(lds, g, S, E, tid);
            } else ph_combine(p, l, last, lds, tid, lane, wave, G);
        }
#if TIMING
        if (blockIdx.x == 0 && tid == 0) ((LAS unsigned long long*)(lds + LDS_STAMP))[32 + ph] = __builtin_amdgcn_s_memrealtime();
#endif
        if (ph + 1 < ph_hi) { { XcdBarrier bar; bar.bar = (unsigned*)(p.ws + WS_ZERO + Z_BAR); bar.x = xb_xcc_id(); bar.st = (volatile LAS unsigned*)(lds + LDS_BARST); xcd_barrier(bar, tid); } }
#if TIMING
        if (blockIdx.x == 0 && tid == 0) ((LAS unsigned long long*)(lds + LDS_STAMP))[ph + 1] = __builtin_amdgcn_s_memrealtime();
#endif
    }
#if TIMING
    if (blockIdx.x == 0 && threadIdx.x == 0) {
        LAS unsigned long long* st = (LAS unsigned long long*)(lds + LDS_STAMP); unsigned long long tot = 0;
        for (int k = 0; k < PH_END; ++k) if ((TIMING_MASK >> k) & 1ull) tot += (TIMING_MODE ? st[32 + k] : st[k + 1]) - st[k];
        const unsigned long long t0 = __builtin_amdgcn_s_memrealtime();
        while (__builtin_amdgcn_s_memrealtime() - t0 < tot * TIMING_MUL) __builtin_amdgcn_s_sleep(8);
    }
#endif
}

extern "C" void kernel_launch(void* const* d_in, const int* in_sizes, int n_in, void* d_out, int out_size, void* d_ws, size_t ws_size, hipStream_t stream) {
    static int grid = 0;
    if (grid == 0) {
        if (n_in != 23 || ws_size < WS_END) { fprintf(stderr, "kernel_launch: n_in %d ws %zu need %zu\n", n_in, ws_size, (size_t)WS_END); grid = -1; return; }
        int dev = 0, cus = 0, per_cu = 0;
        hipGetDevice(&dev); hipDeviceGetAttribute(&cus, hipDeviceAttributeMultiprocessorCount, dev);
        hipFuncSetAttribute((const void*)mk, hipFuncAttributeMaxDynamicSharedMemorySize, LDS_BYTES);
        hipOccupancyMaxActiveBlocksPerMultiprocessor(&per_cu, (const void*)mk, NTHREADS, LDS_BYTES);
        (void)hipGetLastError();
        grid = cus * (per_cu >= 1 ? 1 : 0);
        if (grid != 256) { fprintf(stderr, "kernel_launch: occupancy %d cus %d\n", per_cu, cus); grid = -1; return; }
    }
    if (grid < 0) return;
    hipMemsetAsync((char*)d_ws + WS_ZERO, 0, ZERO_BYTES, stream);
    Params p{};
    for (int i = 0; i < 23; ++i) p.in[i] = (const float*)d_in[i];
    p.out = (float*)d_out; p.ws = (unsigned char*)d_ws;
    int lo = 0, hi = PH_END;
    void* args[] = {&p, &lo, &hi};
    hipError_t e = hipLaunchCooperativeKernel((const void*)mk, dim3(grid), dim3(NTHREADS), args, LDS_BYTES, stream);
    if (e != hipSuccess) fprintf(stderr, "cooperative launch failed: %s (grid %d)\n", hipGetErrorString(e), grid);
}
```

```cpp
#include <hip/hip_runtime.h>
#include <hip/hip_cooperative_groups.h>
#include <cstdio>
#include <cstdint>
#ifndef TIMING
#define TIMING 0
#endif
#ifndef TIMING_GPH
#define TIMING_GPH -1
#endif
#ifndef TIMING_SEL
#define TIMING_SEL 0
#endif
#ifndef TIMING_SPH
#define TIMING_SPH -1
#endif
#ifndef TIMING_STAT
#define TIMING_STAT 0
#endif
#ifndef TIMING_VB
#define TIMING_VB 0
#endif
namespace cg = cooperative_groups;

constexpr int D = 1024, NB = 8, SEQ = 4096, CL = 256, RB = SEQ + CL  , M = NB * RB  ;
constexpr int INW = 3584, NEXP = 32, DE = 512, NSLOT = M * 2, NSLOT_PAD = NSLOT + NEXP * 256, MT_MAX = NSLOT_PAD / 256;
constexpr float EPS = 1e-6f;

namespace pg8 {
#define PG8_LAS __attribute__((address_space(3)))
typedef unsigned short bf16_t;
typedef short bf16x8 __attribute__((ext_vector_type(8)));
typedef float f32x4 __attribute__((ext_vector_type(4)));
typedef unsigned u32x4 __attribute__((ext_vector_type(4)));
constexpr int BM = 256, BK = 64, HALF = 128, HTB = HALF * BK * 2  , STAGE_BYTES = 8 * HTB, NXCD = 8, WGM = 8;

__host__ __device__ __forceinline__ int lds_byte(int r, int c) { const int st = (r >> 4) * 2 + (c >> 5), rr = r & 15, cc = c & 31, ob = rr * 64 + cc * 2; return st * 1024 + (ob ^ (((ob >> 9) & 1) << 5)); }
__host__ __device__ __forceinline__ void stage_rc(int b, int& R, int& C) { const int st = b / 1024, sb = b % 1024, swz = sb ^ (((sb >> 9) & 1) << 5); R = (st >> 1) * 16 + swz / 64; C = (st & 1) * 32 + (swz % 64) / 2; }
__host__ __device__ __forceinline__ int perm32(int rho) { const int n = rho >> 4, i = rho & 15; return 8 * (i >> 2) + 4 * n + (i & 3); }

struct Unit { int pm, pn, pb; };
struct Gemm { const bf16_t* A; const bf16_t* Bt; int M, N, K; const bf16_t* Bt2 = nullptr; int bsplit = 0x7fffffff; };

struct StaticOrder {
    int nM, nN, nwg, G, c;
    __host__ __device__ void init(int M, int N, int G_, int c_) { nM = M / BM; nN = N / BM; nwg = nM * nN; G = G_; c = c_; }
    __host__ __device__ bool next(int i, Unit& u) const {
        const long L = (long)i * G + c; if (L >= nwg) return false;
        int wgid = (int)L; { const int q = nwg / NXCD, r = nwg % NXCD, xcd = wgid % NXCD, off = wgid / NXCD; wgid = (xcd < r ? xcd * (q + 1) : r * (q + 1) + (xcd - r) * q) + off; }
        const int nig = WGM * nN, gid = wgid / nig, fm = gid * WGM, gsz = (nM - fm) < WGM ? (nM - fm) : WGM;
        u.pm = fm + ((wgid % nig) % gsz); u.pn = (wgid % nig) / gsz; u.pb = u.pn; return true;
    }
    __device__ __forceinline__ void a_ready(const Unit&) const {}
    __device__ __forceinline__ void done(const Unit&) const {}
};

__device__ __forceinline__ unsigned cvt_pk_bf16(float lo, float hi) { unsigned r; asm volatile("v_cvt_pk_bf16_f32 %0, %1, %2" : "=v"(r) : "v"(lo), "v"(hi)); return r; }
typedef float f32x2 __attribute__((ext_vector_type(2)));
struct DenseOrder {
    int nM, nN, nwg, G, c, lat_only, base, lim;
    __device__ void init(int nM_, int nN_, int G_, int c_, int lat_only_, int base_ = 0, int lim_ = -1) { nM = nM_; nN = nN_; nwg = nM * nN; G = G_; c = c_; lat_only = lat_only_; base = base_; lim = lim_ < 0 ? nwg : lim_; }
    __device__ bool next(int i, Unit& u) const {
        const long L = (long)base + (long)i * G + c; if (L >= lim) return false;
        int wgid = (int)L; { const int q = nwg / NXCD, r = nwg % NXCD, xcd = wgid % NXCD, off = wgid / NXCD; wgid = (xcd < r ? xcd * (q + 1) : r * (q + 1) + (xcd - r) * q) + off; }
        const int nig = WGM * nN, gid = wgid / nig, fm = gid * WGM, gsz = (nM - fm) < WGM ? (nM - fm) : WGM;
        int pm = fm + ((wgid % nig) % gsz); u.pn = (wgid % nig) / gsz; u.pb = u.pn;
        if (lat_only) pm = (pm >> 4) * 17 + (pm & 15);
        u.pm = pm; return true;
    }
    __device__ __forceinline__ void a_ready(const Unit&) const {}
    __device__ __forceinline__ void done(const Unit&) const {}
};
struct OneUnit {
    Unit u;
    __device__ bool next(int i, Unit& o) const { if (i > 0) return false; o = u; return true; }
    __device__ __forceinline__ void a_ready(const Unit&) const {}
    __device__ __forceinline__ void done(const Unit&) const {}
};
struct MoeOrder {
    const PG8_LAS int* tile_e; int nM, nN, nwg, G, c, nbt;
    __device__ void init(const PG8_LAS int* te, int nM_, int nN_, int G_, int c_, int nbt_) { tile_e = te; nM = nM_; nN = nN_; nwg = nM * nN; G = G_; c = c_; nbt = nbt_; }
    __device__ bool next(int i, Unit& u) const {
        const long L = (long)i * G + c; if (L >= nwg) return false;
        int wgid = (int)L; { const int q = nwg / NXCD, r = nwg % NXCD, xcd = wgid % NXCD, off = wgid / NXCD; wgid = (xcd < r ? xcd * (q + 1) : r * (q + 1) + (xcd - r) * q) + off; }
        const int nig = WGM * nN, gid = wgid / nig, fm = gid * WGM, gsz = (nM - fm) < WGM ? (nM - fm) : WGM;
        u.pm = fm + ((wgid % nig) % gsz); u.pn = (wgid % nig) / gsz;
        u.pb = __builtin_amdgcn_readfirstlane(tile_e[u.pm]) * nbt + u.pn; return true;
    }
    __device__ __forceinline__ void a_ready(const Unit&) const {}
    __device__ __forceinline__ void done(const Unit&) const {}
};

__device__ __forceinline__ float fast_silu(float x) { return x * __builtin_amdgcn_rcpf(1.f + __expf(-x)); }
struct EpiStoreBf16 {
    static constexpr bool PERM = true, AFTER_DRAIN = false; static constexpr int NST = 16;
    bf16_t* O; int ldc;
    __device__ __forceinline__ void operator()(const f32x4 (&acc)[2][2][4][2], const Unit& u, int wr, int wc, int fr, int fq) const {
        const int row0 = u.pm * BM + wr * 64 + fr, col0 = u.pn * BM + wc * 32 + 8 * fq;
#pragma unroll
        for (int ai = 0; ai < 2; ++ai)
#pragma unroll
            for (int m = 0; m < 4; ++m) { bf16_t* rowp = O + (size_t)(row0 + ai * HALF + m * 16) * ldc + col0;
#pragma unroll
                for (int bj = 0; bj < 2; ++bj) { const f32x4 v0 = acc[ai][bj][m][0], v1 = acc[ai][bj][m][1];
                    u32x4 w; w.x = cvt_pk_bf16(v0[0], v0[1]); w.y = cvt_pk_bf16(v0[2], v0[3]); w.z = cvt_pk_bf16(v1[0], v1[1]); w.w = cvt_pk_bf16(v1[2], v1[3]);
                    *(u32x4*)(rowp + bj * HALF) = w; } }
    }
};
struct EpiSwiglu {
    static constexpr bool PERM = true, AFTER_DRAIN = false; static constexpr int NST = 8;
    bf16_t* ACT;
    __device__ __forceinline__ void operator()(const f32x4 (&acc)[2][2][4][2], const Unit& u, int wr, int wc, int fr, int fq) const {
        const int row0 = u.pm * BM + wr * 64 + fr, col0 = u.pn * HALF + wc * 32 + 8 * fq;
#pragma unroll
        for (int ai = 0; ai < 2; ++ai)
#pragma unroll
            for (int m = 0; m < 4; ++m) { bf16_t* rowp = ACT + (size_t)(row0 + ai * HALF + m * 16) * DE + col0;
                const f32x4 g0 = acc[ai][0][m][0], g1 = acc[ai][0][m][1], u0 = acc[ai][1][m][0], u1 = acc[ai][1][m][1];
                u32x4 w; w.x = cvt_pk_bf16(fast_silu(g0[0]) * u0[0], fast_silu(g0[1]) * u0[1]); w.y = cvt_pk_bf16(fast_silu(g0[2]) * u0[2], fast_silu(g0[3]) * u0[3]);
                w.z = cvt_pk_bf16(fast_silu(g1[0]) * u1[0], fast_silu(g1[1]) * u1[1]); w.w = cvt_pk_bf16(fast_silu(g1[2]) * u1[2], fast_silu(g1[3]) * u1[3]);
                *(u32x4*)rowp = w; }
    }
};
#define DPP_F(x, ctrl) __uint_as_float((unsigned)__builtin_amdgcn_update_dpp(0, (int)__float_as_uint(x), (ctrl), 0xf, 0xf, false))
__device__ __forceinline__ float row_allsum16(float x) { x += DPP_F(x, 0xB1); x += DPP_F(x, 0x4E); x += DPP_F(x, 0x141); x += DPP_F(x, 0x140); return x; }
__device__ __forceinline__ float row_incl_scan16(float x) { x += DPP_F(x, 0x111); x += DPP_F(x, 0x112); x += DPP_F(x, 0x114); x += DPP_F(x, 0x118); return x; }
#define DPP_M(x, ctrl) __uint_as_float((unsigned)__builtin_amdgcn_update_dpp(0x3f800000, (int)__float_as_uint(x), (ctrl), 0xf, 0xf, false))
#define DPP4(op) "v_mul_f32_dpp %0, %0, %0 " op " row_mask:0xf bank_mask:0xf\n\tv_mul_f32_dpp %1, %1, %1 " op " row_mask:0xf bank_mask:0xf\n\tv_mul_f32_dpp %2, %2, %2 " op " row_mask:0xf bank_mask:0xf\n\tv_mul_f32_dpp %3, %3, %3 " op " row_mask:0xf bank_mask:0xf\n\t"
#define DPP22(opa, opc) "v_mul_f32_dpp %0, %0, %0 " opa " row_mask:0xf bank_mask:0xf\n\tv_mul_f32_dpp %1, %1, %1 " opa " row_mask:0xf bank_mask:0xf\n\tv_mul_f32_dpp %2, %2, %2 " opc " row_mask:0xf bank_mask:0xf\n\tv_mul_f32_dpp %3, %3, %3 " opc " row_mask:0xf bank_mask:0xf\n\t"
__device__ __forceinline__ void row_allprod16x4(float& a, float& b, float& c, float& d) {
    asm volatile("s_nop 1\n\t" DPP4("quad_perm:[1,0,3,2]") DPP4("quad_perm:[2,3,0,1]") DPP4("row_half_mirror") DPP4("row_mirror") : "+v"(a), "+v"(b), "+v"(c), "+v"(d));
}
__device__ __forceinline__ void row_scan_prod16_sspp(float& a, float& b, float& c, float& d) {
    asm volatile("s_nop 1\n\t" DPP22("row_shl:1", "row_shr:1") DPP22("row_shl:2", "row_shr:2") DPP22("row_shl:4", "row_shr:4") DPP22("row_shl:8", "row_shr:8") : "+v"(a), "+v"(b), "+v"(c), "+v"(d));
}
__device__ __forceinline__ float fast_sigmoid(float x) { return __builtin_amdgcn_rcpf(1.f + __expf(-x)); }
__device__ __forceinline__ float fast_gelu(float x) { return x * fast_sigmoid(1.5957691216057308f * (x + 0.044715f * x * x * x)); }
__device__ __forceinline__ bf16_t bf16_1(float x) { return (bf16_t)(cvt_pk_bf16(x, 0.f) & 0xffffu); }
struct EpiInProj {
    static constexpr bool PERM = true, AFTER_DRAIN = false; static constexpr int NST = 16;
    bf16_t *QA, *KB, *KDT, *VT, *SG, *GU, *GVT; float *EREF, *DEC, *SSV; const float* LBV; const float* vgain; size_t dstride; int nch; PG8_LAS unsigned char* img;
    __device__ __forceinline__ void operator()(const f32x4 (&acc)[2][2][4][2], const Unit& u, int wr, int wc, int fr, int fq) const {
        if (u.pn < 8) hgrn(acc, u, wr, wc, fr, fq); else if (u.pn < 12) actv(acc, u, wr, wc, fr, fq); else vtile(acc, u, wr, wc, fr, fq);
    }
    __device__ __forceinline__ void flush_img(bf16_t* G, unsigned rd, size_t eo0, size_t eo1) const {
        typedef unsigned u32x2v __attribute__((ext_vector_type(2)));
        u32x2v r0, r1, r2, r3;
        asm volatile("ds_read_b64_tr_b16 %0, %4\n\tds_read_b64_tr_b16 %1, %4 offset:160\n\tds_read_b64_tr_b16 %2, %4 offset:1280\n\tds_read_b64_tr_b16 %3, %4 offset:1440\n\ts_waitcnt lgkmcnt(0)"
                     : "=&v"(r0), "=&v"(r1), "=&v"(r2), "=&v"(r3) : "v"(rd) : "memory");
        *(u32x4*)(G + eo0) = (u32x4){r0.x, r0.y, r1.x, r1.y}; *(u32x4*)(G + eo1) = (u32x4){r2.x, r2.y, r3.x, r3.y};
    }
    __device__ __forceinline__ void hgrn(const f32x4 (&acc)[2][2][4][2], const Unit& u, int wr, int wc, int fr, int fq) const {
        const int h = u.pn >> 1, dloc = (u.pn & 1) * 64 + 16 * wc + 4 * fq, dcol = h * 128 + dloc;
        const f32x4 lbf = *(const f32x4*)(LBV + dcol), lbb = *(const f32x4*)(LBV + 512 + dcol);
        PG8_LAS unsigned char* im = img + (wr * 4 + wc) * 2560;
        PG8_LAS unsigned char* wp = im + fr * 40 + fq * 8;
        const int lg = fq, li = fr;
        const unsigned rd = (unsigned)(size_t)im + (unsigned)((8 * lg + (li >> 2)) * 40 + (li & 3) * 8);
        typedef unsigned u32x2v __attribute__((ext_vector_type(2)));
#pragma unroll
        for (int ai = 0; ai < 2; ++ai) {
            const int rowc = u.pm * BM + ai * HALF + wr * 64, gc = rowc >> 6;
            const size_t cb = ((size_t)(gc * 4 + h) * 4 + (dloc >> 5)) * 4;
            const size_t eo0 = (((cb + (lg >> 1)) * 64) + 16 * (wc & 1) + li + 32 * (lg & 1)) * 8, eo1 = eo0 + (size_t)2 * 64 * 8;
#pragma unroll
            for (int dir = 0; dir < 2; ++dir) {
                unsigned pqa[4][2], pkb[4][2]; float hqa[4], hkb[4], hkd[4];
#pragma unroll
                for (int e = 0; e < 4; ++e) {
                    const float lb = dir ? lbb[e] : lbf[e];
                    float f[4], kk[4], T[4], Dm[4];
#pragma unroll
                    for (int m = 0; m < 4; ++m) { const float z = dir ? acc[ai][1][m][0][e] : acc[ai][0][m][1][e]; const float sig = fast_sigmoid(z);
                        f[m] = lb + (1.f - lb) * sig; kk[m] = (1.f - lb) * (1.f - sig); }
#pragma unroll
                    for (int m = 0; m < 4; ++m) T[m] = f[m];
                    row_allprod16x4(T[0], T[1], T[2], T[3]);
                    if (dir == 0) { Dm[0] = DPP_M(f[0], 0x101); Dm[1] = DPP_M(f[1], 0x101); Dm[2] = f[2]; Dm[3] = f[3]; }
                    else { Dm[0] = f[0]; Dm[1] = f[1]; Dm[2] = DPP_M(f[2], 0x111); Dm[3] = DPP_M(f[3], 0x111); }
                    row_scan_prod16_sspp(Dm[0], Dm[1], Dm[2], Dm[3]);
                    Dm[0] *= T[1]; Dm[3] *= T[2];
                    const float p01 = T[0] * T[1], p23 = T[2] * T[3];
                    const float etr = dir ? p01 : p23, eref = dir ? p23 : p01, edec = p01 * p23;
#pragma unroll
                    for (int m = 0; m < 4; ++m) { const float q = acc[ai][0][m][0][e]; const float Di = __builtin_amdgcn_rcpf(Dm[m]);
                        const bool d_is_e = dir ? (m < 2) : (m >= 2);
                        const float qa = q * (d_is_e ? Dm[m] : Di), kb = kk[m] * (d_is_e ? Di : Dm[m]), kd = kb * etr;
                        if (e & 1) { pqa[m][e >> 1] = cvt_pk_bf16(hqa[m], qa); pkb[m][e >> 1] = cvt_pk_bf16(hkb[m], kb); *(PG8_LAS unsigned*)(wp + m * 640 + (e >> 1) * 4) = cvt_pk_bf16(hkd[m], kd); }
                        else { hqa[m] = qa; hkb[m] = kb; hkd[m] = kd; } }
                    if (fr == 0) { EREF[((size_t)dir * nch + gc) * 512 + dcol + e] = eref; DEC[((size_t)dir * nch + gc) * 512 + dcol + e] = edec; }
                }
                flush_img(KDT + dir * dstride, rd, eo0, eo1);
#pragma unroll
                for (int m = 0; m < 4; ++m) {
                    const size_t o = dir * dstride + (((((size_t)(gc * 4 + h) * 2 + (m >> 1)) * 8 + (dloc >> 4)) * 64) + 16 * (m & 1) + fr + 32 * (fq & 1)) * 8 + 4 * (fq >> 1);
                    *(u32x2v*)(QA + o) = (u32x2v){pqa[m][0], pqa[m][1]}; *(u32x2v*)(KB + o) = (u32x2v){pkb[m][0], pkb[m][1]}; }
            }
#pragma unroll
            for (int m = 0; m < 4; ++m) { const f32x4 v = acc[ai][1][m][1]; *(PG8_LAS u32x2v*)(wp + m * 640) = (u32x2v){cvt_pk_bf16(v[0], v[1]), cvt_pk_bf16(v[2], v[3])}; }
            flush_img(VT, rd, eo0, eo1);
        }
    }
    __device__ __forceinline__ void actv(const f32x4 (&acc)[2][2][4][2], const Unit& u, int wr, int wc, int fr, int fq) const {
        const bool isu = u.pn >= 10; bf16_t* O = isu ? GU : SG;
        const int row0 = u.pm * BM + wr * 64 + fr, col0 = (u.pn & 1) * 256 + wc * 32 + 8 * fq;
#pragma unroll
        for (int ai = 0; ai < 2; ++ai)
#pragma unroll
            for (int m = 0; m < 4; ++m) { bf16_t* rowp = O + (size_t)(row0 + ai * HALF + m * 16) * 512 + col0;
#pragma unroll
                for (int bj = 0; bj < 2; ++bj) { float v[8];
#pragma unroll
                    for (int i = 0; i < 8; ++i) v[i] = acc[ai][bj][m][i >> 2][i & 3];
                    u32x4 w; w.x = cvt_pk_bf16(v[0], v[1]); w.y = cvt_pk_bf16(v[2], v[3]); w.z = cvt_pk_bf16(v[4], v[5]); w.w = cvt_pk_bf16(v[6], v[7]);
                    *(u32x4*)(rowp + bj * HALF) = w; } }
    }
    __device__ __forceinline__ void vtile(const f32x4 (&acc)[2][2][4][2], const Unit& u, int wr, int wc, int fr, int fq) const {
        const int ch0 = (u.pn & 1) * 256 + wc * 32 + 8 * fq;
        f32x4 gn[2][2];
#pragma unroll
        for (int bj = 0; bj < 2; ++bj)
#pragma unroll
            for (int n = 0; n < 2; ++n) gn[bj][n] = *(const f32x4*)(vgain + ch0 + bj * HALF + 4 * n);
        float c044 = 0.044715f; asm volatile("" : "+s"(c044));
#define GELU_V(x_) ((x_) * fast_sigmoid(1.5957691216057308f * ((x_) + c044 * (x_) * (x_) * (x_))))
        int lg = fq, li = fr; asm volatile("" : "+v"(lg), "+v"(li));
        PG8_LAS unsigned char* im = img + (wr * 4 + wc) * 2560;
        PG8_LAS unsigned char* wp = im + li * 80 + lg * 16;
        const unsigned rd = (unsigned)(size_t)im + (unsigned)((8 * lg + (li >> 2)) * 80 + (li & 3) * 8);
        typedef unsigned u32x2v __attribute__((ext_vector_type(2)));
#pragma unroll
        for (int ai = 0; ai < 2; ++ai) { const int gc2 = u.pm * 2 + ai; float ssum[4] = {0.f, 0.f, 0.f, 0.f};
#pragma unroll
            for (int bj = 0; bj < 2; ++bj)
#pragma unroll
                for (int m = 0; m < 4; ++m) { const int mh = m >> 1, mm = m & 1;
                    const f32x4 a0 = acc[ai][bj][m][0], a1 = acc[ai][bj][m][1];
                    const float g0 = GELU_V(a0[0]), g1 = GELU_V(a0[1]), g2 = GELU_V(a0[2]), g3 = GELU_V(a0[3]), g4 = GELU_V(a1[0]), g5 = GELU_V(a1[1]), g6 = GELU_V(a1[2]), g7 = GELU_V(a1[3]);
                    ssum[m] += ((g0 * g0 + g1 * g1) + (g2 * g2 + g3 * g3)) + ((g4 * g4 + g5 * g5) + (g6 * g6 + g7 * g7));
                    const f32x4 n0 = gn[bj][0], n1 = gn[bj][1];
                    *(PG8_LAS u32x4*)(wp + mm * 1280) = (u32x4){cvt_pk_bf16(g0 * n0[0], g1 * n0[1]), cvt_pk_bf16(g2 * n0[2], g3 * n0[3]), cvt_pk_bf16(g4 * n1[0], g5 * n1[1]), cvt_pk_bf16(g6 * n1[2], g7 * n1[3])};
                    if (mm == 1) {
                        u32x2v r0, r1, r2, r3;
                        asm volatile("ds_read_b64_tr_b16 %0, %4\n\tds_read_b64_tr_b16 %1, %4 offset:320\n\tds_read_b64_tr_b16 %2, %4 offset:32\n\tds_read_b64_tr_b16 %3, %4 offset:352\n\ts_waitcnt lgkmcnt(0)"
                                     : "=&v"(r0), "=&v"(r1), "=&v"(r2), "=&v"(r3) : "v"(rd) : "memory");
                        const size_t eo = (((((size_t)(gc2 * 4 + 2 * (u.pn & 1) + bj) * 4 + wc) * 8 + 4 * wr + 2 * mh + (lg >> 1)) * 64) + li + 32 * (lg & 1)) * 8;
                        *(u32x4*)(GVT + eo) = (u32x4){r0.x, r0.y, r1.x, r1.y}; *(u32x4*)(GVT + eo + 16 * 8) = (u32x4){r2.x, r2.y, r3.x, r3.y}; }
                    __builtin_amdgcn_sched_barrier(0);
                }
#pragma unroll
            for (int m = 0; m < 4; ++m) { const int tok = wr * 64 + 16 * m + fr; float sv = ssum[m];
                sv += __shfl_xor(sv, 16); sv += __shfl_xor(sv, 32);
                if (fq == 0) atomicAdd(SSV + gc2 * 128 + tok, sv); } }
#undef GELU_V
    }
};
struct EpiResid {
    static constexpr bool PERM = false, AFTER_DRAIN = false; static constexpr int NST = 32;
    const float* src_lat; const float* src_ctx; float* dst_lat; float* dst_ctx; const float* modl; float* ss;
    __device__ __forceinline__ void operator()(const f32x4 (&acc)[2][2][4][2], const Unit& u, int wr, int wc, int fr, int fq) const {
        const int b = u.pm / 17, j = u.pm % 17; const bool isctx = j == 16;
        const size_t trow = isctx ? (size_t)b * CL : (size_t)b * SEQ + (size_t)j * 256;
        const float* sb = (isctx ? src_ctx : src_lat) + trow * D; float* db = (isctx ? dst_ctx : dst_lat) + trow * D;
        const float* g1 = modl + (size_t)(isctx ? 8 : b) * 6144 + 2 * 1024;
        const int col0 = u.pn * BM + wc * 32 + 4 * fq;
        f32x4 gv[2][2];
#pragma unroll
        for (int bj = 0; bj < 2; ++bj)
#pragma unroll
            for (int n = 0; n < 2; ++n) gv[bj][n] = *(const f32x4*)(g1 + col0 + bj * HALF + n * 16);
#pragma unroll
        for (int ai = 0; ai < 2; ++ai) {
            f32x4 xs[4][2][2];
#pragma unroll
            for (int m = 0; m < 4; ++m) { const size_t off = (size_t)(ai * HALF + wr * 64 + m * 16 + fr) * D + col0;
#pragma unroll
                for (int bj = 0; bj < 2; ++bj)
#pragma unroll
                    for (int n = 0; n < 2; ++n) xs[m][bj][n] = *(const f32x4*)(sb + off + bj * HALF + n * 16); }
            __builtin_amdgcn_sched_barrier(0);
#pragma unroll
            for (int m = 0; m < 4; ++m) { const int rt = ai * HALF + wr * 64 + m * 16 + fr; const size_t off = (size_t)rt * D + col0; float s = 0.f;
#pragma unroll
                for (int bj = 0; bj < 2; ++bj)
#pragma unroll
                    for (int n = 0; n < 2; ++n) { const f32x4 o = xs[m][bj][n] + gv[bj][n] * acc[ai][bj][m][n];
                        *(f32x4*)(db + off + bj * HALF + n * 16) = o; s += (o[0] * o[0] + o[1] * o[1]) + (o[2] * o[2] + o[3] * o[3]); }
                s += __shfl_xor(s, 16); s += __shfl_xor(s, 32);
                if (fq == 0) atomicAdd(ss + u.pm * BM + rt, s); } }
    }
};
template <class Epi, class Sched, bool ALIGN_EPI = false, bool SP2 = false, bool GATHER = false>
__device__ __forceinline__ void gemm_phase(PG8_LAS unsigned char* lds, const Gemm g, const Sched& S, const Epi& E, const int tid_in, const PG8_LAS int* rmap = nullptr) {
    const int tid = tid_in, wid = __builtin_amdgcn_readfirstlane(tid >> 6), lane = tid & 63, wr = wid >> 2, wc = wid & 3, fr = lane & 15, fq = lane >> 4;
    const int K = g.K, nt = K / BK;
    unsigned voffA[2], voffB[2]; int gR[2], gC[2];
#pragma unroll
    for (int i = 0; i < 2; ++i) { int R, C; stage_rc(tid * 16 + i * 8192, R, C); const int Rb = Epi::PERM ? ((R & ~31) + perm32(R & 31)) : R;
        voffA[i] = (unsigned)(R * K + C) * 2u; voffB[i] = (unsigned)(Rb * K + C) * 2u; gR[i] = R; gC[i] = C; }
    unsigned vA0[2] = {voffA[0], voffA[1]}, vA1[2] = {voffA[0], voffA[1]}, nV0[2] = {voffA[0], voffA[1]}, nV1[2] = {voffA[0], voffA[1]};
#define PG8_GOFF(slot, o0, o1) do { const PG8_LAS int* _rm = rmap + (slot) * 256; _Pragma("unroll") for (int _i = 0; _i < 2; ++_i) { \
        o0[_i] = ((unsigned)_rm[gR[_i]] * (unsigned)K + (unsigned)gC[_i]) * 2u; o1[_i] = ((unsigned)_rm[128 + gR[_i]] * (unsigned)K + (unsigned)gC[_i]) * 2u; } } while (0)
    const size_t kstep = (size_t)(BK * 2);
    const size_t hstep = (size_t)HALF * K * 2;
    const size_t tstep = 2 * hstep;
    const size_t hstepA = GATHER ? 0 : hstep, tstepA = GATHER ? 0 : tstep;
    const unsigned ldsw = (unsigned)wid * 1024u;
    const int aoff = lds_byte(wr * 64 + fr, fq * 8), boff = lds_byte(wc * 32 + fr, fq * 8);
#define PG8_SA(b, h) (((b) * 2 + (h)) * HTB)
#define PG8_SB(b, h) ((4 + (b) * 2 + (h)) * HTB)
#define PG8_STAGE(bufoff, gbase, voff) do { _Pragma("unroll") for (int _i = 0; _i < 2; ++_i) \
        __builtin_amdgcn_global_load_lds((const unsigned*)((const char*)(gbase) + (voff)[_i]), (PG8_LAS unsigned*)(lds + (bufoff) + ldsw + _i * 8192), 16, 0, 0); } while (0)
#define PG8_LDA(dst, b, h) do { _Pragma("unroll") for (int m = 0; m < 4; ++m) _Pragma("unroll") for (int k = 0; k < 2; ++k) dst[m][k] = *(const PG8_LAS bf16x8*)(lds + PG8_SA(b, h) + aoff + m * 2048 + k * 1024); } while (0)
#define PG8_LDB(dst, b, h) do { _Pragma("unroll") for (int n = 0; n < 2; ++n) _Pragma("unroll") for (int k = 0; k < 2; ++k) dst[n][k] = *(const PG8_LAS bf16x8*)(lds + PG8_SB(b, h) + boff + n * 2048 + k * 1024); } while (0)
#define PG8_MMA(ai, bj, At, Bt) do { __builtin_amdgcn_s_setprio(1); _Pragma("unroll") for (int m = 0; m < 4; ++m) _Pragma("unroll") for (int n = 0; n < 2; ++n) _Pragma("unroll") for (int k = 0; k < 2; ++k) \
        acc[ai][bj][m][n] = __builtin_amdgcn_mfma_f32_16x16x32_bf16(Bt[n][k], At[m][k], acc[ai][bj][m][n], 0, 0, 0); __builtin_amdgcn_s_setprio(0); } while (0)
#define PG8_WAIT_V(n) asm volatile("s_waitcnt vmcnt(" #n ")" ::: "memory")
#define PG8_WAIT_L(n) asm volatile("s_waitcnt lgkmcnt(" #n ")" ::: "memory")
#define PG8_BAR __builtin_amdgcn_s_barrier()
#define PG8_SCHED __builtin_amdgcn_sched_barrier(0)
    Unit cur, nxt; int ui = 0;
    if (!S.next(0, cur)) return;
#if TIMING && TIMING_GPH >= 0
#define PG8_TST ((PG8_LAS unsigned long long*)(unsigned)(160 * 1024 - 1024))
#define PG8_TMARK(slot) do { if (tid == 0) { if (PG8_TST[127] != 0) PG8_TST[slot] = __builtin_amdgcn_s_memrealtime(); } } while (0)
#define PG8_TDIFF(accslot, fromslot) do { if (tid == 0) { if (PG8_TST[127] != 0) PG8_TST[accslot] += __builtin_amdgcn_s_memrealtime() - PG8_TST[fromslot]; } } while (0)
#else
#define PG8_TMARK(slot) do {} while (0)
#define PG8_TDIFF(accslot, fromslot) do {} while (0)
#endif
    f32x4 acc[2][2][4][2];
#pragma unroll
    for (int a = 0; a < 2; ++a)
#pragma unroll
        for (int b = 0; b < 2; ++b)
#pragma unroll
            for (int m = 0; m < 4; ++m)
#pragma unroll
                for (int n = 0; n < 2; ++n) acc[a][b][m][n] = (f32x4){0.f, 0.f, 0.f, 0.f};
    bf16x8 At[4][2], B0[2][2], B1[2][2];
    const char* cA = (const char*)g.A + (size_t)cur.pm * tstepA; const char* cB = (const char*)(cur.pb < g.bsplit ? g.Bt : g.Bt2) + (size_t)cur.pb * tstep;
    if constexpr (GATHER) PG8_GOFF(0, vA0, vA1);
    S.a_ready(cur);
    if constexpr (SP2) {
        PG8_STAGE(PG8_SB(0, 0), cB, voffB); PG8_STAGE(PG8_SB(0, 1), cB + hstep, voffB); PG8_STAGE(PG8_SA(0, 0), cA, vA0); PG8_STAGE(PG8_SA(0, 1), cA + hstepA, vA1);
        if (wr == 1) PG8_BAR;
        PG8_WAIT_V(2); PG8_BAR;
        PG8_STAGE(PG8_SB(1, 0), cB + kstep, voffB); PG8_STAGE(PG8_SA(1, 0), cA + kstep, vA0); PG8_STAGE(PG8_SB(1, 1), cB + hstep + kstep, voffB);
        PG8_WAIT_V(6); PG8_BAR;
    } else {
        PG8_STAGE(PG8_SB(0, 0), cB, voffB); PG8_STAGE(PG8_SA(0, 0), cA, voffA); PG8_STAGE(PG8_SB(0, 1), cB + hstep, voffB); PG8_STAGE(PG8_SA(0, 1), cA + hstep, voffA);
        if (wr == 1) PG8_BAR;
        PG8_WAIT_V(4); PG8_BAR;
        PG8_STAGE(PG8_SB(1, 0), cB + kstep, voffB); PG8_STAGE(PG8_SA(1, 0), cA + kstep, voffA); PG8_STAGE(PG8_SB(1, 1), cB + hstep + kstep, voffB);
        PG8_WAIT_V(6); PG8_BAR;
    }
    for (;;) {
        const bool has_next = S.next(ui + 1, nxt);
        const char* nA = has_next ? (const char*)g.A + (size_t)nxt.pm * tstepA : cA; const char* nB = has_next ? (const char*)(nxt.pb < g.bsplit ? g.Bt : g.Bt2) + (size_t)nxt.pb * tstep : cB;
        PG8_TMARK(72);
        if constexpr (GATHER) { if (has_next) PG8_GOFF(ui + 1, nV0, nV1); else { nV0[0] = vA0[0]; nV0[1] = vA0[1]; nV1[0] = vA1[0]; nV1[1] = vA1[1]; } }
        for (int t = 0; t < nt; t += 2) {
            const bool last = (t == nt - 2);
            const char* a1 = cA + (size_t)(t + 1) * kstep;
            const char* a2 = last ? nA : cA + (size_t)(t + 2) * kstep; const char* b2 = last ? nB : cB + (size_t)(t + 2) * kstep;
            const char* a3 = a2 + kstep; const char* b3 = b2 + kstep;
            const unsigned sA0[2] = {last ? nV0[0] : vA0[0], last ? nV0[1] : vA0[1]}, sA1[2] = {last ? nV1[0] : vA1[0], last ? nV1[1] : vA1[1]};
            if (last && has_next) S.a_ready(nxt);
            const int relax = __builtin_amdgcn_readfirstlane((ui > 0 && t == 0) ? 1 : 0);
#define PG8_WAIT_V8R asm volatile("s_cmp_lg_u32 %0, 0\n\ts_cbranch_scc1 .Lpg8r%=\n\ts_waitcnt vmcnt(8)\n\ts_branch .Lpg8e%=\n.Lpg8r%=:\n\ts_waitcnt vmcnt(%1)\n.Lpg8e%=:" :: "s"(relax), "n"(8 + Epi::NST) : "memory", "scc")
            if constexpr (SP2) {
            PG8_LDB(B0, 0, 0); PG8_LDB(B1, 0, 1); PG8_SCHED; PG8_LDA(At, 0, 0); PG8_STAGE(PG8_SA(1, 1), a1 + hstepA, vA1);
            PG8_WAIT_V8R; PG8_WAIT_L(0); PG8_BAR; PG8_MMA(0, 0, At, B0); PG8_MMA(0, 1, At, B1); PG8_BAR; PG8_SCHED;
            PG8_LDA(At, 0, 1); PG8_STAGE(PG8_SB(0, 0), b2, voffB); PG8_STAGE(PG8_SB(0, 1), b2 + hstep, voffB); PG8_STAGE(PG8_SA(0, 0), a2, sA0);
            PG8_WAIT_V8R; PG8_WAIT_L(0); PG8_BAR; PG8_MMA(1, 0, At, B0); PG8_MMA(1, 1, At, B1); PG8_BAR; PG8_SCHED;
            PG8_LDB(B0, 1, 0); PG8_LDB(B1, 1, 1); PG8_SCHED; PG8_LDA(At, 1, 0); PG8_STAGE(PG8_SA(0, 1), a2 + hstepA, sA1);
            PG8_WAIT_V(8); PG8_WAIT_L(0); PG8_BAR; PG8_MMA(0, 0, At, B0); PG8_MMA(0, 1, At, B1); PG8_BAR; PG8_SCHED;
            PG8_LDA(At, 1, 1); PG8_STAGE(PG8_SB(1, 0), b3, voffB); PG8_STAGE(PG8_SB(1, 1), b3 + hstep, voffB); PG8_STAGE(PG8_SA(1, 0), a3, sA0);
            PG8_WAIT_V(8); PG8_WAIT_L(0); PG8_BAR; PG8_MMA(1, 0, At, B0); PG8_MMA(1, 1, At, B1); PG8_BAR; PG8_SCHED;
#if TIMING
#endif
            } else {
            PG8_LDB(B0, 0, 0); PG8_SCHED; PG8_LDA(At, 0, 0); PG8_STAGE(PG8_SA(1, 1), a1 + hstep, voffA);
            PG8_WAIT_L(8); PG8_BAR; PG8_WAIT_L(0); PG8_MMA(0, 0, At, B0); PG8_BAR; PG8_SCHED;
            PG8_LDB(B1, 0, 1); PG8_STAGE(PG8_SB(0, 0), b2, voffB);
            PG8_BAR; PG8_WAIT_L(0); PG8_MMA(0, 1, At, B1); PG8_BAR;
            PG8_LDA(At, 0, 1); PG8_STAGE(PG8_SA(0, 0), a2, voffA);
            PG8_BAR; PG8_WAIT_L(0); PG8_MMA(1, 0, At, B0); PG8_BAR; PG8_SCHED;
            PG8_STAGE(PG8_SB(0, 1), b2 + hstep, voffB);
            PG8_WAIT_V(6); PG8_BAR; PG8_MMA(1, 1, At, B1); PG8_BAR;
            PG8_LDB(B0, 1, 0); PG8_SCHED; PG8_LDA(At, 1, 0); PG8_STAGE(PG8_SA(0, 1), a2 + hstep, voffA);
            PG8_WAIT_L(8); PG8_BAR; PG8_WAIT_L(0); PG8_MMA(0, 0, At, B0); PG8_BAR; PG8_SCHED;
            PG8_LDB(B1, 1, 1); PG8_STAGE(PG8_SB(1, 0), b3, voffB);
            PG8_BAR; PG8_WAIT_L(0); PG8_MMA(0, 1, At, B1); PG8_BAR;
            PG8_LDA(At, 1, 1); PG8_STAGE(PG8_SA(1, 0), a3, voffA);
            PG8_BAR; PG8_WAIT_L(0); PG8_MMA(1, 0, At, B0); PG8_BAR; PG8_SCHED;
            PG8_STAGE(PG8_SB(1, 1), b3 + hstep, voffB);
            PG8_WAIT_V(6); PG8_BAR; PG8_MMA(1, 1, At, B1); PG8_BAR;
            }
        }
        PG8_TDIFF(64, 72); PG8_TMARK(73);
        if constexpr (ALIGN_EPI) { if (wr == 0) PG8_BAR; }
        if constexpr (!Epi::AFTER_DRAIN) { E(acc, cur, wr, wc, fr, fq); S.done(cur); }
        PG8_TDIFF(65, 73);
        if (!has_next) break;
#pragma unroll
        for (int a = 0; a < 2; ++a)
#pragma unroll
            for (int b = 0; b < 2; ++b)
#pragma unroll
                for (int m = 0; m < 4; ++m)
#pragma unroll
                    for (int n = 0; n < 2; ++n) acc[a][b][m][n] = (f32x4){0.f, 0.f, 0.f, 0.f};
        cur = nxt; cA = nA; cB = nB; ++ui;
        if constexpr (GATHER) { vA0[0] = nV0[0]; vA0[1] = nV0[1]; vA1[0] = nV1[0]; vA1[1] = nV1[1]; }
        if constexpr (ALIGN_EPI) { if (wr == 1) PG8_BAR; }
    }
    PG8_WAIT_V(0);
    if constexpr (!ALIGN_EPI) { if (wr == 0) PG8_BAR; }
    PG8_BAR;
    if constexpr (Epi::AFTER_DRAIN) { E.fused(acc, cur, wr, wc, fr, fq, lds, wid, lane); S.done(cur); }
#undef PG8_GOFF
#undef PG8_SA
#undef PG8_SB
#undef PG8_STAGE
#undef PG8_LDA
#undef PG8_LDB
#undef PG8_MMA
#undef PG8_WAIT_V
#undef PG8_WAIT_V8R
#undef PG8_WAIT_L
#undef PG8_BAR
#undef PG8_SCHED
}
}

#define LAS __attribute__((address_space(3)))
typedef unsigned short bf16;
typedef float f32x4 __attribute__((ext_vector_type(4)));
typedef unsigned u32x4 __attribute__((ext_vector_type(4)));
typedef unsigned u32x2 __attribute__((ext_vector_type(2)));
constexpr int NWAVES = 8, NTHREADS = 512, LDS_BYTES = 160 * 1024;
#define SCHED_FENCE() __builtin_amdgcn_sched_barrier(0)

__device__ __forceinline__ unsigned f2bf(float f) { unsigned u = __float_as_uint(f); return (u + 0x7fffu + ((u >> 16) & 1u)) >> 16; }
__device__ __forceinline__ unsigned pk2(float lo, float hi) { return f2bf(lo) | (f2bf(hi) << 16); }
__device__ __forceinline__ unsigned cvt2(float lo, float hi) { return pg8::cvt_pk_bf16(lo, hi); }
__device__ __forceinline__ float bf2f(unsigned h) { return __uint_as_float(h << 16); }
#define DPPF(x, ctrl) __uint_as_float((unsigned)__builtin_amdgcn_update_dpp(0, (int)__float_as_uint(x), (ctrl), 0xf, 0xf, false))
__device__ __forceinline__ float wave_sum(float v) {
    v += DPPF(v, 0xB1); v += DPPF(v, 0x4E); v += DPPF(v, 0x141); v += DPPF(v, 0x140);
    const float s0 = __uint_as_float(__builtin_amdgcn_readlane(__float_as_uint(v), 0)), s1 = __uint_as_float(__builtin_amdgcn_readlane(__float_as_uint(v), 16));
    const float s2 = __uint_as_float(__builtin_amdgcn_readlane(__float_as_uint(v), 32)), s3 = __uint_as_float(__builtin_amdgcn_readlane(__float_as_uint(v), 48));
    return (s0 + s1) + (s2 + s3);
}
__device__ __forceinline__ float siluf(float x) { return x / (1.f + expf(-x)); }
__device__ __forceinline__ float gelu_tanh(float x) { return 0.5f * x * (1.f + tanhf(0.7978845608028654f * (x + 0.044715f * x * x * x))); }
__device__ __forceinline__ int mod_row(int row) { return ((row % RB) < SEQ) ? row / RB : 8; }
__device__ __forceinline__ bool is_ctx_row(int row) { return (row % RB) >= SEQ; }

typedef __attribute__((address_space(1))) unsigned gu32;
#define RLX_AGENT __ATOMIC_RELAXED, __HIP_MEMORY_SCOPE_AGENT
#define XB_TMO      128
#define XB_XCNT(j)  (256  + 64 * (j))
#define XB_XSUB(j)  (1280 + 64 * (j))
#define XB_XGEN(j)  (2304 + 64 * (j))
#define XB_TOP      3328
#define XB_TOPGEN   3392
#define XCD_BAR_WORDS 3456
#define XB_SPIN_CAP (1u << 18)

__device__ __forceinline__ unsigned xb_ld(unsigned* p)              { return __hip_atomic_load(p, __ATOMIC_RELAXED, __HIP_MEMORY_SCOPE_AGENT); }
__device__ __forceinline__ unsigned xb_add(unsigned* p, unsigned v) { return __hip_atomic_fetch_add(p, v, __ATOMIC_RELAXED, __HIP_MEMORY_SCOPE_AGENT); }
__device__ __forceinline__ unsigned xb_xcc_id() { return (unsigned)__builtin_amdgcn_s_getreg((3 << 11) | 20) & 0xFu; }
#define XB_SPIN(cond, bar) do { unsigned _sp = 0; while (cond) { __builtin_amdgcn_s_sleep(1); \
    if ((++_sp & 255u) == 0u) { if (xb_ld(&(bar)[XB_TMO])) break; if (_sp > XB_SPIN_CAP) { atomicAdd(&(bar)[XB_TMO], 1u); break; } } } } while (0)

struct XcdBarrier {
    unsigned* bar; unsigned x;
    volatile LAS unsigned* st;
};

__device__ __forceinline__ XcdBarrier xcd_barrier_post(unsigned* bar, volatile LAS unsigned* st) {
    XcdBarrier b; b.bar = bar; b.x = xb_xcc_id(); b.st = st;
    if (threadIdx.x == 0) (void)xb_add(&bar[XB_XCNT(b.x)], 1u);
    return b;
}
__device__ __forceinline__ void xcd_barrier_complete(unsigned* bar, unsigned x, unsigned& nloc, unsigned& nx) {
    const unsigned G = gridDim.x * gridDim.y * gridDim.z;
    unsigned sum, cnt, mine, sp = 0u;
    for (;;) {
        sum = 0u; cnt = 0u; mine = 0u;
#pragma unroll
        for (unsigned j = 0; j < 16; ++j) { const unsigned c = xb_ld(&bar[XB_XCNT(j)]); sum += c; cnt += (c > 0u) ? 1u : 0u; mine = (j == x) ? c : mine; }
        if (sum == G) break;
        __builtin_amdgcn_s_sleep(1);
        if ((++sp & 255u) == 0u) { if (xb_ld(&bar[XB_TMO])) break; if (sp > XB_SPIN_CAP) { atomicAdd(&bar[XB_TMO], 1u); break; } }
    }
    nloc = mine > 0u ? mine : 1u; nx = cnt > 0u ? cnt : 1u;
}

__device__ __forceinline__ void xcd_barrier(const XcdBarrier& b, const int xb_tid) {
    asm volatile("s_waitcnt vmcnt(0)" ::: "memory");
    __syncthreads();
    if (xb_tid == 0) {
        unsigned* bar = b.bar;
        __builtin_amdgcn_s_waitcnt(0);
        unsigned nloc = b.st[0], nx = b.st[1];
        if (nloc == 0u) { xcd_barrier_complete(bar, b.x, nloc, nx); b.st[0] = nloc; b.st[1] = nx; }
        const unsigned old = xb_add(&bar[XB_XSUB(b.x)], 1u);
        const unsigned gen = old / nloc;
        if (old + 1u == (gen + 1u) * nloc) {
            __builtin_amdgcn_fence(__ATOMIC_RELEASE, "agent");
            asm volatile("s_waitcnt vmcnt(0)" ::: "memory");
            const unsigned og = xb_add(&bar[XB_TOP], 1u);
            const unsigned tg = og / nx;
            if (og + 1u == (tg + 1u) * nx) xb_add(&bar[XB_TOPGEN], 1u);
            else XB_SPIN(xb_ld(&bar[XB_TOPGEN]) == tg, bar);
            __builtin_amdgcn_fence(__ATOMIC_ACQUIRE, "agent");
            xb_add(&bar[XB_XGEN(b.x)], 1u);
            asm volatile("s_waitcnt vmcnt(0)" ::: "memory");
        } else {
            XB_SPIN(xb_ld(&bar[XB_XGEN(b.x)]) == gen, bar);
            __builtin_amdgcn_fence(__ATOMIC_ACQUIRE, "agent");
            asm volatile("s_waitcnt vmcnt(0)" ::: "memory");
        }
    }
    __syncthreads();
}

constexpr size_t al256(size_t x) { return (x + 255) & ~(size_t)255; }
constexpr size_t WS_ZERO = 0, ZERO_BYTES = 2u << 20;
constexpr size_t Z_GCNT = 0;
constexpr size_t Z_SS2 = 4096;
constexpr size_t WS_MOD = ZERO_BYTES;
constexpr size_t WS_WRT = WS_MOD + al256((size_t)2 * 9 * 6144 * 4);
constexpr size_t WS_TOKE = WS_WRT + al256((size_t)2 * 36 * 1024 * 4);
constexpr size_t WS_TOKP = WS_TOKE + al256((size_t)NSLOT * 4);
constexpr size_t WS_TOKC = WS_TOKP + al256((size_t)NSLOT * 4);
constexpr size_t WS_TOKS = WS_TOKC + al256((size_t)NSLOT * 4);
constexpr size_t WS_TILE = WS_TOKS + al256((size_t)NSLOT * 4);
constexpr size_t WS_XC = WS_TILE + al256((size_t)(MT_MAX + 64) * 4);
constexpr size_t WS_WIN = WS_XC + al256((size_t)NB * CL * D * 4);
constexpr size_t WS_WOUT = WS_WIN + al256((size_t)2 * INW * D * 2);
constexpr size_t WS_WSB = WS_WOUT + al256((size_t)2 * D * D * 2);
constexpr size_t WS_LBV = WS_WSB + al256((size_t)2 * 4 * 128 * 128 * 2);
constexpr size_t WS_HB = WS_LBV + al256((size_t)2 * 2 * 512 * 4);
constexpr size_t WS_R = WS_HB + al256((size_t)M * D * 2);
constexpr int NCH = M / 64  , NCH2 = M / 128;
constexpr size_t R_QA = 0;
constexpr size_t R_KB = R_QA + al256((size_t)2 * M * 512 * 2);
constexpr size_t R_KDT = R_KB + al256((size_t)2 * M * 512 * 2);
constexpr size_t R_VT = R_KDT + al256((size_t)2 * M * 512 * 2);
constexpr size_t R_SG = R_VT + al256((size_t)M * 512 * 2);
constexpr size_t R_GU = R_SG + al256((size_t)M * 512 * 2);
constexpr size_t R_GVT = R_GU + al256((size_t)M * 512 * 2);
constexpr size_t R_EREF = R_GVT + al256((size_t)M * 512 * 2);
constexpr size_t R_DEC = R_EREF + al256((size_t)2 * NCH * 512 * 4);
constexpr size_t R_ST = R_DEC + al256((size_t)2 * NCH * 512 * 4);
constexpr size_t R_MIX_END = R_ST + al256((size_t)(NCH + 1) * 2 * 4 * 128 * 128 * 2);
constexpr size_t R_HS_DUMMY = 0;
constexpr size_t R_WGU = 0;
constexpr size_t R_WD = R_WGU + al256((size_t)NEXP * 1024 * D * 2);
constexpr size_t R_BUF = R_WD + al256((size_t)NEXP * D * DE * 2);
constexpr size_t R_ACT = R_BUF + al256((size_t)NSLOT_PAD * D * 2);
constexpr size_t R_Y = R_ACT + al256((size_t)NSLOT_PAD * DE * 2);
constexpr size_t R_MOE_END = R_Y + al256((size_t)NSLOT_PAD * D * 2);
constexpr int WD_EARLY = 26;
constexpr size_t WS_WDE = WS_R + (R_MIX_END > R_MOE_END ? R_MIX_END : R_MOE_END);
constexpr size_t WS_END = WS_WDE + al256((size_t)WD_EARLY * D * DE * 2);
static_assert(WS_END <= (size_t)634 * 1000 * 1000, "workspace budget (sum of inputs = 634.3 MB)");
constexpr size_t Z_SSV = Z_SS2 + (size_t)2 * M * 4;
constexpr size_t Z_XC = Z_GCNT + 512;
constexpr size_t Z_BAR = Z_SSV + (size_t)2 * M * 4;
static_assert(Z_BAR % 256 == 0 && Z_BAR + (size_t)XCD_BAR_WORDS * 4 <= ZERO_BYTES, "zeroed region");
constexpr int LDS_BARST = LDS_BYTES - 64, LDS_VBLK = LDS_BYTES - 32, LDS_STAMP = LDS_BYTES - 1024;

struct Params { const float* in[23]; float* out; unsigned char* ws; };
enum { I_X = 0, I_C, I_CTX, I_CCTX, I_NORM1, I_NORM2, I_WMOD, I_BMOD, I_WIN, I_LB, I_HGN, I_SGN, I_SGW, I_SGB, I_WOUT, I_WG, I_BG, I_WR, I_BR, I_WGATE, I_WUP, I_WDOWN, I_FN };

__device__ __forceinline__ void transpose_item(const float* W, int K, int N, bf16* WT, int k0, int n0, int rowbase, LAS float* scr, int lane) {
    float t[32];
#pragma unroll
    for (int i = 0; i < 32; ++i) t[i] = W[(size_t)(k0 + 2 * i + (lane >> 5)) * N + n0 + (lane & 31)];
    SCHED_FENCE();
#pragma unroll
    for (int i = 0; i < 32; ++i) scr[(2 * i + (lane >> 5)) * 33 + (lane & 31)] = t[i];
    asm volatile("s_waitcnt lgkmcnt(0)" ::: "memory");
    const int c = lane & 7;
#pragma unroll
    for (int j = 0; j < 4; ++j) { const int n = (lane >> 3) + 8 * j; const LAS float* s = scr + (8 * c) * 33 + n;
        u32x4 o; o.x = cvt2(s[0 * 33], s[1 * 33]); o.y = cvt2(s[2 * 33], s[3 * 33]); o.z = cvt2(s[4 * 33], s[5 * 33]); o.w = cvt2(s[6 * 33], s[7 * 33]);
        *(u32x4*)(WT + (size_t)(rowbase + n) * K + k0 + 8 * c) = o; }
    asm volatile("s_waitcnt lgkmcnt(0)" ::: "memory");
}
__device__ __forceinline__ void transpose_item_g(const float* W, int K, int N, bf16* WT, int k0, int srccol_lane, int rowbase, LAS float* scr, int lane) {
    float t[32];
#pragma unroll
    for (int i = 0; i < 32; ++i) t[i] = W[(size_t)(k0 + 2 * i + (lane >> 5)) * N + srccol_lane];
    SCHED_FENCE();
#pragma unroll
    for (int i = 0; i < 32; ++i) scr[(2 * i + (lane >> 5)) * 33 + (lane & 31)] = t[i];
    asm volatile("s_waitcnt lgkmcnt(0)" ::: "memory");
    const int c = lane & 7;
#pragma unroll
    for (int j = 0; j < 4; ++j) { const int n = (lane >> 3) + 8 * j; const LAS float* s = scr + (8 * c) * 33 + n;
        u32x4 o; o.x = cvt2(s[0 * 33], s[1 * 33]); o.y = cvt2(s[2 * 33], s[3 * 33]); o.z = cvt2(s[4 * 33], s[5 * 33]); o.w = cvt2(s[6 * 33], s[7 * 33]);
        *(u32x4*)(WT + (size_t)(rowbase + n) * K + k0 + 8 * c) = o; }
    asm volatile("s_waitcnt lgkmcnt(0)" ::: "memory");
}
__device__ __forceinline__ int win_srccol(int r) {
    const int pn = r >> 8, c = r & 255;
    if (pn >= 8) return 2048 + (pn - 8) * 256 + c;
    const int bj = c >> 7, wc = (c >> 5) & 3, fq = (c >> 3) & 3, n = (c >> 2) & 1, e = c & 3;
    return (2 * bj + n) * 512 + (pn >> 1) * 128 + (pn & 1) * 64 + 16 * wc + 4 * fq + e;
}
__device__ __forceinline__ void norm_mod_row(const float* xr, const float* gain, const float* sh, const float* sc, bf16* orow, int lane) {
    f32x4 v[4]; float ss = 0.f;
#pragma unroll
    for (int j = 0; j < 4; ++j) { v[j] = *(const f32x4*)(xr + 4 * lane + 256 * j); ss += (v[j][0] * v[j][0] + v[j][1] * v[j][1]) + (v[j][2] * v[j][2] + v[j][3] * v[j][3]); }
    const float rs = rsqrtf(wave_sum(ss) * (1.f / D) + EPS);
#pragma unroll
    for (int j = 0; j < 4; ++j) { const int k = 4 * lane + 256 * j; const f32x4 g = *(const f32x4*)(gain + k), s1 = *(const f32x4*)(sc + k), s0 = *(const f32x4*)(sh + k);
        const f32x4 o = v[j] * rs * g * (s1 + 1.f) + s0; u32x2 w; w.x = cvt2(o[0], o[1]); w.y = cvt2(o[2], o[3]); *(u32x2*)(orow + k) = w; }
}
__device__ __forceinline__ const float* xrow_in(const Params& p, int row) { const int b = row / RB, t = row % RB; return t < SEQ ? p.in[I_X] + ((size_t)b * SEQ + t) * D : p.in[I_CTX] + ((size_t)b * CL + (t - SEQ)) * D; }
__device__ __forceinline__ float* xrow_cur(const Params& p, int row) { const int b = row / RB, t = row % RB; return t < SEQ ? p.out + ((size_t)b * SEQ + t) * D : (float*)(p.ws + WS_XC) + ((size_t)b * CL + (t - SEQ)) * D; }

__device__ __forceinline__ int vblk() { return __builtin_amdgcn_readfirstlane(*(const LAS int*)(unsigned)LDS_VBLK); }
__device__ __forceinline__ void ph_prologue(const Params& p, LAS unsigned char* lds, int tid, int lane, int wave, int G) {
    float* MOD = (float*)(p.ws + WS_MOD);
    if (blockIdx.x < 192) {
        const int l = blockIdx.x / 96, col0 = (blockIdx.x % 96) * 64;
        LAS float* sc = (LAS float*)lds; LAS float* red = (LAS float*)(lds + 36864);
        for (int i = tid; i < 9 * 1024; i += NTHREADS) { const int r = i >> 10, k = i & 1023; sc[i] = siluf(r < 8 ? p.in[I_C][r * 1024 + k] : p.in[I_CCTX][k]); }
        __syncthreads();
        const int c4 = tid & 15, kg = tid >> 4;
        f32x4 acc[9];
#pragma unroll
        for (int r = 0; r < 9; ++r) acc[r] = (f32x4){0.f, 0.f, 0.f, 0.f};
        const float* w = p.in[I_WMOD] + (size_t)l * 1024 * 6144 + col0 + 4 * c4;
#pragma unroll 8
        for (int k = kg; k < 1024; k += 32) { const f32x4 wv = *(const f32x4*)(w + (size_t)k * 6144);
#pragma unroll
            for (int r = 0; r < 9; ++r) acc[r] += wv * sc[r * 1024 + k]; }
#pragma unroll
        for (int r = 0; r < 9; ++r) *(LAS f32x4*)&red[(kg * 9 + r) * 64 + 4 * c4] = acc[r];
        __syncthreads();
        for (int i = tid; i < 576; i += NTHREADS) { const int r = i >> 6, cc = i & 63; float s = 0.f;
            for (int g = 0; g < 32; ++g) s += red[(g * 9 + r) * 64 + cc];
            MOD[(size_t)(l * 9 + r) * 6144 + col0 + cc] = s + p.in[I_BMOD][l * 6144 + col0 + cc]; }
        __syncthreads();
    }
    {
        float* WRT = (float*)(p.ws + WS_WRT);
        for (int i = blockIdx.x * NTHREADS + tid; i < 2 * 36 * 1024; i += G * NTHREADS) { const int l = i / (36 * 1024), o = (i / 1024) % 36, k = i & 1023;
            WRT[i] = o < 4 ? p.in[I_WG][((size_t)l * 1024 + k) * 4 + o] : p.in[I_WR][((size_t)l * 1024 + k) * 32 + (o - 4)]; }
    }
    {
        float* LBV = (float*)(p.ws + WS_LBV); bf16* WSB = (bf16*)(p.ws + WS_WSB);
        for (int i = blockIdx.x * NTHREADS + tid; i < 1024; i += G * NTHREADS) { LBV[i] = 0.f; LBV[1024 + i] = 1.f / (1.f + expf(p.in[I_LB][i] - p.in[I_LB][1024 + i])); }
        for (int i = blockIdx.x * NTHREADS + tid; i < 2 * 4 * 128 * 128; i += G * NTHREADS) {
            const int jj = i & 7, L = (i >> 3) & 63, sidx = (i >> 9) & 7, itile = (i >> 12) & 3, lh = i >> 14;
            WSB[i] = (bf16)f2bf(p.in[I_SGW][(size_t)lh * 128 * 128 + (32 * itile + (L & 31)) * 128 + 16 * sidx + 8 * (L >> 5) + jj]); }
    }
    LAS float* scr = (LAS float*)(lds + wave * 16384);
    const int gw = blockIdx.x * NWAVES + wave, NGW = G * NWAVES;
    constexpr int I_IN = (D / 64) * (INW / 32), I_OUT = (D / 64) * (D / 32);
    for (int it = gw; it < 2 * (I_IN + I_OUT); it += NGW) {
        const int l = it / (I_IN + I_OUT); int r = it % (I_IN + I_OUT);
        if (r < I_IN) { const int nblk = INW / 32, kb = r / nblk, nb = r % nblk; transpose_item_g(p.in[I_WIN] + (size_t)l * D * INW, D, INW, (bf16*)(p.ws + WS_WIN) + (size_t)l * INW * D, 64 * kb, win_srccol(32 * nb + (lane & 31)), 32 * nb, scr, lane); }
        else { r -= I_IN; const int nblk = D / 32, kb = r / nblk, nb = r % nblk; transpose_item(p.in[I_WOUT] + (size_t)l * D * D, D, D, (bf16*)(p.ws + WS_WOUT) + (size_t)l * D * D, 64 * kb, 32 * nb, 32 * nb, scr, lane); }
    }
}
__device__ __forceinline__ void ph_h1_first(const Params& p, LAS unsigned char* lds, int tid, int lane, int wave, int G) {
    const float* MOD = (const float*)(p.ws + WS_MOD); bf16* HB = (bf16*)(p.ws + WS_HB); const float* gain = p.in[I_NORM1];
    LAS f32x4* sm = (LAS f32x4*)lds;
    { f32x4 t[10];
#pragma unroll
      for (int i = 0; i < 10; ++i) { const int e = tid + i * NTHREADS; if (e < 19 * 256) { const int blk = e >> 8, c = e & 255; t[i] = blk < 18 ? *(const f32x4*)(MOD + (size_t)(blk >> 1) * 6144 + (blk & 1) * 1024 + 4 * c) : *(const f32x4*)(gain + 4 * c); } }
      SCHED_FENCE();
#pragma unroll
      for (int i = 0; i < 10; ++i) { const int e = tid + i * NTHREADS; if (e < 19 * 256) sm[e] = t[i]; } }
    __syncthreads();
    const int stride = G * NWAVES;
    for (int row0 = vblk() * NWAVES + wave; row0 < M; row0 += 4 * stride) {
        f32x4 v[4][4]; bool act[4]; int rows[4];
#pragma unroll
        for (int rr = 0; rr < 4; ++rr) { const int row = row0 + rr * stride; act[rr] = row < M; rows[rr] = act[rr] ? row : row0; const float* xr = xrow_in(p, rows[rr]);
#pragma unroll
            for (int j = 0; j < 4; ++j) v[rr][j] = *(const f32x4*)(xr + 4 * lane + 256 * j); }
        SCHED_FENCE();
#pragma unroll
        for (int rr = 0; rr < 4; ++rr) { float ss = 0.f;
#pragma unroll
            for (int j = 0; j < 4; ++j) ss += (v[rr][j][0] * v[rr][j][0] + v[rr][j][1] * v[rr][j][1]) + (v[rr][j][2] * v[rr][j][2] + v[rr][j][3] * v[rr][j][3]);
            const float rs = rsqrtf(wave_sum(ss) * (1.f / D) + EPS); const int mr = mod_row(rows[rr]);
            if (act[rr]) {
#pragma unroll
                for (int j = 0; j < 4; ++j) { const int c = lane + 64 * j; const f32x4 o = v[rr][j] * rs * sm[18 * 256 + c] * (sm[(mr * 2 + 1) * 256 + c] + 1.f) + sm[(mr * 2) * 256 + c];
                    u32x2 w; w.x = cvt2(o[0], o[1]); w.y = cvt2(o[2], o[3]); *(u32x2*)(HB + (size_t)rows[rr] * D + 4 * c) = w; } } }
    }
}
template <int PART>
__device__ __forceinline__ void wc_item(const Params& p, int l, int it, const float*& src, bf16*& dst) {
    if constexpr (PART == 0) { const int e = it >> 9, r0 = it & 511, isup = r0 >> 8, r = r0 & 255, kb = r >> 4, n0 = 32 * (r & 15);
        const float* W = isup ? p.in[I_WUP] : p.in[I_WGATE];
        src = W + ((size_t)l * NEXP + e) * D * DE + (size_t)(64 * kb) * DE + n0;
        dst = (bf16*)(p.ws + WS_R + R_WGU) + (size_t)e * 1024 * D + (size_t)(256 * (n0 >> 7) + 128 * isup + (n0 & 127)) * D + 64 * kb; }
    else { const int e = it >> 8, r = it & 255, kb = r >> 5, n0 = 32 * (r & 31);
        src = p.in[I_WDOWN] + ((size_t)l * NEXP + e) * DE * D + (size_t)(64 * kb) * D + n0;
        dst = (bf16*)(p.ws + (e < WD_EARLY ? WS_WDE : WS_R + R_WD)) + (size_t)e * D * DE + (size_t)n0 * DE + 64 * kb; }
}
template <int N>
__device__ __forceinline__ void wc_load(f32x4 (&t)[8], const float* src, int lane) {
#pragma unroll
    for (int i = 0; i < 8; ++i) t[i] = *(const f32x4*)(src + (size_t)((lane >> 3) + 8 * i) * N + 4 * (lane & 7));
}
template <int K>
__device__ __forceinline__ void wc_finish(const f32x4 (&t)[8], bf16* dst, LAS float* scr, int lane) {
#pragma unroll
    for (int i = 0; i < 8; ++i)
#pragma unroll
        for (int e = 0; e < 4; ++e) scr[((lane >> 3) + 8 * i) * 33 + 4 * (lane & 7) + e] = t[i][e];
    asm volatile("s_waitcnt lgkmcnt(0)" ::: "memory");
    const int c = lane & 7;
#pragma unroll
    for (int j = 0; j < 4; ++j) { const int n = (lane >> 3) + 8 * j; const LAS float* s = scr + (8 * c) * 33 + n;
        u32x4 o; o.x = cvt2(s[0 * 33], s[1 * 33]); o.y = cvt2(s[2 * 33], s[3 * 33]); o.z = cvt2(s[4 * 33], s[5 * 33]); o.w = cvt2(s[6 * 33], s[7 * 33]);
        *(u32x4*)(dst + (size_t)n * K + 8 * c) = o; }
    asm volatile("s_waitcnt lgkmcnt(0)" ::: "memory");
}
template <int PART>
__device__ __forceinline__ void ph_moe_wconv(const Params& p, int l, LAS unsigned char* lds, int lane, int wave, int it_begin, int it_end) {
    constexpr int N = PART ? D : DE, K = PART ? DE : D;
    LAS float* scr = (LAS float*)(lds + wave * 16384);
    const int stride = NWAVES, first = it_begin + wave;
    if (first < it_end) {
        const int lastown = first + ((it_end - 1 - first) / stride) * stride;
        f32x4 ta[8], tb[8]; const float* sa; const float* sb; bf16* da; bf16* db;
        wc_item<PART>(p, l, first, sa, da);
        wc_load<N>(ta, sa, lane);
        for (int it = first; it <= lastown; it += 2 * stride) {
            const int i1 = it + stride < lastown ? it + stride : lastown, i2 = it + 2 * stride < lastown ? it + 2 * stride : lastown;
            wc_item<PART>(p, l, i1, sb, db); wc_load<N>(tb, sb, lane);
            wc_finish<K>(ta, da, scr, lane);
            wc_item<PART>(p, l, i2, sa, da); wc_load<N>(ta, sa, lane);
            wc_finish<K>(tb, db, scr, lane);
        }
    }
}
__device__ __forceinline__ float opaque_v(float x) { asm volatile("" : "+v"(x)); return x; }
__device__ __forceinline__ void ph_router(const Params& p, int l, int last, LAS unsigned char* lds, int tid, int lane, int wave, int G) {
    LAS float* W = (LAS float*)lds; LAS int* hist = (LAS int*)(lds + 147456); LAS int* base = hist + 32; LAS int* sinfo = base + 32 + wave * 40;
    const float* WRT = (const float*)(p.ws + WS_WRT) + (size_t)l * 36 * 1024;
    { f32x4 wt[18];
#pragma unroll
      for (int i = 0; i < 18; ++i) wt[i] = ((const f32x4*)WRT)[tid + i * NTHREADS];
      SCHED_FENCE();
#pragma unroll
      for (int i = 0; i < 18; ++i) ((LAS f32x4*)W)[tid + i * NTHREADS] = wt[i]; }
    if (tid < 32) hist[tid] = 0;
    { int* ROWMAP = (int*)(p.ws + WS_R + R_BUF); for (int i = vblk() * NTHREADS + tid; i < NSLOT_PAD; i += G * NTHREADS) ROWMAP[i] = 0; }
    const float* MOD = (const float*)(p.ws + WS_MOD) + (size_t)l * 9 * 6144; const float* SS2 = (const float*)(p.ws + WS_ZERO + Z_SS2) + (size_t)l * M;
    bf16* HB = (bf16*)(p.ws + WS_HB); int* TOKE = (int*)(p.ws + WS_TOKE); float* TOKC = (float*)(p.ws + WS_TOKC); int* TOKP = (int*)(p.ws + WS_TOKP);
    int* gcnt = (int*)(p.ws + WS_ZERO + Z_GCNT) + l * 64;
    const float* gain = p.in[I_NORM2] + l * D;
    LAS float* Bv = (LAS float*)(lds + 147456 + 2048);
    if (tid < 36) Bv[tid] = tid < 4 ? p.in[I_BG][l * 4 + tid] : p.in[I_BR][l * 32 + tid - 4];
    __syncthreads();
    int nloc = 0;
    const int r0w = (vblk() * NWAVES + wave) * 17, rendw = r0w + 17;
    f32x4 gv[4], s1v[4], s0v[4], xv[2][4]; float ssq[2]; int curmr = -1;
#pragma unroll
    for (int j = 0; j < 4; ++j) gv[j] = *(const f32x4*)(gain + 4 * lane + 256 * j);
#define ROUTER_LOADX(r_, two_) do { _Pragma("unroll") for (int rr = 0; rr < 2; ++rr) { const int row_ = (rr == 0 || (two_)) ? (r_) + rr : (r_); const float* xr_ = xrow_cur(p, row_); ssq[rr] = SS2[row_]; \
        _Pragma("unroll") for (int j = 0; j < 4; ++j) xv[rr][j] = *(const f32x4*)(xr_ + 4 * lane + 256 * j); } } while (0)
    int rcur = r0w; bool two = mod_row(r0w + 1) == mod_row(r0w);
    ROUTER_LOADX(rcur, two);
    while (rcur < rendw) {
        const int rows[2] = {rcur, two ? rcur + 1 : rcur};
        { const int mrow = mod_row(rcur);
          if (mrow != curmr) { const float* mr = MOD + (size_t)mrow * 6144; curmr = mrow;
#pragma unroll
              for (int j = 0; j < 4; ++j) { const int k = 4 * lane + 256 * j; s1v[j] = *(const f32x4*)(mr + 4 * 1024 + k); s0v[j] = *(const f32x4*)(mr + 3 * 1024 + k); } } }
        bool act[2]; f32x4 h[2][4];
#pragma unroll
        for (int rr = 0; rr < 2; ++rr) { act[rr] = (rr == 0 || two) && !(last && is_ctx_row(rows[rr])); const float rs = rsqrtf(ssq[rr] * (1.f / D) + EPS);
#pragma unroll
            for (int j = 0; j < 4; ++j) { const int k = 4 * lane + 256 * j; h[rr][j] = xv[rr][j] * rs * gv[j] * (s1v[j] + 1.f) + s0v[j];
                if (act[rr]) { u32x2 w; w.x = cvt2(h[rr][j][0], h[rr][j][1]); w.y = cvt2(h[rr][j][2], h[rr][j][3]); *(u32x2*)(HB + (size_t)rows[rr] * D + k) = w; } } }
        const int rnext = rcur + (two ? 2 : 1), rload = rnext < rendw ? rnext : rendw - 1; const bool twon = rnext + 1 < rendw && mod_row(rnext + 1) == mod_row(rnext);
        ROUTER_LOADX(rload, twon);
        typedef float f32x2 __attribute__((ext_vector_type(2)));
        float gl[2][4];
        { f32x4 wg[16];
#pragma unroll
          for (int q = 0; q < 16; ++q) wg[q] = *(const LAS f32x4*)&W[(q >> 2) * 1024 + 4 * lane + 256 * (q & 3)];
          SCHED_FENCE();
#pragma unroll
          for (int o = 0; o < 4; ++o)
#pragma unroll
              for (int rr = 0; rr < 2; ++rr) { f32x2 a2 = {0.f, 0.f};
#pragma unroll
                  for (int j = 0; j < 4; ++j) { const f32x4 wv = wg[o * 4 + j], hv = h[rr][j];
                      a2 = __builtin_elementwise_fma((f32x2){hv[0], hv[1]}, (f32x2){wv[0], wv[1]}, a2); a2 = __builtin_elementwise_fma((f32x2){hv[2], hv[3]}, (f32x2){wv[2], wv[3]}, a2); }
                  gl[rr][o] = opaque_v(wave_sum(a2[0] + a2[1]) + Bv[o]); } }
#pragma unroll
        for (int rr = 0; rr < 2; ++rr) {
            const int row = rows[rr];
            int gs = 0; float gmax = gl[rr][0];
#pragma unroll
            for (int o = 1; o < 4; ++o) if (gl[rr][o] > gmax) { gmax = gl[rr][o]; gs = o; }
            float den = 0.f;
#pragma unroll
            for (int o = 0; o < 4; ++o) den += __expf(gl[rr][o] - gmax);
            const float psel = 1.f / den;
            const int gsu = __builtin_amdgcn_readfirstlane(gs);
            const LAS float* wb = W + (4 + 8 * gsu) * 1024 + 4 * lane; const LAS float* bb = Bv + 4 + 8 * gsu;
            float li[8];
#pragma unroll
            for (int half = 0; half < 2; ++half) { f32x4 we[16];
#pragma unroll
                for (int q = 0; q < 16; ++q) we[q] = *(const LAS f32x4*)&wb[(4 * half + (q >> 2)) * 1024 + 256 * (q & 3)];
                SCHED_FENCE();
#pragma unroll
                for (int o = 0; o < 4; ++o) { f32x2 a2 = {0.f, 0.f};
#pragma unroll
                    for (int j = 0; j < 4; ++j) { const f32x4 wv = we[o * 4 + j], hv = h[rr][j];
                        a2 = __builtin_elementwise_fma((f32x2){hv[0], hv[1]}, (f32x2){wv[0], wv[1]}, a2); a2 = __builtin_elementwise_fma((f32x2){hv[2], hv[3]}, (f32x2){wv[2], wv[3]}, a2); }
                    li[4 * half + o] = opaque_v(wave_sum(a2[0] + a2[1]) + bb[4 * half + o]); } }
            int i0 = 0; float m0 = li[0];
#pragma unroll
            for (int j = 1; j < 8; ++j) if (li[j] > m0) { m0 = li[j]; i0 = j; }
            int i1 = 0; float m1 = -3.0e38f;
#pragma unroll
            for (int j = 0; j < 8; ++j) if (j != i0 && li[j] > m1) { m1 = li[j]; i1 = j; }
            const float e1 = __expf(m1 - m0);
            if (act[rr]) {
                if (lane < 2) { const int e = gs * 8 + (lane ? i1 : i0); const float c = lane ? psel * e1 / (1.f + e1) : psel / (1.f + e1);
                    const int lp = __hip_atomic_fetch_add(&hist[e], 1, __ATOMIC_RELAXED, __HIP_MEMORY_SCOPE_WORKGROUP); TOKE[row * 2 + lane] = e; TOKC[row * 2 + lane] = c; sinfo[nloc * 2 + lane] = (e << 16) | lp; }
                ++nloc; }
        }
        rcur = rnext; two = twon;
    }
#undef ROUTER_LOADX
    __syncthreads();
    if (tid < 32) base[tid] = atomicAdd(&gcnt[tid], hist[tid]);
    __syncthreads();
    nloc = 0;
    for (int row = r0w; row < rendw; ++row) if (!(last && is_ctx_row(row))) {
        if (lane < 2) { const int info = sinfo[nloc * 2 + lane]; TOKP[row * 2 + lane] = base[info >> 16] + (info & 0xffff); }
        ++nloc; }
}
__device__ __forceinline__ void ph_place(const Params& p, int l, int last, LAS unsigned char* lds, int tid, int lane, int wave, int G) {
    LAS int* ps = (LAS int*)lds;
    const int* gcnt = (const int*)(p.ws + WS_ZERO + Z_GCNT) + l * 64; int* TILE = (int*)(p.ws + WS_TILE);
    if (tid == 0) { int s = 0; for (int e = 0; e < NEXP; ++e) { ps[e] = s; s += (gcnt[e] + 255) / 256 * 256; } ps[32] = s; }
    __syncthreads();
    if (vblk() == 0 && tid < 32) { for (int t = ps[tid] / 256; t < ps[tid + 1] / 256; ++t) TILE[t] = tid; if (tid == 0) TILE[MT_MAX] = ps[32] / 256; }
    int* ROWMAP = (int*)(p.ws + WS_R + R_BUF);
    const int* TOKE = (const int*)(p.ws + WS_TOKE); const int* TOKP = (const int*)(p.ws + WS_TOKP); int* TOKS = (int*)(p.ws + WS_TOKS);
    for (int i = vblk() * NTHREADS + tid; i < NSLOT; i += G * NTHREADS) { const int row = i >> 1;
        if (last && is_ctx_row(row)) continue;
        const int sl = ps[TOKE[i]] + TOKP[i]; TOKS[i] = sl; ROWMAP[sl] = row; }
}
__device__ __forceinline__ void ph_combine(const Params& p, int l, int last, LAS unsigned char* lds, int tid, int lane, int wave, int G) {
    const float* MOD = (const float*)(p.ws + WS_MOD); const bf16* Y = (const bf16*)(p.ws + WS_R + R_Y); bf16* HB = (bf16*)(p.ws + WS_HB);
    const int* TOKS = (const int*)(p.ws + WS_TOKS); const float* TOKC = (const float*)(p.ws + WS_TOKC);
    const float* gain = last ? p.in[I_FN] : p.in[I_NORM1] + (l + 1) * D;
    LAS f32x4* sm = (LAS f32x4*)lds;
    { f32x4 t[14];
#pragma unroll
      for (int i = 0; i < 14; ++i) { const int e = tid + i * NTHREADS; if (e < 28 * 256) { const int blk = e >> 8, c = e & 255, mr = blk / 3, wh = blk % 3;
          t[i] = blk < 27 ? *(const f32x4*)(MOD + ((size_t)(wh == 0 ? l : (last ? l : l + 1)) * 9 + mr) * 6144 + (wh == 0 ? 5 : wh - 1) * 1024 + 4 * c) : *(const f32x4*)(gain + 4 * c); } }
      SCHED_FENCE();
#pragma unroll
      for (int i = 0; i < 14; ++i) { const int e = tid + i * NTHREADS; if (e < 28 * 256) sm[e] = t[i]; } }
    __syncthreads();
    const int stride = G * NWAVES;
    for (int row0 = vblk() * NWAVES + wave; row0 < M; row0 += 4 * stride) {
        bool act[4]; int rows[4]; float* xr[4]; f32x4 x[4][4]; u32x2 y0[4][4], y1[4][4]; float c0[4], c1[4];
#pragma unroll
        for (int rr = 0; rr < 4; ++rr) { const int rw = row0 + rr * stride; const bool in = rw < M; const int row = in ? rw : row0; rows[rr] = row; act[rr] = in && !(last && is_ctx_row(row)); xr[rr] = xrow_cur(p, row);
            const int s0 = act[rr] ? TOKS[row * 2] : 0, s1 = act[rr] ? TOKS[row * 2 + 1] : 0; c0[rr] = TOKC[row * 2]; c1[rr] = TOKC[row * 2 + 1];
#pragma unroll
            for (int j = 0; j < 4; ++j) { const int k = 4 * lane + 256 * j; x[rr][j] = *(const f32x4*)(xr[rr] + k); y0[rr][j] = *(const u32x2*)(Y + (size_t)s0 * D + k); y1[rr][j] = *(const u32x2*)(Y + (size_t)s1 * D + k); } }
        SCHED_FENCE();
#pragma unroll
        for (int rr = 0; rr < 4; ++rr) { f32x4 v[4]; float ss = 0.f; const int mr = mod_row(rows[rr]);
#pragma unroll
            for (int j = 0; j < 4; ++j) { const u32x2 a = y0[rr][j], b = y1[rr][j]; f32x4 f;
                f[0] = c0[rr] * bf2f(a.x & 0xffffu) + c1[rr] * bf2f(b.x & 0xffffu); f[1] = c0[rr] * bf2f(a.x >> 16) + c1[rr] * bf2f(b.x >> 16);
                f[2] = c0[rr] * bf2f(a.y & 0xffffu) + c1[rr] * bf2f(b.y & 0xffffu); f[3] = c0[rr] * bf2f(a.y >> 16) + c1[rr] * bf2f(b.y >> 16);
                v[j] = x[rr][j] + sm[(mr * 3) * 256 + lane + 64 * j] * f; ss += (v[j][0] * v[j][0] + v[j][1] * v[j][1]) + (v[j][2] * v[j][2] + v[j][3] * v[j][3]); }
            const float rs = rsqrtf(wave_sum(ss) * (1.f / D) + EPS);
            if (act[rr]) {
                if (!last) {
#pragma unroll
                    for (int j = 0; j < 4; ++j) { const int c = lane + 64 * j, k = 4 * c; *(f32x4*)(xr[rr] + k) = v[j];
                        const f32x4 o = v[j] * rs * sm[27 * 256 + c] * (sm[(mr * 3 + 2) * 256 + c] + 1.f) + sm[(mr * 3 + 1) * 256 + c];
                        u32x2 w; w.x = cvt2(o[0], o[1]); w.y = cvt2(o[2], o[3]); *(u32x2*)(HB + (size_t)rows[rr] * D + k) = w; } }
                else {
#pragma unroll
                    for (int j = 0; j < 4; ++j) { const int c = lane + 64 * j; *(f32x4*)(xr[rr] + 4 * c) = v[j] * rs * sm[27 * 256 + c]; } } } }
    }
}
__device__ __forceinline__ int scan_chunk(int step, int dir) { return dir == 0 ? (step < 4 ? 64 + step : step - 4) : 67 - step; }
typedef short bf16x8 __attribute__((ext_vector_type(8)));
typedef short s16x4 __attribute__((ext_vector_type(4)));
typedef float f32x16 __attribute__((ext_vector_type(16)));
#define MFMA32(a, b, c) __builtin_amdgcn_mfma_f32_32x32x16_bf16((a), (b), (c), 0, 0, 0)
__device__ __forceinline__ bf16x8 ld8(const bf16* q) { return *(const bf16x8*)q; }
__device__ __forceinline__ bf16x8 ld44(const bf16* q0, const bf16* q1) { const s16x4 lo = *(const s16x4*)q0, hi = *(const s16x4*)q1; return __builtin_shufflevector(lo, hi, 0, 1, 2, 3, 4, 5, 6, 7); }
__device__ __forceinline__ f32x16 zero16() { f32x16 z;
#pragma unroll
    for (int i = 0; i < 16; ++i) z[i] = 0.f; return z; }
__device__ __forceinline__ bf16x8 pack_acc(const f32x16& x, int s) { u32x4 w; w.x = pk2(x[8 * s], x[8 * s + 1]); w.y = pk2(x[8 * s + 2], x[8 * s + 3]); w.z = pk2(x[8 * s + 4], x[8 * s + 5]); w.w = pk2(x[8 * s + 6], x[8 * s + 7]); return __builtin_bit_cast(bf16x8, w); }
__device__ __forceinline__ bf16x8 scale8(bf16x8 f, f32x4 a, f32x4 b) { const u32x4 w = __builtin_bit_cast(u32x4, f); u32x4 o;
    o.x = cvt2(bf2f(w.x & 0xffffu) * a[0], bf2f(w.x >> 16) * a[1]); o.y = cvt2(bf2f(w.y & 0xffffu) * a[2], bf2f(w.y >> 16) * a[3]);
    o.z = cvt2(bf2f(w.z & 0xffffu) * b[0], bf2f(w.z >> 16) * b[1]); o.w = cvt2(bf2f(w.w & 0xffffu) * b[2], bf2f(w.w >> 16) * b[3]); return __builtin_bit_cast(bf16x8, o); }

constexpr int SCAN_DE_BYTES = 69 * 256 * 4, SCAN_RING_OFF = 71680, SCAN_BUF_BYTES = 24 * 1024;
__device__ __forceinline__ void scan_item(int item, int& b, int& h, int& dir, int& eh) {
    const int xcd = item & 7, j = item >> 3, pair = (j >> 2) * 8 + xcd; eh = j & 1; dir = (j >> 1) & 1; h = pair & 3; b = pair >> 2;
}
__device__ __forceinline__ void scan_preload(const Params& p, LAS unsigned char* lds, int tid, int item) {
    int b, h, dir, eh; scan_item(item, b, h, dir, eh);
    const float* DEC = (const float*)(p.ws + WS_R + R_DEC) + (size_t)dir * NCH * 512 + h * 128; const float* ER = (const float*)(p.ws + WS_R + R_EREF) + (size_t)dir * NCH * 512 + h * 128;
    LAS float* de = (LAS float*)lds;
    for (int i = tid; i < 69 * 256; i += NTHREADS) { const int step = i >> 8, w = i & 255; const size_t gc = (size_t)(b * 68 + scan_chunk(step < 68 ? step : 67, dir));
        de[i] = w < 128 ? DEC[gc * 512 + w] : ER[gc * 512 + (w - 128)]; }
}
struct ScanRegs { bf16x8 f[3]; };
__device__ __forceinline__ void ph_scan(const Params& p, LAS unsigned char* lds, int lane, int wave, int item) {
    int b, h, dir, eh; scan_item(item, b, h, dir, eh);
    const int dt = wave & 3, etl = wave >> 2, et = 2 * eh + etl, hh = lane >> 5;
    const bf16* KD = (const bf16*)(p.ws + WS_R + R_KDT) + (size_t)dir * M * 512; const bf16* V = (const bf16*)(p.ws + WS_R + R_VT);
    const bf16* src[3];
#pragma unroll
    for (int i = 0; i < 3; ++i) { const int f = 3 * wave + i; src[i] = f < 16 ? KD + ((((size_t)h * 4 + (f >> 2)) * 4 + (f & 3)) * 64 + lane) * 8 : V + ((((size_t)h * 4 + 2 * eh + ((f - 16) >> 2)) * 4 + (f & 3)) * 64 + lane) * 8; }
    const LAS float* de = (const LAS float*)lds + 32 * dt + 4 * hh;
    LAS unsigned char* ring = lds + SCAN_RING_OFF;
    const int wofs = 3 * wave * 1024 + lane * 16, aofs = dt * 4 * 1024 + lane * 16, bofs = (16 + etl * 4) * 1024 + lane * 16;
    bf16* ST = (bf16*)(p.ws + WS_R + R_ST) + (((size_t)dir * 4 + h) * 16 + dt * 4 + et) * 1024 + lane * 8;
    f32x16 S = zero16();
#define SCAN_GC(step) ((size_t)(b * 68 + scan_chunk((step) < 68 ? (step) : 67, dir)))
#define SCAN_LOAD(R, step) { const size_t g_ = SCAN_GC(step) * (4 * 4 * 4 * 512); _Pragma("unroll") for (int i = 0; i < 3; ++i) R.f[i] = ld8(src[i] + g_); }
#define SCAN_WRITE(R, buf) { _Pragma("unroll") for (int i = 0; i < 3; ++i) *(LAS bf16x8*)(ring + (buf) * SCAN_BUF_BYTES + wofs + i * 1024) = R.f[i]; }
#define SCAN_BAR() { asm volatile("s_waitcnt lgkmcnt(0)" ::: "memory"); __builtin_amdgcn_s_barrier(); asm volatile("" ::: "memory"); }
    ScanRegs P0, P1;
    SCAN_LOAD(P0, 0); SCAN_LOAD(P1, 1);
    SCAN_WRITE(P0, 0); SCAN_LOAD(P0, 2);
    for (int k0 = 0; k0 < 72; k0 += 6) {
#pragma unroll
        for (int j = 0; j < 6; ++j) { const int k = k0 + j;
            SCAN_BAR();
            if ((j + 1) & 1) { SCAN_WRITE(P1, (j + 1) % 3); SCAN_LOAD(P1, k + 3); } else { SCAN_WRITE(P0, (j + 1) % 3); SCAN_LOAD(P0, k + 3); }
            const LAS unsigned char* buf = ring + (j % 3) * SCAN_BUF_BYTES;
            bf16x8 fa[4], fb[4]; f32x4 dc[4], er[4]; const LAS float* dk = de + (k < 69 ? k : 68) * 256;
#pragma unroll
            for (int s = 0; s < 4; ++s) { fa[s] = *(const LAS bf16x8*)(buf + aofs + s * 1024); fb[s] = *(const LAS bf16x8*)(buf + bofs + s * 1024); dc[s] = *(const LAS f32x4*)(dk + 8 * s); er[s] = *(const LAS f32x4*)(dk + 128 + 8 * s); }
            { bf16* st = ST + (k < 68 ? SCAN_GC(k) : (size_t)NCH) * (2 * 4 * 16384); u32x4 w0, w1;
              w0.x = cvt2(S[0] * er[0][0], S[1] * er[0][1]); w0.y = cvt2(S[2] * er[0][2], S[3] * er[0][3]); w0.z = cvt2(S[4] * er[1][0], S[5] * er[1][1]); w0.w = cvt2(S[6] * er[1][2], S[7] * er[1][3]);
              w1.x = cvt2(S[8] * er[2][0], S[9] * er[2][1]); w1.y = cvt2(S[10] * er[2][2], S[11] * er[2][3]); w1.z = cvt2(S[12] * er[3][0], S[13] * er[3][1]); w1.w = cvt2(S[14] * er[3][2], S[15] * er[3][3]);
              *(u32x4*)st = w0; *(u32x4*)(st + 512) = w1; }
#pragma unroll
            for (int g = 0; g < 4; ++g)
#pragma unroll
                for (int q = 0; q < 4; ++q) S[4 * g + q] *= dc[g][q];
#pragma unroll
            for (int s = 0; s < 4; ++s) S = MFMA32(fa[s], fb[s], S);
        }
    }
#undef SCAN_GC
#undef SCAN_LOAD
#undef SCAN_WRITE
#undef SCAN_BAR
}
__device__ __forceinline__ void ph_sgu(const Params& p, int l, int lane, int widx, int nw) {
    const bf16* GVT = (const bf16*)(p.ws + WS_R + R_GVT); const bf16* GU = (const bf16*)(p.ws + WS_R + R_GU); bf16* HS = (bf16*)(p.ws + WS_HB);
    const float* SSV = (const float*)(p.ws + WS_ZERO + Z_SSV) + (size_t)l * M; const bf16* WSB = (const bf16*)(p.ws + WS_WSB) + (size_t)l * 4 * 128 * 128; const float* bs = p.in[I_SGB] + l * 512;
    const int r = lane & 31, hh = lane >> 5;
    for (int it = widx; it < NCH2 * 16; it += nw) { const int gc2 = it >> 4, h = (it >> 2) & 3, cht = it & 3;
        const bf16* ap = GVT + ((((size_t)(gc2 * 4 + h) * 4 + cht) * 8) * 64 + lane) * 8; const float* sp = SSV + gc2 * 128 + 8 * hh; const bf16* wp = WSB + ((((size_t)h * 4) * 8) * 64 + lane) * 8;
        f32x16 acc[4] = {zero16(), zero16(), zero16(), zero16()};
        bf16x8 av[8]; f32x4 sv[16];
#pragma unroll
        for (int s = 0; s < 8; ++s) { av[s] = ld8(ap + s * 512); sv[2 * s] = *(const f32x4*)(sp + 16 * s); sv[2 * s + 1] = *(const f32x4*)(sp + 16 * s + 4); }
        bf16x8 wa[4], wb[4];
#pragma unroll
        for (int t = 0; t < 4; ++t) wa[t] = ld8(wp + (size_t)t * 8 * 512);
#pragma unroll
        for (int s = 0; s < 8; ++s) {
            SCHED_FENCE();
            if (s < 7) {
#pragma unroll
                for (int t = 0; t < 4; ++t) { const bf16x8 w = ld8(wp + (size_t)t * 8 * 512 + (s + 1) * 512); if (s & 1) wa[t] = w; else wb[t] = w; } }
            SCHED_FENCE();
            f32x4 s0 = sv[2 * s], s1 = sv[2 * s + 1];
#pragma unroll
            for (int q = 0; q < 4; ++q) { s0[q] = rsqrtf(s0[q] * (1.f / 512.f) + EPS); s1[q] = rsqrtf(s1[q] * (1.f / 512.f) + EPS); }
            const bf16x8 a = scale8(av[s], s0, s1);
#pragma unroll
            for (int t = 0; t < 4; ++t) acc[t] = MFMA32(a, (s & 1) ? wb[t] : wa[t], acc[t]); }
        u32x2 gu[4][4]; float bias[4];
#pragma unroll
        for (int t = 0; t < 4; ++t) { const size_t row = (size_t)gc2 * 128 + 32 * t + r; bias[t] = bs[h * 128 + 32 * t + r];
#pragma unroll
            for (int g = 0; g < 4; ++g) gu[t][g] = *(const u32x2*)(GU + row * 512 + h * 128 + 32 * cht + 8 * g + 4 * hh); }
        SCHED_FENCE();
#pragma unroll
        for (int t = 0; t < 4; ++t) { const size_t row = (size_t)gc2 * 128 + 32 * t + r;
#pragma unroll
            for (int g = 0; g < 4; ++g) { const int ch = h * 128 + 32 * cht + 8 * g + 4 * hh; const u32x2 u = gu[t][g];
                u32x2 w; w.x = cvt2(pg8::fast_gelu(bf2f(u.x & 0xffffu)) * (acc[t][4 * g] + bias[t]), pg8::fast_gelu(bf2f(u.x >> 16)) * (acc[t][4 * g + 1] + bias[t])); w.y = cvt2(pg8::fast_gelu(bf2f(u.y & 0xffffu)) * (acc[t][4 * g + 2] + bias[t]), pg8::fast_gelu(bf2f(u.y >> 16)) * (acc[t][4 * g + 3] + bias[t]));
                *(u32x2*)(HS + row * D + 512 + ch) = w; } }
    }
}
__device__ __forceinline__ void ph_out(const Params& p, int l, int last, LAS unsigned char* lds, int lane, int wave, int G) {
    const bf16* QA = (const bf16*)(p.ws + WS_R + R_QA); const bf16* KB = (const bf16*)(p.ws + WS_R + R_KB); const bf16* VT = (const bf16*)(p.ws + WS_R + R_VT);
    const bf16* ST = (const bf16*)(p.ws + WS_R + R_ST); const bf16* SG = (const bf16*)(p.ws + WS_R + R_SG);
    bf16* HS = (bf16*)(p.ws + WS_HB); const float* gain = p.in[I_HGN] + l * 512;
    const int r = lane & 31, hh = lane >> 5;
    for (int kk = 0; kk < 3; ++kk) { int gc, sub;
        if (kk < 2) { const int v = vblk() * NWAVES + wave + kk * (G * NWAVES), r = v >> 3; gc = (r >> 6) * 68 + (r & 63); sub = v & 7; }
        else { if (last || vblk() >= 128 || wave >= 2) break; const int j = vblk() * 2 + wave, q = j >> 3; gc = (q >> 2) * 68 + 64 + (q & 3); sub = j & 7; }
        const int h = (sub >> 1) & 3, ih = sub & 1;
        f32x16 o[4] = {zero16(), zero16(), zero16(), zero16()}; f32x16 Pd, Po;
#pragma unroll
        for (int dir = 0; dir < 2; ++dir) {
            const bf16* qp = QA + (size_t)dir * M * 512 + ((((size_t)(gc * 4 + h) * 2 + ih) * 8) * 64 + lane) * 8;
            const bf16* kd = KB + (size_t)dir * M * 512 + ((((size_t)(gc * 4 + h) * 2 + ih) * 8) * 64 + lane) * 8;
            const bf16* ko = KB + (size_t)dir * M * 512 + ((((size_t)(gc * 4 + h) * 2 + (1 - ih)) * 8) * 64 + lane) * 8;
            const bf16* sp = ST + (((size_t)gc * 2 + dir) * 4 + h) * 16384 + lane * 8;
            const bool off = (dir == 0) == (ih == 1);
            bf16x8 qa[8], ka[8], sa[8], sb[8];
#pragma unroll
            for (int s = 0; s < 8; ++s) { qa[s] = ld8(qp + s * 512); ka[s] = ld8(kd + s * 512); }
            if (off) {
#pragma unroll
                for (int s = 0; s < 8; ++s) sb[s] = ld8(ko + s * 512); }
            SCHED_FENCE();
            { f32x16 t = zero16();
#pragma unroll
              for (int s = 0; s < 8; ++s) t = MFMA32(ka[s], qa[s], t);
              SCHED_FENCE();
#pragma unroll
              for (int s = 0; s < 8; ++s) sa[s] = ld8(sp + (size_t)((s >> 1) * 4 + 0) * 1024 + 512 * (s & 1));
              SCHED_FENCE();
#pragma unroll
              for (int q = 0; q < 16; ++q) { const int j = (q & 3) + 8 * (q >> 2) + 4 * hh; const bool keep = dir == 0 ? (j <= r) : (j >= r); const float v = keep ? t[q] : 0.f; if (dir == 0) Pd[q] = v; else Pd[q] += v; } }
            if (off) { f32x16 t = zero16();
#pragma unroll
              for (int s = 0; s < 8; ++s) t = MFMA32(sb[s], qa[s], t);
              Po = t; }
#pragma unroll
            for (int et = 0; et < 4; ++et) {
                SCHED_FENCE();
                if (et < 3) {
#pragma unroll
                    for (int s = 0; s < 8; ++s) { const bf16x8 w = ld8(sp + (size_t)((s >> 1) * 4 + et + 1) * 1024 + 512 * (s & 1)); if (et & 1) sa[s] = w; else sb[s] = w; } }
                SCHED_FENCE();
#pragma unroll
                for (int s = 0; s < 8; ++s) o[et] = MFMA32((et & 1) ? sb[s] : sa[s], qa[s], o[et]);
            }
        }
        {
            const bf16* vp = VT + (((size_t)(gc * 4 + h) * 4 * 4) * 64 + r) * 8 + 4 * hh;
            bf16x8 va[4][4];
#pragma unroll
            for (int et = 0; et < 4; ++et)
#pragma unroll
                for (int k = 0; k < 4; ++k) { const bf16* v = vp + (size_t)(et * 4 + k) * 512; va[et][k] = ld44(v, v + 32 * 8); }
            SCHED_FENCE();
#pragma unroll
            for (int s = 0; s < 2; ++s) { const bf16x8 pd = pack_acc(Pd, s), po = pack_acc(Po, s);
#pragma unroll
                for (int et = 0; et < 4; ++et) { o[et] = MFMA32(ih ? va[et][2 + s] : va[et][s], pd, o[et]); o[et] = MFMA32(ih ? va[et][s] : va[et][2 + s], po, o[et]); } }
        }
        float ss = 0.f;
#pragma unroll
        for (int et = 0; et < 4; ++et)
#pragma unroll
            for (int q = 0; q < 16; ++q) ss += o[et][q] * o[et][q];
        ss += __shfl_xor(ss, 32);
        const float rs = rsqrtf(ss * (1.f / 128.f) + EPS);
        LAS unsigned char* img = lds + wave * 8704;
#pragma unroll
        for (int et = 0; et < 4; ++et)
#pragma unroll
            for (int g = 0; g < 4; ++g) { u32x2 w; w.x = cvt2(o[et][4 * g] * rs, o[et][4 * g + 1] * rs); w.y = cvt2(o[et][4 * g + 2] * rs, o[et][4 * g + 3] * rs);
                *(LAS u32x2*)(img + r * 272 + (32 * et + 8 * g + 4 * hh) * 2) = w; }
        asm volatile("s_waitcnt lgkmcnt(0)" ::: "memory");
        const int ck = lane & 15, rq = lane >> 4;
        const f32x4 g0 = *(const f32x4*)(gain + h * 128 + 8 * ck), g1 = *(const f32x4*)(gain + h * 128 + 8 * ck + 4);
        u32x4 sg[8], ov[8];
#pragma unroll
        for (int i = 0; i < 8; ++i) { const size_t row = (size_t)gc * 64 + 32 * ih + 4 * i + rq; sg[i] = *(const u32x4*)(SG + row * 512 + h * 128 + 8 * ck); ov[i] = *(const LAS u32x4*)(img + (4 * i + rq) * 272 + ck * 16); }
#pragma unroll
        for (int i = 0; i < 8; ++i) { const size_t row = (size_t)gc * 64 + 32 * ih + 4 * i + rq; const u32x4 a = ov[i], b = sg[i]; u32x4 w;
#define SILU_BF(h_) pg8::fast_silu(bf2f(h_))
            w.x = cvt2(bf2f(a.x & 0xffffu) * g0[0] * SILU_BF(b.x & 0xffffu), bf2f(a.x >> 16) * g0[1] * SILU_BF(b.x >> 16)); w.y = cvt2(bf2f(a.y & 0xffffu) * g0[2] * SILU_BF(b.y & 0xffffu), bf2f(a.y >> 16) * g0[3] * SILU_BF(b.y >> 16));
            w.z = cvt2(bf2f(a.z & 0xffffu) * g1[0] * SILU_BF(b.z & 0xffffu), bf2f(a.z >> 16) * g1[1] * SILU_BF(b.z >> 16)); w.w = cvt2(bf2f(a.w & 0xffffu) * g1[2] * SILU_BF(b.w & 0xffffu), bf2f(a.w >> 16) * g1[3] * SILU_BF(b.w >> 16));
#undef SILU_BF
            *(u32x4*)(HS + row * D + h * 128 + 8 * ck) = w; }
        asm volatile("s_waitcnt lgkmcnt(0)" ::: "memory");
    }
}
#ifndef TIMING
#define TIMING 0
#endif
#ifndef TIMING_MASK
#define TIMING_MASK 0ull
#endif
#ifndef TIMING_MODE
#define TIMING_MODE 0
#endif
#ifndef TIMING_MUL
#define TIMING_MUL 4
#endif
constexpr int PH_PRO = 0, PH_H1 = 1, PH_L0 = 2, PH_PER_LAYER = 9, PH_END = PH_L0 + 2 * PH_PER_LAYER;
__device__ __forceinline__ void* launder_ptr(void* q) { unsigned long long v = (unsigned long long)q; asm volatile("" : "+s"(v)); return (void*)v; }
__global__ void __launch_bounds__(NTHREADS, 2) mk(Params p, int ph_lo, int ph_hi) {
    extern __shared__ __attribute__((aligned(16))) unsigned char lds_raw[];
    LAS unsigned char* lds = (LAS unsigned char*)lds_raw;
    constexpr int G = 256;
    unsigned char* const ws0 = p.ws; const int wave0 = __builtin_amdgcn_readfirstlane(threadIdx.x >> 6);
    cg::grid_group grid = cg::this_grid();
    if (threadIdx.x < 16) ((LAS unsigned*)(lds + LDS_BARST))[threadIdx.x] = 0u;
    __syncthreads();
    (void)xcd_barrier_post((unsigned*)(p.ws + WS_ZERO + Z_BAR), (volatile LAS unsigned*)(lds + LDS_BARST));
#if TIMING
    if (blockIdx.x == 0 && threadIdx.x == 0) ((LAS unsigned long long*)(lds + LDS_STAMP))[0] = __builtin_amdgcn_s_memrealtime();
    if (threadIdx.x < 16) ((LAS unsigned long long*)(lds + LDS_STAMP))[64 + threadIdx.x] = 0ull;
#endif
    {
        const int tid0 = threadIdx.x;
        if (tid0 == 0) { const unsigned x = xb_xcc_id() & 7u; ((LAS int*)(lds + LDS_VBLK))[1] = (int)x; ((LAS int*)(lds + LDS_VBLK))[2] = (int)atomicAdd((unsigned*)(p.ws + WS_ZERO + Z_XC) + x, 1u); }
        ph_prologue(p, lds, tid0, tid0 & 63, wave0, G);
#if TIMING
        if (blockIdx.x == 0 && tid0 == 0) ((LAS unsigned long long*)(lds + LDS_STAMP))[32] = __builtin_amdgcn_s_memrealtime();
#endif
        grid.sync();
        if (tid0 == 0) {
            LAS int* vw = (LAS int*)(lds + LDS_VBLK); const unsigned* XC = (const unsigned*)(p.ws + WS_ZERO + Z_XC); const int myx = vw[1], myr = vw[2]; int vb = -1;
            if (myr < 32) vb = myr * 8 + myx;
            else { int o = myr - 32;
                for (int x = 0; x < myx; ++x) { const int c = (int)XC[x]; o += c > 32 ? c - 32 : 0; }
                for (int x = 0; x < 8 && vb < 0; ++x) { const int c = (int)XC[x] < 32 ? (int)XC[x] : 32, empty = 32 - c; if (o < empty) vb = (c + o) * 8 + x; else o -= empty; } }
            vw[0] = vb < 0 ? 0 : vb; }
        __syncthreads();
#if TIMING
        if (blockIdx.x == 0 && tid0 == 0) ((LAS unsigned long long*)(lds + LDS_STAMP))[1] = __builtin_amdgcn_s_memrealtime();
#endif
    }
    for (int ph = 1; ph < ph_hi; ++ph) {
        int zlane = 0; asm volatile("" : "+v"(zlane));
        const int tid = wave0 * 64 + (int)__builtin_amdgcn_mbcnt_hi(~0u, __builtin_amdgcn_mbcnt_lo(~0u, (unsigned)zlane));
        { size_t zoff = 0; asm volatile("" : "+s"(zoff)); p.ws = ws0 + zoff; }
        const int lane = tid & 63, wave = wave0;
#if TIMING && TIMING_GPH >= 0
        if (tid == 0) ((LAS unsigned long long*)(lds + LDS_STAMP))[127] = (blockIdx.x == 0 && ph == TIMING_GPH) ? 1ull : 0ull;
#endif
        if (ph == PH_H1) ph_h1_first(p, lds, tid, lane, wave, G);
        else {
            const int l = (ph - PH_L0) / PH_PER_LAYER, s = (ph - PH_L0) % PH_PER_LAYER, last = l == 1;
            const float* modl = (const float*)(p.ws + WS_MOD) + (size_t)l * 9 * 6144;
            if (s == 0) {
                pg8::Gemm g{(const bf16*)(p.ws + WS_HB), (const bf16*)(p.ws + WS_WIN) + (size_t)l * INW * D, M, INW, D};
                pg8::DenseOrder S; S.init(M / 256, INW / 256, G, vblk(), 0);
                unsigned char* R = p.ws + WS_R;
                pg8::EpiInProj E{(bf16*)(R + R_QA), (bf16*)(R + R_KB), (bf16*)(R + R_KDT), (bf16*)(R + R_VT), (bf16*)(R + R_SG), (bf16*)(R + R_GU), (bf16*)(R + R_GVT), (float*)(R + R_EREF), (float*)(R + R_DEC),
                                 (float*)(p.ws + WS_ZERO + Z_SSV) + (size_t)l * M, (const float*)(p.ws + WS_LBV) + l * 1024, p.in[I_SGN] + l * 512, (size_t)M * 512, NCH, lds + 131072};
                pg8::gemm_phase<pg8::EpiInProj, pg8::DenseOrder, true, true>(lds, g, S, E, tid);
                { constexpr int TOTE = WD_EARLY * 256; const int rem = S.nwg % G, nlow = rem == 0 ? G : G - rem, vb0 = vblk();
                  if (rem == 0 || vb0 >= rem) { const int per = (TOTE + nlow - 1) / nlow, b0 = (rem == 0 ? vb0 : vb0 - rem) * per;
                      ph_moe_wconv<1>(p, l, lds, lane, wave, b0 < TOTE ? b0 : TOTE, b0 + per < TOTE ? b0 + per : TOTE); } }
            } else if (s == 1) { if (vblk() < 128) { scan_preload(p, lds, tid, vblk()); __syncthreads(); ph_scan(p, lds, lane, wave, vblk()); }
                else ph_sgu(p, l, lane, (vblk() - 128) * 8 + wave, 128 * 8); }
            else if (s == 2) ph_out(p, l, last, lds, lane, wave, G);
            else if (s == 3) {
                pg8::Gemm g{(const bf16*)(p.ws + WS_HB), (const bf16*)(p.ws + WS_WOUT) + (size_t)l * D * D, M, D, D};
                const int vb3 = vblk(), NC3 = last ? 0 : 32, NW3 = G - NC3; constexpr int T0 = NEXP * 512;
                pg8::EpiResid E{l == 0 ? p.in[I_X] : p.out, l == 0 ? p.in[I_CTX] : (const float*)(p.ws + WS_XC), p.out, (float*)(p.ws + WS_XC), modl, (float*)(p.ws + WS_ZERO + Z_SS2) + (size_t)l * M};
                if (vb3 < NC3) { pg8::OneUnit S1; S1.u.pm = (vb3 >> 2) * 17 + 16; S1.u.pn = vb3 & 3; S1.u.pb = vb3 & 3; pg8::gemm_phase<pg8::EpiResid, pg8::OneUnit, true, true>(lds, g, S1, E, tid); }
                else { const int b3 = (T0 + NW3 - 1) / NW3, i0 = (vb3 - NC3) * b3; ph_moe_wconv<0>(p, l, lds, lane, wave, i0 < T0 ? i0 : T0, i0 + b3 < T0 ? i0 + b3 : T0); __syncthreads(); }
                pg8::DenseOrder S; S.init(NB * 16, D / 256, G, vb3, 1);
                pg8::gemm_phase<pg8::EpiResid, pg8::DenseOrder, true, true>(lds, g, S, E, tid);
            } else if (s == 4) ph_router(p, l, last, lds, tid, lane, wave, G);
            else if (s == 5) ph_place(p, l, last, lds, tid, lane, wave, G);
            else if (s == 6) {
                const int* TILE = (const int*)(p.ws + WS_TILE); const int nt = __builtin_amdgcn_readfirstlane(TILE[MT_MAX]);
                LAS int* tl = (LAS int*)(lds + 131072 + 8192);
                if (tid < MT_MAX) tl[tid] = TILE[tid];
                __syncthreads();
                pg8::Gemm g{(const bf16*)(p.ws + WS_HB), (const bf16*)(p.ws + WS_R + R_WGU), M, 1024, D};
                pg8::MoeOrder S; S.init(tl, nt, 4, G, vblk(), 4);
                pg8::EpiSwiglu E{(bf16*)(p.ws + WS_R + R_ACT)};
                LAS int* rm = (LAS int*)(lds + 131072);
                { const int* ROWMAP = (const int*)(p.ws + WS_R + R_BUF);
                  for (int i = 0; i < 5; ++i) { pg8::Unit uu; if (S.next(i, uu) && tid < 256) { const int v_ = ROWMAP[uu.pm * 256 + tid]; rm[i * 256 + tid] = v_; } }
                  __syncthreads(); }
                pg8::gemm_phase<pg8::EpiSwiglu, pg8::MoeOrder, true, true, true>(lds, g, S, E, tid, rm);
                { constexpr int TOT = (NEXP - WD_EARLY) * 256, OFS = WD_EARLY * 256; const int rem = S.nwg % G, nlow = G - rem, vb6 = vblk();
                  int y = (TOT - 27 * nlow) / G; y = rem == 0 ? TOT / G : (y < 0 ? 0 : y);
                  const int x = rem == 0 ? y : (TOT - rem * y + nlow - 1) / nlow;
                  const int b6 = vb6 < rem ? vb6 * y : rem * y + (vb6 - rem) * x, e6 = b6 + (vb6 < rem ? y : x);
                  ph_moe_wconv<1>(p, l, lds, lane, wave, OFS + (b6 < TOT ? b6 : TOT), OFS + (e6 < TOT ? e6 : TOT)); }
            } else if (s == 7) {
                const int* TILE = (const int*)(p.ws + WS_TILE); const int nt = __builtin_amdgcn_readfirstlane(TILE[MT_MAX]);
                LAS int* tl = (LAS int*)(lds + 131072 + 8192);
                if (tid < MT_MAX) tl[tid] = TILE[tid];
                __syncthreads();
                pg8::Gemm g{(const bf16*)(p.ws + WS_R + R_ACT), (const bf16*)(p.ws + WS_WDE), NSLOT_PAD, D, DE, (const bf16*)(p.ws + WS_R + R_WD), WD_EARLY * 4};
                pg8::MoeOrder S; S.init(tl, nt, 4, G, vblk(), 4);
                pg8::EpiStoreBf16 E{(bf16*)(p.ws + WS_R + R_Y), D};
                pg8::gemm_phase<pg8::EpiStoreBf16, pg8::MoeOrder, true, true>(lds, g, S, E, tid);
            } else ph_combine(p, l, last, lds, tid, lane, wave, G);
        }
#if TIMING
        if (blockIdx.x == 0 && tid == 0) ((LAS unsigned long long*)(lds + LDS_STAMP))[32 + ph] = __builtin_amdgcn_s_memrealtime();
#endif
#if TIMING && TIMING_SPH >= 0
        if (ph == TIMING_SPH && tid == 0) __hip_atomic_store((unsigned long long*)(p.ws + WS_ZERO + ZERO_BYTES - 8192) + vblk(), (unsigned long long)__builtin_amdgcn_s_memrealtime(), __ATOMIC_RELAXED, __HIP_MEMORY_SCOPE_AGENT);
#endif
        if (ph + 1 < ph_hi) { { XcdBarrier bar; bar.bar = (unsigned*)(p.ws + WS_ZERO + Z_BAR); bar.x = xb_xcc_id(); bar.st = (volatile LAS unsigned*)(lds + LDS_BARST); xcd_barrier(bar, tid); } }
#if TIMING
        if (blockIdx.x == 0 && tid == 0) ((LAS unsigned long long*)(lds + LDS_STAMP))[ph + 1] = __builtin_amdgcn_s_memrealtime();
#endif
    }
#if TIMING
    if (blockIdx.x == 0 && threadIdx.x == 0) {
        LAS unsigned long long* st = (LAS unsigned long long*)(lds + LDS_STAMP); unsigned long long tot = 0;
        for (int k = 0; k < PH_END; ++k) if ((TIMING_MASK >> k) & 1ull) tot += (TIMING_MODE ? st[32 + k] : st[k + 1]) - st[k];
        if (TIMING_SEL >= 64) tot = st[TIMING_SEL];
#if TIMING_SPH >= 0
        { unsigned long long* TS = (unsigned long long*)(p.ws + WS_ZERO + ZERO_BYTES - 8192); const unsigned long long t_s = st[TIMING_SPH]; unsigned long long mx = 0, mn = ~0ull, sm = 0, one = 0;
          for (int b = 0; b < 256; ++b) { const unsigned long long d = __hip_atomic_load(TS + b, __ATOMIC_RELAXED, __HIP_MEMORY_SCOPE_AGENT) - t_s; mx = d > mx ? d : mx; mn = d < mn ? d : mn; sm += d; if (b == TIMING_VB) one = d; }
          tot = TIMING_STAT == 0 ? mx : TIMING_STAT == 1 ? mn : TIMING_STAT == 2 ? sm / 256 : one; }
#endif
        const unsigned long long t0 = __builtin_amdgcn_s_memrealtime();
        while (__builtin_amdgcn_s_memrealtime() - t0 < tot * TIMING_MUL) __builtin_amdgcn_s_sleep(8);
    }
#endif
}

extern "C" void kernel_launch(void* const* d_in, const int* in_sizes, int n_in, void* d_out, int out_size, void* d_ws, size_t ws_size, hipStream_t stream) {
    static int grid = 0;
    if (grid == 0) {
        if (n_in != 23 || ws_size < WS_END) { fprintf(stderr, "kernel_launch: n_in %d ws %zu need %zu\n", n_in, ws_size, (size_t)WS_END); grid = -1; return; }
        int dev = 0, cus = 0, per_cu = 0;
        hipGetDevice(&dev); hipDeviceGetAttribute(&cus, hipDeviceAttributeMultiprocessorCount, dev);
        hipFuncSetAttribute((const void*)mk, hipFuncAttributeMaxDynamicSharedMemorySize, LDS_BYTES);
        hipOccupancyMaxActiveBlocksPerMultiprocessor(&per_cu, (const void*)mk, NTHREADS, LDS_BYTES);
        (void)hipGetLastError();
        grid = cus * (per_cu >= 1 ? 1 : 0);
        if (grid != 256) { fprintf(stderr, "kernel_launch: occupancy %d cus %d\n", per_cu, cus); grid = -1; return; }
    }
    if (grid < 0) return;
    hipMemsetAsync((char*)d_ws + WS_ZERO, 0, ZERO_BYTES, stream);
    Params p{};
    for (int i = 0; i < 23; ++i) p.in[i] = (const float*)d_in[i];
    p.out = (float*)d_out; p.ws = (unsigned char*)d_ws;
    int lo = 0, hi = PH_END;
    void* args[] = {&p, &lo, &hi};
    hipError_t e = hipLaunchCooperativeKernel((const void*)mk, dim3(grid), dim3(NTHREADS), args, LDS_BYTES, stream);
    if (e != hipSuccess) fprintf(stderr, "cooperative launch failed: %s (grid %d)\n", hipGetErrorString(e), grid);
}
```
